# Optimizing an MI355X kernel written in HIP

```python
import math
import jax, jax.numpy as jnp
from jax import lax
import numpy as np

D_MODEL = 1024
BATCH = 4
SEQ = 4096
DEPTH = 1

D_MIX = D_MODEL
D_A = D_MIX // 2
A_GROUPS = 4
A_DH = D_A // A_GROUPS
A_CHUNK = 128
D_B = D_MIX - D_A
B_HEADS = 8
B_DH = D_B // B_HEADS
B_BLOCK = 256
B_TOPK = 3
B_QCHUNK = 64
D_IN_PROJ = 2 * D_A + 3 * D_B
D_PLE = 256
N_GROUPS = 4
EXP_PER_GROUP = 8
N_EXPERTS = N_GROUPS * EXP_PER_GROUP
D_FF_EXP = 256
TOP_K_EXP = 2
MOE_TCHUNK = 2048
EPS = 1e-6
NEG = -1e30

kernel_name = "hymba_gmlp_moba_hiermoe_block"


def rms_norm(x, g):
    xf = x.astype(jnp.float32)
    y = xf * lax.rsqrt(jnp.mean(xf * xf, axis=-1, keepdims=True) + EPS)
    return (y * g.astype(jnp.float32)).astype(x.dtype)


def mixer_a(u, v, g_v, w_s, b_s):
    b, s, _ = u.shape
    nc = s // A_CHUNK
    u = jax.nn.gelu(u).reshape(b, nc, A_CHUNK, A_GROUPS, A_DH)
    v = jax.nn.gelu(v).reshape(b, s, A_GROUPS, A_DH)
    v = rms_norm(v, g_v.reshape(A_GROUPS, A_DH)).reshape(b, nc, A_CHUNK, A_GROUPS, A_DH)
    ws = jnp.tril(w_s)
    mixed = jnp.einsum('gts,bnsgd->bntgd', ws, v) + b_s.T[None, None, :, :, None]
    return (u * mixed).reshape(b, s, D_A)


def mixer_b(q, k, v, g_q, g_k):
    b, s, _ = q.shape
    nb = -(-s // B_BLOCK)
    sp = nb * B_BLOCK
    pad = ((0, 0), (0, sp - s), (0, 0))
    q, k, v = (jnp.pad(t, pad).reshape(b, sp, B_HEADS, B_DH).transpose(0, 2, 1, 3) for t in (q, k, v))
    q = rms_norm(q, g_q)
    k = rms_norm(k, g_k)
    scale = 1.0 / math.sqrt(B_DH)
    kb = k.reshape(b, B_HEADS, nb, B_BLOCK, B_DH)
    vb = v.reshape(b, B_HEADS, nb, B_BLOCK, B_DH)
    kmean = jnp.mean(kb.astype(jnp.float32), axis=3)
    gate = jnp.einsum('bhsd,bhnd->bhsn', q.astype(jnp.float32), kmean)
    qblk = jnp.arange(sp) // B_BLOCK
    past = jnp.arange(nb)[None, :] < qblk[:, None]
    gate = jnp.where(past[None, None], gate, NEG)
    k_sel = min(B_TOPK, nb)
    sel_score, sel_idx = lax.top_k(gate, k_sel)
    sel_valid = sel_score > (NEG * 0.5)

    nqc = sp // B_QCHUNK
    q_ch = jnp.moveaxis(q.reshape(b, B_HEADS, nqc, B_QCHUNK, B_DH), 2, 0)
    idx_ch = jnp.moveaxis(sel_idx.reshape(b, B_HEADS, nqc, B_QCHUNK, k_sel), 2, 0)
    val_ch = jnp.moveaxis(sel_valid.reshape(b, B_HEADS, nqc, B_QCHUNK, k_sel), 2, 0)
    gather = jax.vmap(jax.vmap(lambda blocks, ix: blocks[ix]))

    def step(args):
        q_c, idx_c, val_c, c = args
        blk = (c * B_QCHUNK) // B_BLOCK
        k_own = lax.dynamic_index_in_dim(kb, blk, axis=2, keepdims=False)
        v_own = lax.dynamic_index_in_dim(vb, blk, axis=2, keepdims=False)
        k_g = gather(kb, idx_c)
        v_g = gather(vb, idx_c)
        s_g = jnp.einsum('bhqd,bhqnkd->bhqnk', q_c, k_g).astype(jnp.float32) * scale
        s_g = jnp.where(val_c[..., None], s_g, NEG).reshape(b, B_HEADS, B_QCHUNK, k_sel * B_BLOCK)
        s_o = jnp.einsum('bhqd,bhkd->bhqk', q_c, k_own).astype(jnp.float32) * scale
        qpos = c * B_QCHUNK + jnp.arange(B_QCHUNK)
        kpos = blk * B_BLOCK + jnp.arange(B_BLOCK)
        s_o = jnp.where((kpos[None, :] <= qpos[:, None])[None, None], s_o, NEG)
        probs = jax.nn.softmax(jnp.concatenate([s_g, s_o], axis=-1), axis=-1).astype(v.dtype)
        p_g = probs[..., :k_sel * B_BLOCK].reshape(b, B_HEADS, B_QCHUNK, k_sel, B_BLOCK)
        p_o = probs[..., k_sel * B_BLOCK:]
        return (jnp.einsum('bhqnk,bhqnkd->bhqd', p_g, v_g)
                + jnp.einsum('bhqk,bhkd->bhqd', p_o, v_own))

    out = lax.map(step, (q_ch, idx_ch, val_ch, jnp.arange(nqc)))
    out = jnp.moveaxis(out, 0, 2).reshape(b, B_HEADS, sp, B_DH)[:, :, :s]
    return out.transpose(0, 2, 1, 3).reshape(b, s, D_B)


def hier_moe(xn, w_group, w_expert, w_gate_e, w_up_e, w_down_e):
    t = xn.shape[0]
    g_prob = jax.nn.softmax((xn @ w_group).astype(jnp.float32), axis=-1)
    pg, g_sel = lax.top_k(g_prob, 1)
    e_logits = (xn @ w_expert).astype(jnp.float32).reshape(t, N_GROUPS, EXP_PER_GROUP)
    e_in = jnp.take_along_axis(e_logits, g_sel[:, :, None], axis=1)[:, 0]
    e_prob = jax.nn.softmax(e_in, axis=-1)
    e_w, e_idx = lax.top_k(e_prob, TOP_K_EXP)
    e_w = e_w / jnp.sum(e_w, axis=-1, keepdims=True)
    w_in = jnp.sum(jax.nn.one_hot(e_idx, EXP_PER_GROUP, dtype=jnp.float32) * e_w[..., None], axis=1)
    combine = (jax.nn.one_hot(g_sel[:, 0], N_GROUPS, dtype=jnp.float32)[:, :, None]
               * (pg[:, :, None] * w_in[:, None, :])).reshape(t, N_EXPERTS).astype(xn.dtype)

    tc = math.gcd(t, MOE_TCHUNK)
    xs = xn.reshape(t // tc, tc, -1)
    cs = combine.reshape(t // tc, tc, N_EXPERTS)

    def step(args):
        xc, cc = args
        h = jnp.einsum('td,edf->tef', xc, w_gate_e)
        u = jnp.einsum('td,edf->tef', xc, w_up_e)
        a = jax.nn.silu(h) * u * cc[:, :, None]
        return jnp.einsum('tef,efd->td', a, w_down_e)

    return lax.map(step, (xs, cs)).reshape(t, -1)


def setup_inputs(seed: int = 0) -> dict:
    key = jax.random.key(seed)
    ks = jax.random.split(key, 24)
    f = jnp.float32
    nrm = lambda k, shape, s: jax.random.normal(k, shape, f) * s
    gain = lambda k, shape: 1.0 + 0.05 * jax.random.normal(k, shape, f)
    L = DEPTH
    return {
        "x": jax.random.normal(ks[0], (BATCH, SEQ, D_MODEL), f),
        "p": jax.random.normal(ks[1], (DEPTH, BATCH, SEQ, D_PLE), f),
        "g_mix": gain(ks[2], (L, D_MODEL)),
        "w_in": nrm(ks[3], (L, D_MODEL, D_IN_PROJ), D_MODEL ** -0.5),
        "g_v_a": gain(ks[4], (L, D_A)),
        "w_s": nrm(ks[5], (L, A_GROUPS, A_CHUNK, A_CHUNK), A_CHUNK ** -0.5),
        "b_s": 1.0 + 0.1 * jax.random.normal(ks[6], (L, A_GROUPS, A_CHUNK), f),
        "g_q": gain(ks[7], (L, B_DH)),
        "g_k": gain(ks[8], (L, B_DH)),
        "g_out_a": gain(ks[9], (L, D_A)),
        "g_out_b": gain(ks[10], (L, D_B)),
        "w_out": nrm(ks[11], (L, D_MIX, D_MODEL), D_MIX ** -0.5),
        "g_ffn": gain(ks[12], (L, D_MODEL)),
        "w_group": nrm(ks[13], (L, D_MODEL, N_GROUPS), D_MODEL ** -0.5),
        "w_expert": nrm(ks[14], (L, D_MODEL, N_EXPERTS), D_MODEL ** -0.5),
        "w_gate_e": nrm(ks[15], (L, N_EXPERTS, D_MODEL, D_FF_EXP), D_MODEL ** -0.5),
        "w_up_e": nrm(ks[16], (L, N_EXPERTS, D_MODEL, D_FF_EXP), D_MODEL ** -0.5),
        "w_down_e": nrm(ks[17], (L, N_EXPERTS, D_FF_EXP, D_MODEL), D_FF_EXP ** -0.5),
        "g_ple": gain(ks[18], (L, D_MODEL)),
        "w_ple": nrm(ks[19], (L, D_PLE, D_MODEL), D_PLE ** -0.5),
        "w_ple_gate": nrm(ks[20], (L, D_MODEL, D_MODEL), D_MODEL ** -0.5),
    }


def reference(x, p, g_mix, w_in, g_v_a, w_s, b_s, g_q, g_k, g_out_a, g_out_b, w_out,
              g_ffn, w_group, w_expert, w_gate_e, w_up_e, w_down_e, g_ple, w_ple, w_ple_gate):
    b, s, d = x.shape
    h = x
    for i in range(DEPTH):
        xn = rms_norm(h, g_mix[i])
        proj = xn @ w_in[i]
        u_a, v_a, q_b, k_b, v_b = jnp.split(
            proj, [D_A, 2 * D_A, 2 * D_A + D_B, 2 * D_A + 2 * D_B], axis=-1)
        y_a = rms_norm(mixer_a(u_a, v_a, g_v_a[i], w_s[i], b_s[i]), g_out_a[i])
        y_b = rms_norm(mixer_b(q_b, k_b, v_b, g_q[i], g_k[i]), g_out_b[i])
        h = h + jnp.concatenate([y_a, y_b], axis=-1) @ w_out[i]
        hn = rms_norm(h, g_ffn[i]).reshape(b * s, d)
        h = h + hier_moe(hn, w_group[i], w_expert[i], w_gate_e[i], w_up_e[i], w_down_e[i]).reshape(b, s, d)
        gate = jax.nn.sigmoid(rms_norm(h, g_ple[i]) @ w_ple_gate[i])
        h = h + (p[i] @ w_ple[i]) * gate
    return h
```

```cpp
#include <hip/hip_runtime.h>
#include <math.h>
#include <stdint.h>
#include <cstdio>

#ifndef MODE
#define MODE 1
#endif

typedef unsigned short bf16_t;
constexpr int NB_ = 4, S_ = 4096, D_ = 1024, T_ = NB_ * S_;
constexpr int DIN = 2560, NH = 8, DH = 64, BLK = 256, NBLK = 16;
constexpr int NE = 32, DFF = 256, DPLE = 256;
constexpr float EPS = 1e-6f;
constexpr size_t MiB = 1u << 20;
constexpr size_t ARR = (size_t)T_ * 512;

__host__ __device__ __forceinline__ unsigned f2bf(float f) { unsigned u = __builtin_bit_cast(unsigned, f); return (u + 0x7fffu + ((u >> 16) & 1u)) >> 16; }
__device__ __forceinline__ float bf2f(unsigned h) { return __uint_as_float(h << 16); }
__device__ __forceinline__ float ldv(const float* p, size_t i) { return p[i]; }
__device__ __forceinline__ float ldv(const bf16_t* p, size_t i) { return bf2f((unsigned)p[i]); }
__device__ __forceinline__ void stv(float* p, size_t i, float v) { p[i] = v; }
__device__ __forceinline__ void stv(bf16_t* p, size_t i, float v) { p[i] = (bf16_t)f2bf(v); }

namespace orc {
__device__ __forceinline__ float gelu_tanh(float x) {
    const float c = 0.7978845608028654f;
    return 0.5f * x * (1.f + tanhf(c * (x + 0.044715f * x * x * x)));
}
__device__ __forceinline__ float sigmoidf_(float x) { return 1.f / (1.f + expf(-x)); }
__device__ __forceinline__ float wave_sum(float v) {
#pragma unroll
    for (int o = 32; o > 0; o >>= 1) v += __shfl_xor(v, o);
    return v;
}
template <class TI>
__global__ void __launch_bounds__(256) k_row_rstd(const TI* __restrict__ x, float* __restrict__ rstd, int nrows, int ncols, int ld, int pad_) {
    const int row = blockIdx.x * 4 + (threadIdx.x >> 6), lane = threadIdx.x & 63;
    if (row >= nrows) return;
    float s = 0.f;
    for (int c = lane; c < ncols; c += 64) { const float v = ldv(x, (size_t)row * ld + c); s += v * v; }
    s = wave_sum(s);
    if (lane == 0) rstd[row] = rsqrtf(s / (float)ncols + EPS);
}
template <class TO>
__global__ void __launch_bounds__(256) k_rownorm_inplace(TO* __restrict__ y, const float* __restrict__ g, int nrows, int ncols, int ld, int c0) {
    const int row = blockIdx.x * 4 + (threadIdx.x >> 6), lane = threadIdx.x & 63;
    if (row >= nrows) return;
    float s = 0.f;
    for (int c = lane; c < ncols; c += 64) { const float v = ldv(y, (size_t)row * ld + c0 + c); s += v * v; }
    s = wave_sum(s);
    const float r = rsqrtf(s / (float)ncols + EPS);
    for (int c = lane; c < ncols; c += 64) { const size_t i = (size_t)row * ld + c0 + c; stv(y, i, ldv(y, i) * r * g[c]); }
}
template <class AL, class BL, class EP>
__global__ void __launch_bounds__(256) k_sgemm(long K, AL al, BL bl, EP ep) {
    __shared__ float As[16][65];
    __shared__ float Bs[16][65];
    const int tx = threadIdx.x & 15, ty = threadIdx.x >> 4;
    const int m0 = blockIdx.y * 64, n0 = blockIdx.x * 64;
    float acc[4][4];
#pragma unroll
    for (int i = 0; i < 4; ++i)
#pragma unroll
        for (int j = 0; j < 4; ++j) acc[i][j] = 0.f;
    for (int k0 = 0; k0 < K; k0 += 16) {
#pragma unroll
        for (int r = 0; r < 4; ++r) { const int i = threadIdx.x + r * 256; const int m = i >> 4, k = i & 15; As[k][m] = al(m0 + m, k0 + k); }
#pragma unroll
        for (int r = 0; r < 4; ++r) { const int i = threadIdx.x + r * 256; const int k = i >> 6, n = i & 63; Bs[k][n] = bl(k0 + k, n0 + n); }
        __syncthreads();
#pragma unroll
        for (int k = 0; k < 16; ++k) {
            float a[4], b[4];
#pragma unroll
            for (int i = 0; i < 4; ++i) a[i] = As[k][ty * 4 + i];
#pragma unroll
            for (int j = 0; j < 4; ++j) b[j] = Bs[k][tx * 4 + j];
#pragma unroll
            for (int i = 0; i < 4; ++i)
#pragma unroll
                for (int j = 0; j < 4; ++j) acc[i][j] += a[i] * b[j];
        }
        __syncthreads();
    }
#pragma unroll
    for (int i = 0; i < 4; ++i)
#pragma unroll
        for (int j = 0; j < 4; ++j) ep(m0 + ty * 4 + i, n0 + tx * 4 + j, acc[i][j]);
}
template <class TI> struct ALScaled { const TI* x; const float* rstd; const float* g; int ld; int pad;
    __device__ float operator()(int m, int k) const { return ldv(x, (size_t)m * ld + k) * rstd[m] * g[k]; } };
template <class TI> struct ALPlain { const TI* x; int ld; int pad;
    __device__ float operator()(int m, int k) const { return ldv(x, (size_t)m * ld + k); } };
struct BLPlain { const float* w; int ld; int pad;
    __device__ float operator()(int k, int n) const { return w[(size_t)k * ld + n]; } };
struct EPStore { float* c; int ld; int pad;
    __device__ void operator()(int m, int n, float v) const { c[(size_t)m * ld + n] = v; } };
struct EPSplit5 { float* a0;
    __device__ void operator()(int m, int n, float v) const { a0[(size_t)(n >> 9) * ARR + (size_t)m * 512 + (n & 511)] = v; } };
struct EPResid { const float* r; float* c; int ld; int pad;
    __device__ void operator()(int m, int n, float v) const { c[(size_t)m * ld + n] = r[(size_t)m * ld + n] + v; } };
template <class TP> struct EPPle { const float* h; const TP* pw; float* c; int ld; int pad;
    __device__ void operator()(int m, int n, float v) const { const size_t i = (size_t)m * ld + n; c[i] = h[i] + ldv(pw, i) * sigmoidf_(v); } };

__global__ void __launch_bounds__(256) k_post_gelu(float* __restrict__ a0) {
    const size_t i = (size_t)blockIdx.x * 256 + threadIdx.x;
    a0[i] = gelu_tanh(a0[i]);
}
__global__ void __launch_bounds__(256) k_qknorm(float* __restrict__ a0, const float* __restrict__ g_q, const float* __restrict__ g_k) {
    const int idx = blockIdx.x * 256 + threadIdx.x;
    if (idx >= T_ * 16) return;
    const int t = idx >> 4, which = (idx >> 3) & 1, h = idx & 7;
    float* p = a0 + (size_t)(2 + which) * ARR + (size_t)t * 512 + h * 64;
    const float* g = which ? g_k : g_q;
    float s = 0.f;
    for (int d = 0; d < 64; ++d) s += p[d] * p[d];
    const float r = rsqrtf(s / 64.f + EPS);
    for (int d = 0; d < 64; ++d) p[d] = p[d] * r * g[d];
}
template <class TI>
__global__ void __launch_bounds__(256) k_va_rstd(const TI* __restrict__ va, float* __restrict__ rstd_va) {
    const int idx = blockIdx.x * 4 + (threadIdx.x >> 6), lane = threadIdx.x & 63;
    const int t = idx >> 2, g = idx & 3;
    float s = 0.f;
    for (int d = lane; d < 128; d += 64) { const float v = ldv(va, (size_t)t * 512 + g * 128 + d); s += v * v; }
    s = wave_sum(s);
    if (lane == 0) rstd_va[idx] = rsqrtf(s / 128.f + EPS);
}
template <class TI, class TO>
__global__ void __launch_bounds__(256) k_mixa(const TI* __restrict__ ua, const TI* __restrict__ va, const float* __restrict__ rstd_va, const float* __restrict__ g_v,
                                              const float* __restrict__ w_s, const float* __restrict__ b_s, TO* __restrict__ ycat) {
    const int bc = blockIdx.x, g = blockIdx.y;
    const int t0 = bc * 128;
    for (int o = threadIdx.x; o < 128 * 128; o += 256) {
        const int tl = o >> 7, d = o & 127;
        float acc = 0.f;
        for (int s = 0; s <= tl; ++s) {
            const float v = ldv(va, (size_t)(t0 + s) * 512 + g * 128 + d) * rstd_va[(t0 + s) * 4 + g] * g_v[g * 128 + d];
            acc += w_s[((size_t)g * 128 + tl) * 128 + s] * v;
        }
        acc += b_s[g * 128 + tl];
        const float u = ldv(ua, (size_t)(t0 + tl) * 512 + g * 128 + d);
        stv(ycat, (size_t)(t0 + tl) * D_ + g * 128 + d, u * acc);
    }
}
template <class TI>
__global__ void __launch_bounds__(256) k_kmean(const TI* __restrict__ kn, float* __restrict__ kmean) {
    const int idx = blockIdx.x * 256 + threadIdx.x;
    if (idx >= NB_ * NH * NBLK * DH) return;
    const int d = idx & 63, n = (idx >> 6) & 15, h = (idx >> 10) & 7, b = idx >> 13;
    float s = 0.f;
    for (int r = 0; r < BLK; ++r) s += ldv(kn, (size_t)(b * S_ + n * BLK + r) * 512 + h * 64 + d);
    kmean[idx] = s / (float)BLK;
}
template <class TI>
__global__ void __launch_bounds__(256) k_gate(const TI* __restrict__ qn, const float* __restrict__ kmean, int* __restrict__ sel) {
    const int idx = blockIdx.x * 256 + threadIdx.x;
    if (idx >= T_ * NH) return;
    const int t = idx >> 3, h = idx & 7, b = t / S_, s = t % S_, qb = s / BLK;
    float v0 = -INFINITY, v1 = -INFINITY, v2 = -INFINITY; int i0 = -1, i1 = -1, i2 = -1;
    for (int n = 0; n < qb; ++n) {
        const float* km = kmean + ((size_t)(b * NH + h) * NBLK + n) * DH;
        float sc = 0.f;
        for (int d = 0; d < 64; ++d) sc += ldv(qn, (size_t)t * 512 + h * 64 + d) * km[d];
        if (sc > v0) { v2 = v1; i2 = i1; v1 = v0; i1 = i0; v0 = sc; i0 = n; }
        else if (sc > v1) { v2 = v1; i2 = i1; v1 = sc; i1 = n; }
        else if (sc > v2) { v2 = sc; i2 = n; }
    }
    sel[idx * 3 + 0] = i0; sel[idx * 3 + 1] = i1; sel[idx * 3 + 2] = i2;
}
template <class TI, class TO>
__global__ void __launch_bounds__(256) k_attn(const TI* __restrict__ qn, const TI* __restrict__ kn, const TI* __restrict__ vb, const int* __restrict__ sel, TO* __restrict__ ycat, int ldo, int coff) {
    __shared__ float qs[64];
    __shared__ float ps[4][256];
    __shared__ float red[4];
    __shared__ float part[4][64];
    const int idx = blockIdx.x;
    const int t = idx >> 3, h = idx & 7, b = t / S_, s = t % S_, qb = s / BLK;
    const int tid = threadIdx.x, lane = tid & 63, wid = tid >> 6;
    if (tid < 64) qs[tid] = ldv(qn, (size_t)t * 512 + h * 64 + tid);
    __syncthreads();
    const int b0 = sel[idx * 3 + 0], b1 = sel[idx * 3 + 1], b2 = sel[idx * 3 + 2], b3 = qb;
    float sc[4];
    float mx = -INFINITY;
#pragma unroll
    for (int j = 0; j < 4; ++j) {
        const int bj = (j == 0) ? b0 : (j == 1) ? b1 : (j == 2) ? b2 : b3;
        sc[j] = -INFINITY;
        if (bj >= 0) {
            const int kpos = bj * BLK + tid;
            if (j < 3 || kpos <= s) {
                float a = 0.f;
                for (int d = 0; d < 64; ++d) a += qs[d] * ldv(kn, (size_t)(b * S_ + kpos) * 512 + h * 64 + d);
                sc[j] = a * 0.125f;
            }
        }
        mx = fmaxf(mx, sc[j]);
    }
#pragma unroll
    for (int o = 32; o > 0; o >>= 1) mx = fmaxf(mx, __shfl_xor(mx, o));
    if (lane == 0) red[wid] = mx;
    __syncthreads();
    mx = fmaxf(fmaxf(red[0], red[1]), fmaxf(red[2], red[3]));
    __syncthreads();
    float sum = 0.f;
#pragma unroll
    for (int j = 0; j < 4; ++j) { const float p = (sc[j] == -INFINITY) ? 0.f : expf(sc[j] - mx); ps[j][tid] = p; sum += p; }
    sum = wave_sum(sum);
    if (lane == 0) red[wid] = sum;
    __syncthreads();
    sum = red[0] + red[1] + red[2] + red[3];
    float o = 0.f;
    {
        const int j = wid;
        const int bj = (j == 0) ? b0 : (j == 1) ? b1 : (j == 2) ? b2 : b3;
        if (bj >= 0) {
            for (int k = 0; k < 256; ++k) {
                const float p = ps[j][k];
                if (p != 0.f) o += p * ldv(vb, (size_t)(b * S_ + bj * BLK + k) * 512 + h * 64 + lane);
            }
        }
    }
    part[wid][lane] = o;
    __syncthreads();
    if (tid < 64) stv(ycat, (size_t)t * ldo + coff + h * 64 + tid, (part[0][tid] + part[1][tid] + part[2][tid] + part[3][tid]) / sum);
}
__global__ void __launch_bounds__(256) k_fill(float* __restrict__ p, float v, int n, int pad_) { const int i = blockIdx.x * 256 + threadIdx.x; if (i < n) p[i] = v; }
struct Route { int e1, e2; float c1, c2; };
__global__ void __launch_bounds__(256) k_route(const float* __restrict__ h, const float* __restrict__ rstd, const float* __restrict__ g,
                                               const float* __restrict__ w_group, const float* __restrict__ w_expert, Route* __restrict__ route) {
    const int t = blockIdx.x * 4 + (threadIdx.x >> 6), lane = threadIdx.x & 63;
    float acc[36];
#pragma unroll
    for (int j = 0; j < 36; ++j) acc[j] = 0.f;
    const float r = rstd[t];
    for (int k = lane; k < D_; k += 64) {
        const float xv = h[(size_t)t * D_ + k] * r * g[k];
#pragma unroll
        for (int j = 0; j < 4; ++j) acc[j] += xv * w_group[k * 4 + j];
#pragma unroll
        for (int j = 0; j < 32; ++j) acc[4 + j] += xv * w_expert[k * 32 + j];
    }
#pragma unroll
    for (int j = 0; j < 36; ++j) acc[j] = wave_sum(acc[j]);
    if (lane == 0) {
        int gs = 0; float gm = acc[0];
#pragma unroll
        for (int j = 1; j < 4; ++j) if (acc[j] > gm) { gm = acc[j]; gs = j; }
        float den = 0.f;
#pragma unroll
        for (int j = 0; j < 4; ++j) den += expf(acc[j] - gm);
        const float pg = 1.f / den;
        float el[8];
#pragma unroll
        for (int j = 0; j < 8; ++j) {
            float v = acc[4 + j];
#pragma unroll
            for (int gg = 1; gg < 4; ++gg) v = (gs == gg) ? acc[4 + gg * 8 + j] : v;
            el[j] = v;
        }
        int a1 = 0; float m1 = el[0];
#pragma unroll
        for (int j = 1; j < 8; ++j) if (el[j] > m1) { m1 = el[j]; a1 = j; }
        int a2 = -1; float m2 = -INFINITY;
#pragma unroll
        for (int j = 0; j < 8; ++j) if (j != a1 && el[j] > m2) { m2 = el[j]; a2 = j; }
        const float e2 = expf(m2 - m1);
        Route rt; rt.e1 = gs * 8 + a1; rt.e2 = gs * 8 + a2; rt.c1 = pg / (1.f + e2); rt.c2 = pg * e2 / (1.f + e2);
        route[t] = rt;
    }
}
__global__ void __launch_bounds__(256) k_moe(const float* __restrict__ h, const float* __restrict__ rstd, const float* __restrict__ g, const Route* __restrict__ route,
                                             const float* __restrict__ wg, const float* __restrict__ wu, const float* __restrict__ wd, float* __restrict__ h2) {
    __shared__ float xs[D_];
    __shared__ float as[DFF];
    const int t = blockIdx.x, tid = threadIdx.x;
    const float r = rstd[t];
    for (int k = tid; k < D_; k += 256) xs[k] = h[(size_t)t * D_ + k] * r * g[k];
    __syncthreads();
    const Route rt = route[t];
    float out[4] = {0.f, 0.f, 0.f, 0.f};
    for (int slot = 0; slot < 2; ++slot) {
        const int e = slot ? rt.e2 : rt.e1; const float cw = slot ? rt.c2 : rt.c1;
        const float* pg_ = wg + (size_t)e * D_ * DFF; const float* pu_ = wu + (size_t)e * D_ * DFF; const float* pd_ = wd + (size_t)e * DFF * D_;
        float hh = 0.f, uu = 0.f;
        for (int k = 0; k < D_; ++k) { const float xv = xs[k]; hh += xv * pg_[(size_t)k * DFF + tid]; uu += xv * pu_[(size_t)k * DFF + tid]; }
        __syncthreads();
        as[tid] = hh * sigmoidf_(hh) * uu * cw;
        __syncthreads();
        for (int f = 0; f < DFF; ++f) {
            const float a = as[f];
#pragma unroll
            for (int i = 0; i < 4; ++i) out[i] += a * pd_[(size_t)f * D_ + tid + 256 * i];
        }
    }
#pragma unroll
    for (int i = 0; i < 4; ++i) h2[(size_t)t * D_ + tid + 256 * i] = h[(size_t)t * D_ + tid + 256 * i] + out[i];
}
}

namespace pg8 {
#define PG8_LAS __attribute__((address_space(3)))
typedef short bf16x8 __attribute__((ext_vector_type(8)));
typedef float f32x4 __attribute__((ext_vector_type(4)));
typedef float f32x2 __attribute__((ext_vector_type(2)));
typedef unsigned u32x4 __attribute__((ext_vector_type(4)));
typedef unsigned u32x2 __attribute__((ext_vector_type(2)));
constexpr int BM = 256, BK = 64, HALF = 128, HTB = HALF * BK * 2, STAGE_BYTES = 8 * HTB, NXCD = 8, WGM = 8;

__host__ __device__ __forceinline__ int lds_byte(int r, int c) { const int st = (r >> 4) * 2 + (c >> 5), rr = r & 15, cc = c & 31, ob = rr * 64 + cc * 2; return st * 1024 + (ob ^ (((ob >> 9) & 1) << 5)); }
__host__ __device__ __forceinline__ void stage_rc(int b, int& R, int& C) { const int st = b / 1024, sb = b % 1024, swz = sb ^ (((sb >> 9) & 1) << 5); R = (st >> 1) * 16 + swz / 64; C = (st & 1) * 32 + (swz % 64) / 2; }
__host__ __device__ __forceinline__ int perm32(int rho) { const int n = rho >> 4, i = rho & 15; return 8 * (i >> 2) + 4 * n + (i & 3); }

struct Unit { int pm, pn, e, aux; };

__device__ __forceinline__ unsigned cvt_pk_bf16(float lo, float hi) { unsigned r; asm volatile("v_cvt_pk_bf16_f32 %0, %1, %2" : "=v"(r) : "v"(lo), "v"(hi)); return r; }

struct StaticOrder {
    static constexpr bool GATHER = false;
    const char* A; const char* Bt; int K; int nM, nN, nwg, G, c;
    __device__ void init(const void* A_, const void* Bt_, int M, int N, int K_, int G_, int c_) { A = (const char*)A_; Bt = (const char*)Bt_; K = K_; nM = M / BM; nN = N / BM; nwg = nM * nN; G = G_; c = c_; }
    __device__ bool next(int i, Unit& u) const {
        const long L = (long)i * G + c; if (L >= nwg) return false;
        int wgid = (int)L; { const int q = nwg / NXCD, r = nwg % NXCD, xcd = wgid % NXCD, off = wgid / NXCD; wgid = (xcd < r ? xcd * (q + 1) : r * (q + 1) + (xcd - r) * q) + off; }
        const int nig = WGM * nN, gid = wgid / nig, fm = gid * WGM, gsz = (nM - fm) < WGM ? (nM - fm) : WGM;
        u.pm = fm + ((wgid % nig) % gsz); u.pn = (wgid % nig) / gsz; u.e = 0; u.aux = 0; return true;
    }
    __device__ __forceinline__ const char* a_base(const Unit& u) const { return A + (size_t)u.pm * BM * K * 2; }
    __device__ __forceinline__ const char* b_base(const Unit& u) const { return Bt + (size_t)u.pn * BM * K * 2; }
    __device__ __forceinline__ int row(const Unit&, int r) const { return r; }
    __device__ __forceinline__ void a_ready(const Unit&) const {}
    __device__ __forceinline__ void done(const Unit&) const {}
};

template <class Epi, class Sched, bool ALIGN_EPI>
__device__ __forceinline__ void gemm_phase(PG8_LAS unsigned char* lds, const int K, const Sched& S, const Epi& E) {
    const int tid = threadIdx.x, wid = __builtin_amdgcn_readfirstlane(tid >> 6), lane = tid & 63, wr = wid >> 2, wc = wid & 3, fr = lane & 15, fq = lane >> 4;
    const int nt = K / BK;
    unsigned voffB[2]; unsigned cv0[2], cv1[2], nv0[2], nv1[2];
    const size_t kstep = (size_t)(BK * 2);
    const size_t hstep = (size_t)HALF * K * 2;
    const unsigned ldsw = (unsigned)wid * 1024u;
    const int aoff = lds_byte(wr * 64 + fr, fq * 8), boff = lds_byte(wc * 32 + fr, fq * 8);
#define PG8_SA(b, h) (((b) * 2 + (h)) * HTB)
#define PG8_SB(b, h) ((4 + (b) * 2 + (h)) * HTB)
#define PG8_STAGE(bufoff, gbase, voff) do { _Pragma("unroll") for (int _i = 0; _i < 2; ++_i) \
        __builtin_amdgcn_global_load_lds((const unsigned*)((const char*)(gbase) + (voff)[_i]), (PG8_LAS unsigned*)(lds + (bufoff) + ldsw + _i * 8192), 16, 0, 0); } while (0)
#define PG8_STAGE_A1(bufoff, gbase, v0_, v1_) do { if constexpr (Sched::GATHER) { PG8_STAGE(bufoff, gbase, v1_); } else { PG8_STAGE(bufoff, (gbase) + hstep, v0_); } } while (0)
#define PG8_LDA(dst, b, h) do { _Pragma("unroll") for (int m = 0; m < 4; ++m) _Pragma("unroll") for (int k = 0; k < 2; ++k) dst[m][k] = *(const PG8_LAS bf16x8*)(lds + PG8_SA(b, h) + aoff + m * 2048 + k * 1024); } while (0)
#define PG8_LDB(dst, b, h) do { _Pragma("unroll") for (int n = 0; n < 2; ++n) _Pragma("unroll") for (int k = 0; k < 2; ++k) dst[n][k] = *(const PG8_LAS bf16x8*)(lds + PG8_SB(b, h) + boff + n * 2048 + k * 1024); } while (0)
#define PG8_MMA(ai, bj, At, Bt) do { __builtin_amdgcn_s_setprio(1); _Pragma("unroll") for (int m = 0; m < 4; ++m) _Pragma("unroll") for (int n = 0; n < 2; ++n) _Pragma("unroll") for (int k = 0; k < 2; ++k) \
        acc[ai][bj][m][n] = __builtin_amdgcn_mfma_f32_16x16x32_bf16(Bt[n][k], At[m][k], acc[ai][bj][m][n], 0, 0, 0); __builtin_amdgcn_s_setprio(0); } while (0)
#define PG8_WAIT_V(n) asm volatile("s_waitcnt vmcnt(" #n ")" ::: "memory")
#define PG8_WAIT_L(n) asm volatile("s_waitcnt lgkmcnt(" #n ")" ::: "memory")
#define PG8_BAR __builtin_amdgcn_s_barrier()
#define PG8_SCHED __builtin_amdgcn_sched_barrier(0)
#define PG8_AOFFS(v0, v1, U) do { _Pragma("unroll") for (int _i = 0; _i < 2; ++_i) { int R_, C_; stage_rc(tid * 16 + _i * 8192, R_, C_); \
        v0[_i] = (unsigned)(S.row(U, R_) * K + C_) * 2u; v1[_i] = (unsigned)(S.row(U, HALF + R_) * K + C_) * 2u; } } while (0)
    Unit cur, nxt; int ui = 0;
    if (!S.next(0, cur)) return;
#pragma unroll
    for (int i = 0; i < 2; ++i) { int R, C; stage_rc(tid * 16 + i * 8192, R, C); const int Rb = Epi::PERM ? ((R & ~31) + perm32(R & 31)) : R; voffB[i] = (unsigned)(Rb * K + C) * 2u; }
    PG8_AOFFS(cv0, cv1, cur);
    f32x4 acc[2][2][4][2];
#pragma unroll
    for (int a = 0; a < 2; ++a)
#pragma unroll
        for (int b = 0; b < 2; ++b)
#pragma unroll
            for (int m = 0; m < 4; ++m)
#pragma unroll
                for (int n = 0; n < 2; ++n) acc[a][b][m][n] = (f32x4){0.f, 0.f, 0.f, 0.f};
    bf16x8 At[4][2], B0[2][2], B1[2][2];
    const char* cA = S.a_base(cur); const char* cB = S.b_base(cur);
    S.a_ready(cur);
    PG8_STAGE(PG8_SB(0, 0), cB, voffB); PG8_STAGE(PG8_SB(0, 1), cB + hstep, voffB); PG8_STAGE(PG8_SA(0, 0), cA, cv0); PG8_STAGE_A1(PG8_SA(0, 1), cA, cv0, cv1);
    if (wr == 1) PG8_BAR;
    PG8_WAIT_V(2); PG8_BAR;
    PG8_STAGE(PG8_SB(1, 0), cB + kstep, voffB); PG8_STAGE(PG8_SA(1, 0), cA + kstep, cv0); PG8_STAGE(PG8_SB(1, 1), cB + hstep + kstep, voffB);
    PG8_WAIT_V(6); PG8_BAR;
    for (;;) {
        const bool has_next = S.next(ui + 1, nxt);
        const char* nA = has_next ? S.a_base(nxt) : cA; const char* nB = has_next ? S.b_base(nxt) : cB;
        if constexpr (Sched::GATHER) { if (has_next) { PG8_AOFFS(nv0, nv1, nxt); } else { nv0[0] = cv0[0]; nv0[1] = cv0[1]; nv1[0] = cv1[0]; nv1[1] = cv1[1]; } }
        for (int t = 0; t < nt; t += 2) {
            const bool last = (t == nt - 2);
            const char* a1 = cA + (size_t)(t + 1) * kstep;
            const char* a2 = last ? nA : cA + (size_t)(t + 2) * kstep; const char* b2 = last ? nB : cB + (size_t)(t + 2) * kstep;
            const char* a3 = a2 + kstep; const char* b3 = b2 + kstep;
            unsigned s0[2], s1[2];
            if constexpr (Sched::GATHER) { s0[0] = last ? nv0[0] : cv0[0]; s0[1] = last ? nv0[1] : cv0[1]; s1[0] = last ? nv1[0] : cv1[0]; s1[1] = last ? nv1[1] : cv1[1]; }
            else { s0[0] = cv0[0]; s0[1] = cv0[1]; s1[0] = 0u; s1[1] = 0u; }
            if (last && has_next) S.a_ready(nxt);
            PG8_LDB(B0, 0, 0); PG8_LDB(B1, 0, 1); PG8_SCHED; PG8_LDA(At, 0, 0); PG8_STAGE_A1(PG8_SA(1, 1), a1, cv0, cv1);
            PG8_WAIT_V(8); PG8_WAIT_L(0); PG8_BAR; PG8_MMA(0, 0, At, B0); PG8_MMA(0, 1, At, B1); PG8_BAR; PG8_SCHED;
            PG8_LDA(At, 0, 1); PG8_STAGE(PG8_SB(0, 0), b2, voffB); PG8_STAGE(PG8_SB(0, 1), b2 + hstep, voffB); PG8_STAGE(PG8_SA(0, 0), a2, s0);
            PG8_WAIT_V(8); PG8_WAIT_L(0); PG8_BAR; PG8_MMA(1, 0, At, B0); PG8_MMA(1, 1, At, B1); PG8_BAR; PG8_SCHED;
            PG8_LDB(B0, 1, 0); PG8_LDB(B1, 1, 1); PG8_SCHED; PG8_LDA(At, 1, 0); PG8_STAGE_A1(PG8_SA(0, 1), a2, s0, s1);
            PG8_WAIT_V(8); PG8_WAIT_L(0); PG8_BAR; PG8_MMA(0, 0, At, B0); PG8_MMA(0, 1, At, B1); PG8_BAR; PG8_SCHED;
            PG8_LDA(At, 1, 1); PG8_STAGE(PG8_SB(1, 0), b3, voffB); PG8_STAGE(PG8_SB(1, 1), b3 + hstep, voffB); PG8_STAGE(PG8_SA(1, 0), a3, s0);
            PG8_WAIT_V(8); PG8_WAIT_L(0); PG8_BAR; PG8_MMA(1, 0, At, B0); PG8_MMA(1, 1, At, B1); PG8_BAR; PG8_SCHED;
        }
        if constexpr (ALIGN_EPI) { if (wr == 0) PG8_BAR; }
        { int l2 = lane; asm volatile("" : "+v"(l2)); E(acc, cur, wr, wc, l2 & 15, l2 >> 4); } S.done(cur);
        if (!has_next) break;
#pragma unroll
        for (int a = 0; a < 2; ++a)
#pragma unroll
            for (int b = 0; b < 2; ++b)
#pragma unroll
                for (int m = 0; m < 4; ++m)
#pragma unroll
                    for (int n = 0; n < 2; ++n) acc[a][b][m][n] = (f32x4){0.f, 0.f, 0.f, 0.f};
        cur = nxt; cA = nA; cB = nB; ++ui;
        if constexpr (Sched::GATHER) { cv0[0] = nv0[0]; cv0[1] = nv0[1]; cv1[0] = nv1[0]; cv1[1] = nv1[1]; }
        if constexpr (ALIGN_EPI) { if (wr == 1) PG8_BAR; }
    }
    PG8_WAIT_V(0);
    if constexpr (!ALIGN_EPI) { if (wr == 0) PG8_BAR; }
    PG8_BAR;
#undef PG8_SA
#undef PG8_SB
#undef PG8_STAGE
#undef PG8_STAGE_A1
#undef PG8_LDA
#undef PG8_LDB
#undef PG8_MMA
#undef PG8_WAIT_V
#undef PG8_WAIT_L
#undef PG8_BAR
#undef PG8_SCHED
#undef PG8_AOFFS
}
}

#define GAS __attribute__((address_space(1)))
#define LAS __attribute__((address_space(3)))
typedef unsigned v4u __attribute__((ext_vector_type(4)));
typedef unsigned v2u __attribute__((ext_vector_type(2)));
typedef float f32x4 __attribute__((ext_vector_type(4)));
typedef float f32x2 __attribute__((ext_vector_type(2)));
typedef short bf16x8 __attribute__((ext_vector_type(8)));
typedef GAS unsigned gu32;
#define RLX_AGENT __ATOMIC_RELAXED, __HIP_MEMORY_SCOPE_AGENT
#define LDS_WAIT() asm volatile("s_waitcnt lgkmcnt(0)" ::: "memory")
#define VM_WAIT() asm volatile("s_waitcnt vmcnt(0)" ::: "memory")
constexpr int NWAVES = 8;
constexpr int PH_COMB = 4;

constexpr size_t WS_WIN = 0;
constexpr size_t WS_WOUT = 5 * MiB;
constexpr size_t WS_WGU = 7 * MiB;
constexpr size_t WS_WD = 39 * MiB;
constexpr size_t WS_WPLE = 55 * MiB;
constexpr size_t WS_WPG = 56 * MiB;
constexpr size_t WS_XN = 58 * MiB;
constexpr size_t WS_PB = 90 * MiB;
constexpr size_t WS_ARR = 98 * MiB;
constexpr size_t WS_PW = 211 * MiB;
constexpr size_t WS_CTL = 243 * MiB;
constexpr size_t WS_ACC = 244 * MiB;
constexpr size_t ZERO_BYTES = 2 * MiB;
constexpr size_t WS_KMEAN = WS_ACC, WS_SSQ1 = WS_ACC + 128 * 1024, WS_SSQ2 = WS_ACC + 192 * 1024;
constexpr size_t WS_YCAT = 58 * MiB;
constexpr size_t WS_H1B = 90 * MiB;
constexpr size_t WS_A2 = 122 * MiB;
constexpr size_t WS_YS = 142 * MiB;
constexpr size_t WS_H2B = 58 * MiB;
constexpr size_t WS_YA = 178 * MiB;
constexpr size_t WS_LP = 194 * MiB;
constexpr size_t WS_QL = 196 * MiB;
constexpr int CW_QCNT = 8192;
constexpr size_t WS_LTOK = 245 * MiB;
constexpr size_t WS_LSC = 247 * MiB;
constexpr size_t WS_RSTD2 = 251 * MiB;
constexpr size_t WS_WR = 251 * MiB + 512 * 1024;
constexpr size_t WS_ORC = 252 * MiB;
constexpr int CW_CNT = 1024;
constexpr int LCAP = 16384;
constexpr int CW_BAR = 4096;

constexpr int RING_OFF = 0, RING_BYTES = 131072;
constexpr int XTRA_OFF = 131072;
constexpr int LDS_BYTES = 163840;
constexpr int LDSCTL_OFF = LDS_BYTES - 512, MISC_OFF = LDSCTL_OFF + 320;

#define XB_TMO      128
#define XB_XCNT(j)  (256  + 64 * (j))
#define XB_XSUB(j)  (1280 + 64 * (j))
#define XB_XGEN(j)  (2304 + 64 * (j))
#define XB_TOP      3328
#define XB_TOPGEN   3392
#define XCD_BAR_WORDS 3456
#define XB_SPIN_CAP (1u << 18)
__device__ __forceinline__ unsigned xb_ld(unsigned* p)              { return __hip_atomic_load(p, __ATOMIC_RELAXED, __HIP_MEMORY_SCOPE_AGENT); }
__device__ __forceinline__ unsigned xb_add(unsigned* p, unsigned v) { return __hip_atomic_fetch_add(p, v, __ATOMIC_RELAXED, __HIP_MEMORY_SCOPE_AGENT); }
__device__ __forceinline__ unsigned xb_xcc_id() { return (unsigned)__builtin_amdgcn_s_getreg((3 << 11) | 20) & 0xFu; }
#define XB_SPIN(cond, bar) do { unsigned _sp = 0; while (cond) { __builtin_amdgcn_s_sleep(1); \
    if ((++_sp & 255u) == 0u) { if (xb_ld(&(bar)[XB_TMO])) break; if (_sp > XB_SPIN_CAP) { atomicAdd(&(bar)[XB_TMO], 1u); break; } } } } while (0)
struct XcdBarrier { unsigned* bar; unsigned x; volatile LAS unsigned* st; };
__device__ __forceinline__ XcdBarrier xcd_barrier_post(unsigned* bar, volatile LAS unsigned* st) {
    XcdBarrier b; b.bar = bar; b.x = xb_xcc_id(); b.st = st;
    if (threadIdx.x == 0) (void)xb_add(&bar[XB_XCNT(b.x)], 1u);
    return b;
}
__device__ __forceinline__ void xcd_barrier_complete(unsigned* bar, unsigned x, unsigned& nloc, unsigned& nx) {
    const unsigned G = gridDim.x * gridDim.y * gridDim.z;
    unsigned sum, cnt, mine, sp = 0u;
    for (;;) {
        sum = 0u; cnt = 0u; mine = 0u;
#pragma unroll
        for (unsigned j = 0; j < 16; ++j) { const unsigned c = xb_ld(&bar[XB_XCNT(j)]); sum += c; cnt += (c > 0u) ? 1u : 0u; mine = (j == x) ? c : mine; }
        if (sum == G) break;
        __builtin_amdgcn_s_sleep(1);
        if ((++sp & 255u) == 0u) { if (xb_ld(&bar[XB_TMO])) break; if (sp > XB_SPIN_CAP) { atomicAdd(&bar[XB_TMO], 1u); break; } }
    }
    nloc = mine > 0u ? mine : 1u; nx = cnt > 0u ? cnt : 1u;
}
__device__ __forceinline__ void xcd_barrier(const XcdBarrier& b) {
    asm volatile("s_waitcnt vmcnt(0)" ::: "memory");
    __syncthreads();
    if (threadIdx.x == 0) {
        unsigned* bar = b.bar;
        __builtin_amdgcn_s_waitcnt(0);
        unsigned nloc = b.st[0], nx = b.st[1];
        if (nloc == 0u) { xcd_barrier_complete(bar, b.x, nloc, nx); b.st[0] = nloc; b.st[1] = nx; }
        const unsigned old = xb_add(&bar[XB_XSUB(b.x)], 1u);
        const unsigned gen = old / nloc;
        if (old + 1u == (gen + 1u) * nloc) {
            __builtin_amdgcn_fence(__ATOMIC_RELEASE, "agent");
            asm volatile("s_waitcnt vmcnt(0)" ::: "memory");
            const unsigned og = xb_add(&bar[XB_TOP], 1u);
            const unsigned tg = og / nx;
            if (og + 1u == (tg + 1u) * nx) xb_add(&bar[XB_TOPGEN], 1u);
            else XB_SPIN(xb_ld(&bar[XB_TOPGEN]) == tg, bar);
            __builtin_amdgcn_fence(__ATOMIC_ACQUIRE, "agent");
            xb_add(&bar[XB_XGEN(b.x)], 1u);
            asm volatile("s_waitcnt vmcnt(0)" ::: "memory");
        } else {
            XB_SPIN(xb_ld(&bar[XB_XGEN(b.x)]) == gen, bar);
            __builtin_amdgcn_fence(__ATOMIC_ACQUIRE, "agent");
            asm volatile("s_waitcnt vmcnt(0)" ::: "memory");
        }
    }
    __syncthreads();
}

struct Args { const float* in[21]; float* out; unsigned char* ws; int ph_lo, ph_hi, li, pad; };

__device__ __forceinline__ float gelu_fast(float x) {
    const float z = x * (0.7978845608f + 0.0356774081f * x * x);
    const float e = __builtin_amdgcn_exp2f(-2.885390082f * z);
    return x * __builtin_amdgcn_rcpf(1.f + e);
}
struct EpiInProj {
    static constexpr bool PERM = true;
    bf16_t* arr0; float* kmean; const float* gq; const float* gk;
    __device__ __forceinline__ void operator()(const pg8::f32x4 (&acc)[2][2][4][2], const pg8::Unit& u, int wr, int wc, int fr, int fq) const {
        using namespace pg8;
        const int kind = u.pn >> 1;
        bf16_t* base = arr0 + (size_t)kind * ARR + (size_t)(u.pm * 256 + wr * 64 + fr) * 512 + (u.pn & 1) * 256;
        if (kind == 2 || kind == 3) {
            const float* g = (kind == 2) ? gq : gk;
            f32x4 gv[2][2], ks[2][2];
#pragma unroll
            for (int bj = 0; bj < 2; ++bj)
#pragma unroll
                for (int n = 0; n < 2; ++n) { gv[bj][n] = *(const f32x4*)(g + 32 * bj + 8 * fq + 4 * n); ks[bj][n] = (f32x4){0.f, 0.f, 0.f, 0.f}; }
#pragma unroll
            for (int ai = 0; ai < 2; ++ai)
#pragma unroll
                for (int m = 0; m < 4; ++m) {
                    float ss = 0.f;
#pragma unroll
                    for (int bj = 0; bj < 2; ++bj)
#pragma unroll
                        for (int n = 0; n < 2; ++n) { const f32x4 x = acc[ai][bj][m][n]; ss += (x[0] * x[0] + x[1] * x[1]) + (x[2] * x[2] + x[3] * x[3]); }
                    ss += __shfl_xor(ss, 16); ss += __shfl_xor(ss, 32);
                    const float rs = rsqrtf(ss * (1.f / 64.f) + EPS);
                    bf16_t* rowp = base + (size_t)(ai * HALF + m * 16) * 512 + wc * 64 + 8 * fq;
#pragma unroll
                    for (int bj = 0; bj < 2; ++bj) {
                        const f32x4 v0 = acc[ai][bj][m][0] * rs * gv[bj][0], v1 = acc[ai][bj][m][1] * rs * gv[bj][1];
                        ks[bj][0] += v0; ks[bj][1] += v1;
                        u32x4 w; w.x = cvt_pk_bf16(v0[0], v0[1]); w.y = cvt_pk_bf16(v0[2], v0[3]); w.z = cvt_pk_bf16(v1[0], v1[1]); w.w = cvt_pk_bf16(v1[2], v1[3]);
                        *(u32x4*)(rowp + 32 * bj) = w;
                    }
                }
            if (kind == 3) {
                float* km = kmean + ((size_t)((u.pm >> 4) * NH + (u.pn & 1) * 4 + wc) * NBLK + (u.pm & 15)) * DH + 8 * fq;
#pragma unroll
                for (int bj = 0; bj < 2; ++bj)
#pragma unroll
                    for (int n = 0; n < 2; ++n)
#pragma unroll
                        for (int r = 0; r < 4; ++r) {
                            float v = ks[bj][n][r];
                            v += __shfl_xor(v, 1); v += __shfl_xor(v, 2); v += __shfl_xor(v, 4); v += __shfl_xor(v, 8);
                            if (fr == 0) atomicAdd(km + 32 * bj + 4 * n + r, v * (1.f / 256.f));
                        }
            }
        } else {
#pragma unroll
            for (int ai = 0; ai < 2; ++ai)
#pragma unroll
                for (int m = 0; m < 4; ++m) {
                    bf16_t* rowp = base + (size_t)(ai * HALF + m * 16) * 512 + wc * 32 + 8 * fq;
#pragma unroll
                    for (int bj = 0; bj < 2; ++bj) {
                        f32x4 v0 = acc[ai][bj][m][0], v1 = acc[ai][bj][m][1];
                        if (kind <= 1) {
#pragma unroll
                            for (int r = 0; r < 4; ++r) { v0[r] = gelu_fast(v0[r]); v1[r] = gelu_fast(v1[r]); }
                        }
                        u32x4 w; w.x = cvt_pk_bf16(v0[0], v0[1]); w.y = cvt_pk_bf16(v0[2], v0[3]); w.z = cvt_pk_bf16(v1[0], v1[1]); w.w = cvt_pk_bf16(v1[2], v1[3]);
                        *(u32x4*)(rowp + bj * HALF) = w;
                    }
                }
        }
    }
};
struct EpiBf16Plain {
    static constexpr bool PERM = true;
    bf16_t* O; int ldc;
    __device__ __forceinline__ void operator()(const pg8::f32x4 (&acc)[2][2][4][2], const pg8::Unit& u, int wr, int wc, int fr, int fq) const {
        using namespace pg8;
        bf16_t* base = O + (size_t)(u.pm * 256 + wr * 64 + fr) * ldc + u.pn * 256 + wc * 32 + 8 * fq;
#pragma unroll
        for (int ai = 0; ai < 2; ++ai)
#pragma unroll
            for (int m = 0; m < 4; ++m) {
                bf16_t* rowp = base + (size_t)(ai * HALF + m * 16) * ldc;
#pragma unroll
                for (int bj = 0; bj < 2; ++bj) {
                    const f32x4 v0 = acc[ai][bj][m][0], v1 = acc[ai][bj][m][1];
                    u32x4 w; w.x = cvt_pk_bf16(v0[0], v0[1]); w.y = cvt_pk_bf16(v0[2], v0[3]); w.z = cvt_pk_bf16(v1[0], v1[1]); w.w = cvt_pk_bf16(v1[2], v1[3]);
                    *(u32x4*)(rowp + bj * HALF) = w;
                }
            }
    }
};

struct EpiOutProj {
    static constexpr bool PERM = true;
    const float* x; float* out; bf16_t* h1b; float* ssq;
    __device__ __forceinline__ void operator()(const pg8::f32x4 (&acc)[2][2][4][2], const pg8::Unit& u, int wr, int wc, int fr, int fq) const {
        using namespace pg8;
        const int row0 = u.pm * 256 + wr * 64 + fr, col0 = u.pn * 256 + wc * 32 + 8 * fq;
#pragma unroll
        for (int ai = 0; ai < 2; ++ai)
#pragma unroll
            for (int m = 0; m < 4; ++m) {
                const int row = row0 + ai * HALF + m * 16; const size_t off = (size_t)row * D_ + col0;
                float ss = 0.f;
#pragma unroll
                for (int bj = 0; bj < 2; ++bj) {
                    const f32x4 x0 = *(const f32x4*)(x + off + bj * HALF), x1 = *(const f32x4*)(x + off + bj * HALF + 4);
                    const f32x4 v0 = acc[ai][bj][m][0] + x0, v1 = acc[ai][bj][m][1] + x1;
                    *(f32x4*)(out + off + bj * HALF) = v0; *(f32x4*)(out + off + bj * HALF + 4) = v1;
                    u32x4 w; w.x = cvt_pk_bf16(v0[0], v0[1]); w.y = cvt_pk_bf16(v0[2], v0[3]); w.z = cvt_pk_bf16(v1[0], v1[1]); w.w = cvt_pk_bf16(v1[2], v1[3]);
                    *(u32x4*)(h1b + off + bj * HALF) = w;
                    ss += (v0[0] * v0[0] + v0[1] * v0[1]) + (v0[2] * v0[2] + v0[3] * v0[3]) + (v1[0] * v1[0] + v1[1] * v1[1]) + (v1[2] * v1[2] + v1[3] * v1[3]);
                }
                ss += __shfl_xor(ss, 16); ss += __shfl_xor(ss, 32);
                if (fq == 0) atomicAdd(ssq + row, ss);
                if (m & 1) asm volatile("" ::: "memory");
            }
    }
};
struct EpiPleGate {
    static constexpr bool PERM = true;
    float* out; const bf16_t* pw; const float* rstd2;
    __device__ __forceinline__ void operator()(const pg8::f32x4 (&acc)[2][2][4][2], const pg8::Unit& u, int wr, int wc, int fr, int fq) const {
        using namespace pg8;
        const int row0 = u.pm * 256 + wr * 64 + fr, col0 = u.pn * 256 + wc * 32 + 8 * fq;
#pragma unroll
        for (int ai = 0; ai < 2; ++ai)
#pragma unroll
            for (int m = 0; m < 4; ++m) {
                const int row = row0 + ai * HALF + m * 16; const size_t off = (size_t)row * D_ + col0;
                const float rs = rstd2[row] * -1.4426950408889634f;
#pragma unroll
                for (int bj = 0; bj < 2; ++bj) {
                    const f32x4 h0 = *(const f32x4*)(out + off + bj * HALF), h1 = *(const f32x4*)(out + off + bj * HALF + 4);
                    const u32x4 pv = *(const u32x4*)(pw + off + bj * HALF);
                    f32x4 v0, v1;
#pragma unroll
                    for (int r = 0; r < 4; ++r) {
                        const unsigned pw0 = (r & 1) ? (pv[r >> 1] & 0xffff0000u) : (pv[r >> 1] << 16);
                        const unsigned pw1 = (r & 1) ? (pv[2 + (r >> 1)] & 0xffff0000u) : (pv[2 + (r >> 1)] << 16);
                        const float s0 = __builtin_amdgcn_rcpf(1.f + __builtin_amdgcn_exp2f(acc[ai][bj][m][0][r] * rs));
                        const float s1 = __builtin_amdgcn_rcpf(1.f + __builtin_amdgcn_exp2f(acc[ai][bj][m][1][r] * rs));
                        v0[r] = h0[r] + __uint_as_float(pw0) * s0; v1[r] = h1[r] + __uint_as_float(pw1) * s1;
                    }
                    *(f32x4*)(out + off + bj * HALF) = v0; *(f32x4*)(out + off + bj * HALF + 4) = v1;
                }
                if (m & 1) asm volatile("" ::: "memory");
            }
    }
};
struct MoeOrder1 {
    static constexpr bool GATHER = true;
    const char* A; const char* Bt; const unsigned* ltok; const LAS int* pref; int G, c;
    __device__ bool next(int i, pg8::Unit& u) const {
        const int L = i * G + c; const int tot = pref[32];
        if (L >= 2 * tot) return false;
        const int tile = L >> 1; int e = 0;
#pragma unroll 1
        for (int j = 16; j > 0; j >>= 1) if (pref[e + j] <= tile) e += j;
        const int rt = tile - pref[e]; const int valid = min(256, pref[33 + e] - rt * 256);
        u.pm = tile; u.pn = L & 1; u.e = e; u.aux = valid | (rt << 16); return true;
    }
    __device__ __forceinline__ const char* a_base(const pg8::Unit&) const { return A; }
    __device__ __forceinline__ const char* b_base(const pg8::Unit& u) const { return Bt + ((size_t)u.e * 512 + u.pn * 256) * 1024 * 2; }
    __device__ __forceinline__ int row(const pg8::Unit& u, int r) const { const int valid = u.aux & 0xffff ? (u.aux & 0xffff) : 256; const int rr = r < valid ? r : valid - 1;
        return (int)(ltok[(size_t)u.e * LCAP + (u.aux >> 16) * 256 + rr] & 0x3fffu); }
    __device__ __forceinline__ void a_ready(const pg8::Unit&) const {}
    __device__ __forceinline__ void done(const pg8::Unit&) const {}
};
struct MoeOrder2 {
    static constexpr bool GATHER = false;
    const char* A; const char* Bt; const LAS int* pref; int G, c;
    __device__ bool next(int i, pg8::Unit& u) const {
        const int L = i * G + c; const int tot = pref[32];
        if (L >= 4 * tot) return false;
        const int tile = L >> 2; int e = 0;
#pragma unroll 1
        for (int j = 16; j > 0; j >>= 1) if (pref[e + j] <= tile) e += j;
        const int rt = tile - pref[e]; const int valid = min(256, pref[33 + e] - rt * 256);
        u.pm = tile; u.pn = L & 3; u.e = e; u.aux = valid | (rt << 16); return true;
    }
    __device__ __forceinline__ const char* a_base(const pg8::Unit& u) const { return A + (size_t)u.pm * 256 * 256 * 2; }
    __device__ __forceinline__ const char* b_base(const pg8::Unit& u) const { return Bt + ((size_t)u.e * 1024 + u.pn * 256) * 256 * 2; }
    __device__ __forceinline__ int row(const pg8::Unit&, int r) const { return r; }
    __device__ __forceinline__ void a_ready(const pg8::Unit&) const {}
    __device__ __forceinline__ void done(const pg8::Unit&) const {}
};
struct EpiMoe1 {
    static constexpr bool PERM = true;
    bf16_t* a2; const f32x2* lsc;
    __device__ __forceinline__ void operator()(const pg8::f32x4 (&acc)[2][2][4][2], const pg8::Unit& u, int wr, int wc, int fr, int fq) const {
        using namespace pg8;
        const int rt = u.aux >> 16;
#pragma unroll
        for (int ai = 0; ai < 2; ++ai)
#pragma unroll
            for (int m = 0; m < 4; ++m) {
                const int rl = ai * HALF + wr * 64 + m * 16 + fr;
                const f32x2 sc = lsc[(size_t)u.e * LCAP + rt * 256 + rl];
                const float rs = sc.x, cw = sc.y * sc.x;
                f32x4 o0, o1;
#pragma unroll
                for (int r = 0; r < 4; ++r) {
                    const float g0 = acc[ai][0][m][0][r] * rs, g1 = acc[ai][0][m][1][r] * rs;
                    o0[r] = g0 * __builtin_amdgcn_rcpf(1.f + __builtin_amdgcn_exp2f(-1.4426950408889634f * g0)) * acc[ai][1][m][0][r] * cw;
                    o1[r] = g1 * __builtin_amdgcn_rcpf(1.f + __builtin_amdgcn_exp2f(-1.4426950408889634f * g1)) * acc[ai][1][m][1][r] * cw;
                }
                u32x4 w; w.x = cvt_pk_bf16(o0[0], o0[1]); w.y = cvt_pk_bf16(o0[2], o0[3]); w.z = cvt_pk_bf16(o1[0], o1[1]); w.w = cvt_pk_bf16(o1[2], o1[3]);
                *(u32x4*)(a2 + ((size_t)u.pm * 256 + rl) * 256 + u.pn * 128 + wc * 32 + 8 * fq) = w;
            }
    }
};
struct EpiMoe2 {
    static constexpr bool PERM = true;
    bf16_t* ys; const unsigned* ltok;
    __device__ __forceinline__ void operator()(const pg8::f32x4 (&acc)[2][2][4][2], const pg8::Unit& u, int wr, int wc, int fr, int fq) const {
        using namespace pg8;
        const int rt = u.aux >> 16, valid = u.aux & 0xffff;
#pragma unroll
        for (int ai = 0; ai < 2; ++ai)
#pragma unroll
            for (int m = 0; m < 4; ++m) {
                const int rl = ai * HALF + wr * 64 + m * 16 + fr;
                if (rl < valid) {
                    const unsigned ts = ltok[(size_t)u.e * LCAP + rt * 256 + rl];
                    bf16_t* rowp = ys + ((size_t)(ts >> 16) * T_ + (ts & 0x3fffu)) * D_ + u.pn * 256 + wc * 32 + 8 * fq;
#pragma unroll
                    for (int bj = 0; bj < 2; ++bj) {
                        const f32x4 v0 = acc[ai][bj][m][0], v1 = acc[ai][bj][m][1];
                        u32x4 w; w.x = cvt_pk_bf16(v0[0], v0[1]); w.y = cvt_pk_bf16(v0[2], v0[3]); w.z = cvt_pk_bf16(v1[0], v1[1]); w.w = cvt_pk_bf16(v1[2], v1[3]);
                        *(u32x4*)(rowp + bj * HALF) = w;
                    }
                }
            }
    }
};

__device__ __forceinline__ float wave_sum_x(float v) {
#pragma unroll
    for (int o = 1; o < 64; o <<= 1) v += __shfl_xor(v, o);
    return v;
}
__device__ __forceinline__ unsigned pk2(float lo, float hi) { return f2bf(lo) | (f2bf(hi) << 16); }
__device__ __forceinline__ void p0_transpose_item(const float* W, int K, int N, bf16_t* WT, const float* gain, int mapmode, LAS float* scr, int item, int lane) {
    const int nblk = N / 32, kb = item / nblk, nb = item % nblk, k0 = 64 * kb, n0 = 32 * nb;
#pragma unroll 8
    for (int i = 0; i < 32; ++i) { const int kk = 2 * i + (lane >> 5); float v = W[(size_t)(k0 + kk) * N + n0 + (lane & 31)]; if (gain) v *= gain[k0 + kk]; scr[kk * 33 + (lane & 31)] = v; }
    LDS_WAIT(); asm volatile("" ::: "memory");
    int r0 = n0;
    if (mapmode == 1) { if (n0 >= 1024 && n0 < 2048) { const int cc = n0 & 255; r0 = (n0 & ~255) + 128 * ((cc >> 5) & 1) + 32 * (cc >> 6); } }
    else if (mapmode == 2) r0 = (n0 >> 7) * 256 + (n0 & 127);
    else if (mapmode == 3) r0 = (n0 >> 7) * 256 + 128 + (n0 & 127);
    const int c = lane & 7;
#pragma unroll
    for (int j = 0; j < 4; ++j) { const int n = (lane >> 3) + 8 * j; const LAS float* s = scr + (8 * c) * 33 + n;
        v4u o; o.x = pk2(s[0 * 33], s[1 * 33]); o.y = pk2(s[2 * 33], s[3 * 33]); o.z = pk2(s[4 * 33], s[5 * 33]); o.w = pk2(s[6 * 33], s[7 * 33]);
        *(GAS v4u*)(WT + (size_t)(r0 + n) * K + k0 + 8 * c) = o; }
    LDS_WAIT(); asm volatile("" ::: "memory");
}

typedef short s16x4 __attribute__((ext_vector_type(4)));
__device__ __forceinline__ s16x4 lds_tr16(LAS const void* p) { return __builtin_bit_cast(s16x4, __builtin_amdgcn_ds_read_tr16_b64_v4i16((LAS s16x4*)p)); }
__device__ __forceinline__ unsigned cvt_pk(float lo, float hi) { unsigned r; asm volatile("v_cvt_pk_bf16_f32 %0, %1, %2" : "=v"(r) : "v"(lo), "v"(hi)); return r; }

constexpr int MA_WS_STRIDE = 136, MA_VS_STRIDE = 144, MA_VS_OFF = 128 * MA_WS_STRIDE * 2;
__device__ __forceinline__ void mixa_load_w(LAS unsigned char* lds, const float* wsg, int tid) {
    for (int i = tid; i < 128 * 16; i += NWAVES * 64) {
        const int t = i >> 4, c = i & 15;
        const f32x4 a = *(const f32x4*)(wsg + t * 128 + 8 * c), b = *(const f32x4*)(wsg + t * 128 + 8 * c + 4);
        float v[8] = {a.x, a.y, a.z, a.w, b.x, b.y, b.z, b.w};
#pragma unroll
        for (int j = 0; j < 8; ++j) if (8 * c + j > t) v[j] = 0.f;
        v4u o; o.x = pk2(v[0], v[1]); o.y = pk2(v[2], v[3]); o.z = pk2(v[4], v[5]); o.w = pk2(v[6], v[7]);
        *(LAS v4u*)(lds + (t * MA_WS_STRIDE + 8 * c) * 2) = o;
    }
}
__device__ __forceinline__ void mixa_unit(LAS unsigned char* lds, int u, const bf16_t* UA, const bf16_t* VA, const float* g_v, const float* b_s, bf16_t* YA, int tid, int lane, int wave) {
    const int g = u & 3, bn = u >> 2, t0 = bn * 128, c0 = g * 128;
#pragma unroll
    for (int i = 0; i < 4; ++i) {
        const int s_ = (tid >> 4) + 32 * i, c = tid & 15;
        const v4u raw = *(const GAS v4u*)(VA + (size_t)(t0 + s_) * 512 + c0 + 8 * c);
        float v[8];
#pragma unroll
        for (int j = 0; j < 4; ++j) { v[2 * j] = __uint_as_float(raw[j] << 16); v[2 * j + 1] = __uint_as_float(raw[j] & 0xffff0000u); }
        float ss = 0.f;
#pragma unroll
        for (int j = 0; j < 8; ++j) ss += v[j] * v[j];
        ss += __shfl_xor(ss, 1); ss += __shfl_xor(ss, 2); ss += __shfl_xor(ss, 4); ss += __shfl_xor(ss, 8);
        const float rs = rsqrtf(ss * (1.f / 128.f) + EPS);
        v4u o; o.x = pk2(v[0] * rs, v[1] * rs); o.y = pk2(v[2] * rs, v[3] * rs); o.z = pk2(v[4] * rs, v[5] * rs); o.w = pk2(v[6] * rs, v[7] * rs);
        *(LAS v4u*)(lds + MA_VS_OFF + (s_ * MA_VS_STRIDE + 8 * c) * 2) = o;
    }
    LDS_WAIT(); __syncthreads();
    const int fr = lane & 15, fq = lane >> 4;
    bf16x8 vf[4];
#pragma unroll
    for (int ks = 0; ks < 4; ++ks) {
        LAS const unsigned char* p = lds + MA_VS_OFF + ((32 * ks + 8 * fq + (fr >> 2)) * MA_VS_STRIDE + 16 * wave + 4 * (lane & 3)) * 2;
        const s16x4 lo = lds_tr16(p), hi = lds_tr16(p + 4 * MA_VS_STRIDE * 2);
        vf[ks] = (bf16x8){lo[0], lo[1], lo[2], lo[3], hi[0], hi[1], hi[2], hi[3]};
    }
    const f32x4 gv = *(const f32x4*)(g_v + c0 + 16 * wave + 4 * fq);
#pragma unroll
    for (int j = 0; j < 8; ++j) {
        f32x4 acc = {0.f, 0.f, 0.f, 0.f};
#pragma unroll
        for (int ks = 0; ks < 4; ++ks) if (ks <= (j >> 1)) {
            const bf16x8 wf = *(const LAS bf16x8*)(lds + ((16 * j + fr) * MA_WS_STRIDE + 32 * ks + 8 * fq) * 2);
            acc = __builtin_amdgcn_mfma_f32_16x16x32_bf16(vf[ks], wf, acc, 0, 0, 0);
        }
        const int t = 16 * j + fr;
        const float bias = b_s[g * 128 + t];
        const size_t off = (size_t)(t0 + t) * 512 + c0 + 16 * wave + 4 * fq;
        const v2u ur = *(const GAS v2u*)(UA + off);
        v2u o;
        o.x = pk2(__uint_as_float(ur.x << 16) * (acc[0] * gv[0] + bias), __uint_as_float(ur.x & 0xffff0000u) * (acc[1] * gv[1] + bias));
        o.y = pk2(__uint_as_float(ur.y << 16) * (acc[2] * gv[2] + bias), __uint_as_float(ur.y & 0xffff0000u) * (acc[3] * gv[3] + bias));
        *(GAS v2u*)(YA + off) = o;
    }
    LDS_WAIT(); __syncthreads();
}

__device__ __forceinline__ void combine_row(int m, const bf16_t* YA, const bf16_t* OP, const float* LP, const float* g_out_a, const float* g_out_b, bf16_t* YCAT, int lane) {
    const int nsel = min((m & (S_ - 1)) >> 8, 3);
    const int h = lane >> 3;
    float o[8], l = 0.f;
#pragma unroll
    for (int j = 0; j < 8; ++j) o[j] = 0.f;
#pragma unroll
    for (int sl = 0; sl < 4; ++sl) {
        if (sl == 3 || sl < nsel) {
            const v4u raw = *(const GAS v4u*)(OP + ((size_t)sl * T_ + m) * 512 + 8 * lane);
#pragma unroll
            for (int j = 0; j < 4; ++j) { o[2 * j] += __uint_as_float(raw[j] << 16); o[2 * j + 1] += __uint_as_float(raw[j] & 0xffff0000u); }
            l += LP[((size_t)sl * T_ + m) * 8 + h];
        }
    }
    const float il = 1.f / l;
    float sb = 0.f;
#pragma unroll
    for (int j = 0; j < 8; ++j) { o[j] *= il; sb += o[j] * o[j]; }
    const v4u ar = *(const GAS v4u*)(YA + (size_t)m * 512 + 8 * lane);
    float a[8], sa = 0.f;
#pragma unroll
    for (int j = 0; j < 4; ++j) { a[2 * j] = __uint_as_float(ar[j] << 16); a[2 * j + 1] = __uint_as_float(ar[j] & 0xffff0000u); }
#pragma unroll
    for (int j = 0; j < 8; ++j) sa += a[j] * a[j];
    sa = wave_sum_x(sa); sb = wave_sum_x(sb);
    const float ra = rsqrtf(sa * (1.f / 512.f) + EPS), rb = rsqrtf(sb * (1.f / 512.f) + EPS);
    const f32x4 ga0 = *(const f32x4*)(g_out_a + 8 * lane), ga1 = *(const f32x4*)(g_out_a + 8 * lane + 4);
    const f32x4 gb0 = *(const f32x4*)(g_out_b + 8 * lane), gb1 = *(const f32x4*)(g_out_b + 8 * lane + 4);
    v4u wa, wb;
    wa.x = pk2(a[0] * ra * ga0[0], a[1] * ra * ga0[1]); wa.y = pk2(a[2] * ra * ga0[2], a[3] * ra * ga0[3]); wa.z = pk2(a[4] * ra * ga1[0], a[5] * ra * ga1[1]); wa.w = pk2(a[6] * ra * ga1[2], a[7] * ra * ga1[3]);
    wb.x = pk2(o[0] * rb * gb0[0], o[1] * rb * gb0[1]); wb.y = pk2(o[2] * rb * gb0[2], o[3] * rb * gb0[3]); wb.z = pk2(o[4] * rb * gb1[0], o[5] * rb * gb1[1]); wb.w = pk2(o[6] * rb * gb1[2], o[7] * rb * gb1[3]);
    *(GAS v4u*)(YCAT + (size_t)m * D_ + 8 * lane) = wa;
    *(GAS v4u*)(YCAT + (size_t)m * D_ + 512 + 8 * lane) = wb;
}

__device__ __forceinline__ void gate_task(int task, const bf16_t* QN, const float* KMEAN, unsigned* qcnt, unsigned short* QL, int lane) {
    const int qq = task & 3; int r = task >> 2; const int i = (r % 15) + 1; r /= 15; const int h = r & 7, b = r >> 3;
    const int s_ = i * 256 + qq * 64 + lane;
    const bf16_t* qp = QN + (size_t)(b * S_ + s_) * 512 + h * 64;
    float q[64];
#pragma unroll
    for (int c = 0; c < 8; ++c) { const v4u raw = *(const GAS v4u*)(qp + 8 * c);
#pragma unroll
        for (int j = 0; j < 4; ++j) { q[8 * c + 2 * j] = __uint_as_float(raw[j] << 16); q[8 * c + 2 * j + 1] = __uint_as_float(raw[j] & 0xffff0000u); } }
    float v0 = -INFINITY, v1 = -INFINITY, v2 = -INFINITY; int i0 = -1, i1 = -1, i2 = -1;
    const float* kmb = KMEAN + (size_t)((b * NH + h) * NBLK) * DH;
#pragma unroll 1
    for (int n = 0; n < i; ++n) {
        const float* km = kmb + n * DH;
        float sc = 0.f;
#pragma unroll
        for (int d = 0; d < 64; ++d) sc += q[d] * km[d];
        if (sc > v0) { v2 = v1; i2 = i1; v1 = v0; i1 = i0; v0 = sc; i0 = n; }
        else if (sc > v1) { v2 = v1; i2 = i1; v1 = sc; i1 = n; }
        else if (sc > v2) { v2 = sc; i2 = n; }
    }
    const int lbase = (b * NH + h) * NBLK;
#pragma unroll 1
    for (int n = 0; n < i; ++n) {
        const bool mine = (i0 == n) | (i1 == n) | (i2 == n);
        const unsigned long long mask = __ballot(mine);
        if (mask != 0ull) {
            unsigned base = 0;
            if (lane == 0) base = __hip_atomic_fetch_add(qcnt + lbase + n, (unsigned)__popcll(mask), RLX_AGENT);
            base = __builtin_amdgcn_readfirstlane(base);
            if (mine) {
                const int rank = __popcll(mask & ((1ull << lane) - 1ull));
                const int slot = (i0 == n) ? 0 : (i1 == n) ? 1 : 2;
                QL[(size_t)(lbase + n) * 4096 + base + rank] = (unsigned short)(s_ | (slot << 12));
            }
        }
    }
}

constexpr int AT_IPREF = XTRA_OFF + 2048, AT_ICNT = XTRA_OFF + 4352, AT_MYIT = XTRA_OFF + 6400;
__device__ __forceinline__ void attn_stage_tile(LAS unsigned char* dst, const bf16_t* src  , int wave, int lane) {
#pragma unroll
    for (int i = 0; i < 4; ++i) {
        const int key = 8 * (wave * 4 + i) + (lane >> 3), ch = (lane & 7) ^ (key & 7);
        __builtin_amdgcn_global_load_lds((const unsigned*)(src + (size_t)key * 512 + ch * 8), (LAS unsigned*)(dst + (wave * 4 + i) * 1024), 16, 0, 0);
    }
}
__device__ __forceinline__ bf16x8 scale_bf16x8(const v4u raw, float c) {
    v4u o;
#pragma unroll
    for (int j = 0; j < 4; ++j) o[j] = cvt_pk(__uint_as_float(raw[j] << 16) * c, __uint_as_float(raw[j] & 0xffff0000u) * c);
    return __builtin_bit_cast(bf16x8, o);
}
__device__ __forceinline__ void attn_phase(LAS unsigned char* L, const bf16_t* QN, const bf16_t* KN, const bf16_t* VB, const float* g_q, const float* g_k,
                                           const unsigned* qcnt, const unsigned short* QL, bf16_t* OP, float* LP, int vcu, int G, int tid, int lane, int wave) {
    LAS int* ipref = (LAS int*)(L + AT_IPREF); LAS int* icnt = (LAS int*)(L + AT_ICNT); LAS int* myit = (LAS int*)(L + AT_MYIT);
    {
        const int c = (int)__hip_atomic_load(qcnt + tid, RLX_AGENT);
        const int nit = 1 + ((c + 255) >> 8);
        int incl = nit;
#pragma unroll
        for (int o = 1; o < 64; o <<= 1) { const int v = __shfl_up(incl, o); if (lane >= o) incl += v; }
        icnt[tid] = c;
        if (lane == 63) myit[64 + wave] = incl;
        __syncthreads();
        int woff = 0;
        for (int w = 0; w < wave; ++w) woff += myit[64 + w];
        ipref[tid] = woff + incl - nit;
        if (tid == 511) ipref[512] = woff + incl;
        __syncthreads();
    }
    const int nitems = ipref[512];
    const int nmine = (nitems - vcu + G - 1) / G;
    if (tid < nmine && tid < 64) {
        const int Lx = tid * G + vcu; int t = 0;
#pragma unroll 1
        for (int j = 256; j > 0; j >>= 1) if (ipref[t + j] <= Lx) t += j;
        myit[tid] = (t << 8) | (Lx - ipref[t]);
    }
    __syncthreads();
    float gqm = 0.f, gkm = 0.f;
#pragma unroll 1
    for (int d = 0; d < 64; ++d) { gqm = fmaxf(gqm, fabsf(g_q[d])); gkm = fmaxf(gkm, fabsf(g_k[d])); }
    const float MREF = 11.6f * gqm * gkm + 0.125f;
    const float CS = 0.125f * 1.4426950408889634f;
    const int fr = lane & 15, fq = lane >> 4;
    const int nloop = nmine < 64 ? nmine : 64;
    if (nloop <= 0) return;
#define AT_DECODE(itw, E0, E1) do { const int t_ = (itw) >> 8, k_ = (itw) & 255; \
        if (k_ == 0) { const int ql = 32 * wave + fr; E0 = ((t_ & 15) * 256 + ql) | (3 << 12) | 0x8000; E1 = ((t_ & 15) * 256 + ql + 16) | (3 << 12) | 0x8000; } \
        else { const int base_ = (k_ - 1) * 256, nq_ = min(256, icnt[t_] - base_); const int q0 = 32 * wave + fr, q1 = q0 + 16; \
               const unsigned short* ql_ = QL + (size_t)t_ * 4096 + base_; \
               E0 = (int)ql_[q0 < nq_ ? q0 : 0] | (q0 < nq_ ? 0x8000 : 0); E1 = (int)ql_[q1 < nq_ ? q1 : 0] | (q1 < nq_ ? 0x8000 : 0); } } while (0)
#define AT_QLOAD(itw, E0, E1, QR) do { const int t_ = (itw) >> 8; const int b_ = t_ >> 7, h_ = (t_ >> 4) & 7; \
        const bf16_t* q0_ = QN + (size_t)(b_ * S_ + ((E0) & 0xfff)) * 512 + h_ * 64 + 8 * fq; const bf16_t* q1_ = QN + (size_t)(b_ * S_ + ((E1) & 0xfff)) * 512 + h_ * 64 + 8 * fq; \
        QR[0] = *(const GAS v4u*)(q0_); QR[1] = *(const GAS v4u*)(q0_ + 32); QR[2] = *(const GAS v4u*)(q1_); QR[3] = *(const GAS v4u*)(q1_ + 32); } while (0)
#define AT_STAGE(itw, bufi) do { const int t_ = (itw) >> 8; const int b_ = t_ >> 7, h_ = (t_ >> 4) & 7, j_ = t_ & 15; const size_t r0_ = (size_t)(b_ * S_ + j_ * 256) * 512 + h_ * 64; \
        attn_stage_tile(L + (bufi) * 65536, KN + r0_, wave, lane); attn_stage_tile(L + (bufi) * 65536 + 32768, VB + r0_, wave, lane); } while (0)
    int it0 = myit[0];
    int ec0, ec1, en0 = 0, en1 = 0;
    v4u qn[4];
    AT_STAGE(it0, 0);
    AT_DECODE(it0, ec0, ec1);
    AT_QLOAD(it0, ec0, ec1, qn);
    if (nloop > 1) { const int it1 = myit[1]; AT_DECODE(it1, en0, en1); }
    for (int it = 0; it < nloop; ++it) {
        const int itw = myit[it];
        const int t_ = itw >> 8, own = ((itw & 255) == 0);
        const int h_ = (t_ >> 4) & 7;
        asm volatile("s_waitcnt vmcnt(0) lgkmcnt(0)" ::: "memory"); __builtin_amdgcn_s_barrier(); asm volatile("" ::: "memory");
        bf16x8 qf[2][2];
        qf[0][0] = scale_bf16x8(qn[0], CS); qf[0][1] = scale_bf16x8(qn[1], CS); qf[1][0] = scale_bf16x8(qn[2], CS); qf[1][1] = scale_bf16x8(qn[3], CS);
        int ex0 = 0, ex1 = 0;
        if (it + 1 < nloop) {
            const int itn = myit[it + 1];
            AT_STAGE(itn, (it + 1) & 1);
            AT_QLOAD(itn, en0, en1, qn);
            if (it + 2 < nloop) { const int itn2 = myit[it + 2]; AT_DECODE(itn2, ex0, ex1); }
        }
        asm volatile("" ::: "memory");
        LAS const unsigned char* Kb = L + (it & 1) * 65536; LAS const unsigned char* Vb = Kb + 32768;
        float lsum0 = 0.f, lsum1 = 0.f;
        f32x4 O[4][2];
#pragma unroll
        for (int dt = 0; dt < 4; ++dt) { O[dt][0] = (f32x4){0.f, 0.f, 0.f, 0.f}; O[dt][1] = (f32x4){0.f, 0.f, 0.f, 0.f}; }
        const int ql0 = (ec0 & 0xff), ql1 = (ec1 & 0xff);
#pragma unroll 1
        for (int hf = 0; hf < 2; ++hf) {
            f32x4 S[8][2];
#pragma unroll
            for (int kt = 0; kt < 8; ++kt) {
                const int key = 128 * hf + 16 * kt + fr;
                const bf16x8 k0 = *(const LAS bf16x8*)(Kb + key * 128 + ((fq ^ (key & 7)) << 4));
                const bf16x8 k1 = *(const LAS bf16x8*)(Kb + key * 128 + (((4 + fq) ^ (key & 7)) << 4));
#pragma unroll
                for (int qi = 0; qi < 2; ++qi) {
                    f32x4 a = {-MREF, -MREF, -MREF, -MREF};
                    a = __builtin_amdgcn_mfma_f32_16x16x32_bf16(k0, qf[qi][0], a, 0, 0, 0);
                    a = __builtin_amdgcn_mfma_f32_16x16x32_bf16(k1, qf[qi][1], a, 0, 0, 0);
                    S[kt][qi] = a;
                }
            }
            if (own) {
#pragma unroll
                for (int kt = 0; kt < 8; ++kt)
#pragma unroll
                    for (int r = 0; r < 4; ++r) { const int keyl = 128 * hf + 16 * kt + 4 * fq + r;
                        if (keyl > ql0) S[kt][0][r] = -INFINITY;
                        if (keyl > ql1) S[kt][1][r] = -INFINITY; }
            }
#pragma unroll
            for (int kt = 0; kt < 8; ++kt)
#pragma unroll
                for (int r = 0; r < 4; ++r) { const float p0 = __builtin_amdgcn_exp2f(S[kt][0][r]), p1 = __builtin_amdgcn_exp2f(S[kt][1][r]); S[kt][0][r] = p0; S[kt][1][r] = p1; lsum0 += p0; lsum1 += p1; }
#pragma unroll
            for (int s2 = 0; s2 < 4; ++s2) {
                bf16x8 pf[2];
#pragma unroll
                for (int qi = 0; qi < 2; ++qi) { v4u w; w.x = cvt_pk(S[2 * s2][qi][0], S[2 * s2][qi][1]); w.y = cvt_pk(S[2 * s2][qi][2], S[2 * s2][qi][3]);
                    w.z = cvt_pk(S[2 * s2 + 1][qi][0], S[2 * s2 + 1][qi][1]); w.w = cvt_pk(S[2 * s2 + 1][qi][2], S[2 * s2 + 1][qi][3]); pf[qi] = __builtin_bit_cast(bf16x8, w); }
                const int keyb = 128 * hf + 32 * s2 + 4 * fq + (fr >> 2);
#pragma unroll
                for (int dt = 0; dt < 4; ++dt) {
                    const int ch = 2 * dt + ((lane & 3) >> 1);
                    const s16x4 lo = lds_tr16(Vb + keyb * 128 + ((ch ^ (keyb & 7)) << 4) + (lane & 1) * 8);
                    const s16x4 hi = lds_tr16(Vb + (keyb + 16) * 128 + ((ch ^ ((keyb + 16) & 7)) << 4) + (lane & 1) * 8);
                    const bf16x8 vf = (bf16x8){lo[0], lo[1], lo[2], lo[3], hi[0], hi[1], hi[2], hi[3]};
                    O[dt][0] = __builtin_amdgcn_mfma_f32_16x16x32_bf16(vf, pf[0], O[dt][0], 0, 0, 0);
                    O[dt][1] = __builtin_amdgcn_mfma_f32_16x16x32_bf16(vf, pf[1], O[dt][1], 0, 0, 0);
                }
            }
        }
        lsum0 += __shfl_xor(lsum0, 16); lsum0 += __shfl_xor(lsum0, 32); lsum1 += __shfl_xor(lsum1, 16); lsum1 += __shfl_xor(lsum1, 32);
        {
            const int b_ = t_ >> 7;
#pragma unroll
            for (int qi = 0; qi < 2; ++qi) {
                const int e = qi ? ec1 : ec0;
                if (e & 0x8000) {
                    const size_t row = (size_t)((e >> 12) & 3) * T_ + (size_t)(b_ * S_ + (e & 0xfff));
                    bf16_t* op = OP + row * 512 + h_ * 64 + 4 * fq;
#pragma unroll
                    for (int dt = 0; dt < 4; ++dt) { v2u w; w.x = cvt_pk(O[dt][qi][0], O[dt][qi][1]); w.y = cvt_pk(O[dt][qi][2], O[dt][qi][3]); *(GAS v2u*)(op + 16 * dt) = w; }
                    if (fq == 0) LP[row * 8 + h_] = qi ? lsum1 : lsum0;
                }
            }
        }
        ec0 = en0; ec1 = en1; en0 = ex0; en1 = ex1;
    }
    asm volatile("s_waitcnt vmcnt(0) lgkmcnt(0)" ::: "memory"); __builtin_amdgcn_s_barrier();
#undef AT_DECODE
#undef AT_QLOAD
#undef AT_STAGE
}

__global__ void __launch_bounds__(NWAVES * 64, 2) mk_fwd(Args args) {
    extern __shared__ __attribute__((aligned(16))) unsigned char lds[];
    LAS unsigned char* L = (LAS unsigned char*)lds;
    volatile LAS unsigned* MISC = (volatile LAS unsigned*)(L + MISC_OFF);
    const int tid = threadIdx.x, lane = tid & 63, wave = __builtin_amdgcn_readfirstlane(tid >> 6);
    const int G = gridDim.x; const int bx = blockIdx.x;
    const int vcu = (G % 8 == 0) ? (bx % 8) * (G / 8) + bx / 8 : bx;
    unsigned char* ws = args.ws;
    gu32* ctl = (gu32*)(ws + WS_CTL);
    const float* x = args.in[0]; const float* p_in = args.in[1]; const float* g_mix = args.in[2]; const float* w_in = args.in[3];
    const float* g_q = args.in[7]; const float* g_k = args.in[8];
    const float* w_out = args.in[11]; const float* g_ffn = args.in[12];
    const float* w_gate_e = args.in[15]; const float* w_up_e = args.in[16]; const float* w_down_e = args.in[17];
    const float* g_ple = args.in[18]; const float* w_ple = args.in[19]; const float* w_ple_gate = args.in[20];
    bf16_t* WIN = (bf16_t*)(ws + WS_WIN); bf16_t* WOUT = (bf16_t*)(ws + WS_WOUT); bf16_t* WGU = (bf16_t*)(ws + WS_WGU); bf16_t* WD = (bf16_t*)(ws + WS_WD);
    bf16_t* WPLE = (bf16_t*)(ws + WS_WPLE); bf16_t* WPG = (bf16_t*)(ws + WS_WPG);
    bf16_t* XN = (bf16_t*)(ws + WS_XN); bf16_t* PB = (bf16_t*)(ws + WS_PB); bf16_t* ARR0 = (bf16_t*)(ws + WS_ARR); bf16_t* PW = (bf16_t*)(ws + WS_PW);
    float* KMEAN = (float*)(ws + WS_KMEAN); float* SSQ1 = (float*)(ws + WS_SSQ1);
    const float* w_group = args.in[13]; const float* w_expert = args.in[14];
    bf16_t* YCAT = (bf16_t*)(ws + WS_YCAT); bf16_t* H1B = (bf16_t*)(ws + WS_H1B); bf16_t* A2 = (bf16_t*)(ws + WS_A2); bf16_t* YS = (bf16_t*)(ws + WS_YS); bf16_t* H2B = (bf16_t*)(ws + WS_H2B);
    unsigned* LTOK = (unsigned*)(ws + WS_LTOK); f32x2* LSC = (f32x2*)(ws + WS_LSC); float* RSTD2 = (float*)(ws + WS_RSTD2); bf16_t* WR = (bf16_t*)(ws + WS_WR);
    float* OUT = args.out;
    const float* g_v_a = args.in[4]; const float* w_s = args.in[5]; const float* b_s = args.in[6]; const float* g_out_a = args.in[9]; const float* g_out_b = args.in[10];
    unsigned short* QLp = (unsigned short*)(ws + WS_QL);
    bf16_t* YA = (bf16_t*)(ws + WS_YA); bf16_t* OP = (bf16_t*)args.out; float* LP = (float*)(ws + WS_LP);

    for (int u = tid; u < (LDS_BYTES - LDSCTL_OFF) / 4; u += NWAVES * 64) ((LAS unsigned*)(L + LDSCTL_OFF))[u] = 0u;
    __syncthreads();
    const int lo = args.ph_lo, hi = args.ph_hi;
    const bool multi = (hi - lo) > 1;
    XcdBarrier bar; bar.bar = (unsigned*)(ctl + CW_BAR); bar.x = 0; bar.st = nullptr;
    if (multi) bar = xcd_barrier_post((unsigned*)(ctl + CW_BAR), MISC + 8);
#define IN(k) (lo <= (k) && (k) < hi)
#define SEAM(k) do { if (IN(k) && IN((k) + 1)) xcd_barrier(bar); } while (0)

    if (IN(0)) {
        LAS float* scr = (LAS float*)(L + RING_OFF + wave * 16384);
        const int gw = vcu * NWAVES + wave, NGW = G * NWAVES;
        constexpr int I_IN = 16 * 80, I_OUT = 16 * 32, I_G = 32 * 16 * 8, I_U = I_G, I_D = 32 * 4 * 32, I_PLE = 4 * 32, I_PG = 16 * 32;
        constexpr int NITEMS = I_IN + I_OUT + I_G + I_U + I_D + I_PLE + I_PG;
        for (int it = gw; it < NITEMS; it += NGW) {
            int r = it;
            if (r < I_IN) { p0_transpose_item(w_in, 1024, 2560, WIN, g_mix, 1, scr, r, lane); continue; } r -= I_IN;
            if (r < I_OUT) { p0_transpose_item(w_out, 1024, 1024, WOUT, nullptr, 0, scr, r, lane); continue; } r -= I_OUT;
            if (r < I_G) { const int e = r >> 7; p0_transpose_item(w_gate_e + (size_t)e * 1024 * 256, 1024, 256, WGU + (size_t)e * 512 * 1024, g_ffn, 2, scr, r & 127, lane); continue; } r -= I_G;
            if (r < I_U) { const int e = r >> 7; p0_transpose_item(w_up_e + (size_t)e * 1024 * 256, 1024, 256, WGU + (size_t)e * 512 * 1024, g_ffn, 3, scr, r & 127, lane); continue; } r -= I_U;
            if (r < I_D) { const int e = r >> 7; p0_transpose_item(w_down_e + (size_t)e * 256 * 1024, 256, 1024, WD + (size_t)e * 1024 * 256, nullptr, 0, scr, r & 127, lane); continue; } r -= I_D;
            if (r < I_PLE) { p0_transpose_item(w_ple, 256, 1024, WPLE, nullptr, 0, scr, r, lane); continue; } r -= I_PLE;
            p0_transpose_item(w_ple_gate, 1024, 1024, WPG, g_ple, 0, scr, r, lane);
        }
        for (int m = gw; m < T_; m += NGW) {
            const GAS f32x4* xr = (const GAS f32x4*)(x + (size_t)m * D_) + lane;
            f32x4 v[4]; float s = 0.f;
#pragma unroll
            for (int j = 0; j < 4; ++j) { v[j] = xr[64 * j]; s += (v[j].x * v[j].x + v[j].y * v[j].y) + (v[j].z * v[j].z + v[j].w * v[j].w); }
            const float rstd = rsqrtf(wave_sum_x(s) * (1.f / D_) + EPS);
            GAS v2u* o8 = (GAS v2u*)(XN + (size_t)m * D_) + lane;
#pragma unroll
            for (int j = 0; j < 4; ++j) { v2u w; w.x = pk2(v[j].x * rstd, v[j].y * rstd); w.y = pk2(v[j].z * rstd, v[j].w * rstd); o8[64 * j] = w; }
        }
        for (int m = gw; m < T_; m += NGW) {
            const f32x4 v = ((const GAS f32x4*)(p_in + (size_t)m * DPLE))[lane];
            v2u w; w.x = pk2(v.x, v.y); w.y = pk2(v.z, v.w);
            ((GAS v2u*)(PB + (size_t)m * DPLE))[lane] = w;
        }
        for (int i = gw * 64 + lane; i < 48 * 1024; i += NGW * 64) {
            const int jj = i >> 10, k = i & 1023; float v = 0.f;
            if (jj < 4) v = w_group[k * 4 + jj] * g_ffn[k];
            else if (jj >= 16) { const int hi = (jj >= 32), g = ((jj - 16) & 15) >> 2, r = jj & 3; v = w_expert[k * 32 + g * 8 + hi * 4 + r] * g_ffn[k]; }
            WR[i] = (bf16_t)f2bf(v);
        }
    }
    SEAM(0);
    if (IN(1)) {
        { pg8::StaticOrder S; S.init(XN, WIN, T_, DIN, D_, G, bx);
          EpiInProj E{ARR0, KMEAN, g_q, g_k};
          pg8::gemm_phase<EpiInProj, pg8::StaticOrder, true>(L + RING_OFF, D_, S, E); }
        { pg8::StaticOrder S; S.init(PB, WPLE, T_, D_, DPLE, G, bx);
          EpiBf16Plain E{PW, D_};
          pg8::gemm_phase<EpiBf16Plain, pg8::StaticOrder, true>(L + RING_OFF, DPLE, S, E); }
    }
    SEAM(1);
    if (IN(2)) {
        { const int gw = vcu * NWAVES + wave, NGW = G * NWAVES;
          for (int task = gw; task < NB_ * NH * 15 * 4; task += NGW) gate_task(task, ARR0 + 2 * ARR, KMEAN, (unsigned*)ctl + CW_QCNT, QLp, lane); }
        int curg = -1;
        for (int u = vcu; u < 512; u += G) {
            const int g = u & 3;
            if (g != curg) { mixa_load_w(L + RING_OFF, w_s + (size_t)g * 128 * 128, tid); curg = g; }
            mixa_unit(L + RING_OFF, u, ARR0, ARR0 + ARR, g_v_a, b_s, YA, tid, lane, wave);
        }
    }
    SEAM(2);
    if (IN(3)) attn_phase(L, ARR0 + 2 * ARR, ARR0 + 3 * ARR, ARR0 + 4 * ARR, g_q, g_k, (const unsigned*)ctl + CW_QCNT, QLp, OP, LP, vcu, G, tid, lane, wave);
    SEAM(3);
    if (IN(PH_COMB)) {
        const int gw = vcu * NWAVES + wave, NGW = G * NWAVES;
        for (int m = gw; m < T_; m += NGW) combine_row(m, YA, OP, LP, g_out_a, g_out_b, YCAT, lane);
    }
    SEAM(PH_COMB);
    if (IN(5)) {
        pg8::StaticOrder S; S.init(YCAT, WOUT, T_, D_, D_, G, bx);
        EpiOutProj E{x, OUT, H1B, SSQ1};
        pg8::gemm_phase<EpiOutProj, pg8::StaticOrder, true>(L + RING_OFF, D_, S, E);
    }
    SEAM(5);
    if (IN(6)) {
        LAS int* hist = (LAS int*)(L + XTRA_OFF); LAS int* hbase = hist + 32;
        for (int chunk = vcu; chunk < T_ / 64; chunk += G) {
            if (tid < 32) hist[tid] = 0;
            __syncthreads();
            int e1 = -1, e2 = -1, rk1 = 0, rk2 = 0, tok = 0; float c1 = 0.f, c2 = 0.f, rs1 = 0.f;
            if (wave < 4) {
                const int fr = lane & 15, fq = lane >> 4;
                const int t0 = chunk * 64 + wave * 16;
                f32x4 d0 = {0.f, 0.f, 0.f, 0.f}, d1 = d0, d2 = d0;
                const bf16_t* ap = H1B + (size_t)(t0 + fr) * D_ + 8 * fq;
                const bf16_t* bp = WR + (size_t)fr * D_ + 8 * fq;
#pragma unroll 4
                for (int ks = 0; ks < 32; ++ks) {
                    const bf16x8 hf = *(const bf16x8*)(ap + ks * 32);
                    const bf16x8 w0 = *(const bf16x8*)(bp + ks * 32), w1 = *(const bf16x8*)(bp + 16 * D_ + ks * 32), w2 = *(const bf16x8*)(bp + 32 * D_ + ks * 32);
                    d0 = __builtin_amdgcn_mfma_f32_16x16x32_bf16(w0, hf, d0, 0, 0, 0);
                    d1 = __builtin_amdgcn_mfma_f32_16x16x32_bf16(w1, hf, d1, 0, 0, 0);
                    d2 = __builtin_amdgcn_mfma_f32_16x16x32_bf16(w2, hf, d2, 0, 0, 0);
                }
                tok = t0 + fr;
                rs1 = rsqrtf(SSQ1[tok] * (1.f / D_) + EPS);
                float gl[4];
#pragma unroll
                for (int r = 0; r < 4; ++r) gl[r] = __shfl(d0[r], fr) * rs1;
                int gs = 0; float gm = gl[0];
#pragma unroll
                for (int r = 1; r < 4; ++r) if (gl[r] > gm) { gm = gl[r]; gs = r; }
                float den = 0.f;
#pragma unroll
                for (int r = 0; r < 4; ++r) den += __expf(gl[r] - gm);
                const float pg = 1.f / den;
                float el[8];
#pragma unroll
                for (int r = 0; r < 4; ++r) { el[r] = d1[r] * rs1; el[4 + r] = d2[r] * rs1; }
                int a1 = 0; float m1 = el[0];
#pragma unroll
                for (int j = 1; j < 8; ++j) if (el[j] > m1) { m1 = el[j]; a1 = j; }
                int a2 = -1; float m2 = -INFINITY;
#pragma unroll
                for (int j = 0; j < 8; ++j) if (j != a1 && el[j] > m2) { m2 = el[j]; a2 = j; }
                const float ex2 = __expf(m2 - m1);
                if (fq == gs) {
                    e1 = gs * 8 + a1; e2 = gs * 8 + a2; c1 = pg / (1.f + ex2); c2 = pg * ex2 / (1.f + ex2);
                    rk1 = __hip_atomic_fetch_add(hist + e1, 1, __ATOMIC_RELAXED, __HIP_MEMORY_SCOPE_WORKGROUP);
                    rk2 = __hip_atomic_fetch_add(hist + e2, 1, __ATOMIC_RELAXED, __HIP_MEMORY_SCOPE_WORKGROUP);
                }
            }
            __syncthreads();
            if (tid < 32) { const int hc = hist[tid]; hbase[tid] = hc > 0 ? (int)__hip_atomic_fetch_add((unsigned*)ctl + CW_CNT + 64 * tid, (unsigned)hc, RLX_AGENT) : 0; }
            __syncthreads();
            if (e1 >= 0) {
                const int p1 = hbase[e1] + rk1, p2 = hbase[e2] + rk2;
                LTOK[(size_t)e1 * LCAP + p1] = (unsigned)tok; LSC[(size_t)e1 * LCAP + p1] = (f32x2){rs1, c1};
                LTOK[(size_t)e2 * LCAP + p2] = (unsigned)tok | 0x10000u; LSC[(size_t)e2 * LCAP + p2] = (f32x2){rs1, c2};
            }
            __syncthreads();
        }
    }
    SEAM(6);
    if (IN(7) || IN(8)) {
        LAS int* pref = (LAS int*)(L + XTRA_OFF + 1024);
        __syncthreads();
        if (tid < 32) pref[33 + tid] = (int)__hip_atomic_load((unsigned*)ctl + CW_CNT + 64 * tid, RLX_AGENT);
        __syncthreads();
        if (tid == 0) { int acc_ = 0; for (int e = 0; e < 32; ++e) { pref[e] = acc_; acc_ += (pref[33 + e] + 255) >> 8; } pref[32] = acc_; }
        __syncthreads();
    }
    if (IN(7)) {
        const LAS int* pref = (const LAS int*)(L + XTRA_OFF + 1024);
        MoeOrder1 S{(const char*)H1B, (const char*)WGU, LTOK, pref, G, bx};
        EpiMoe1 E{A2, LSC};
        pg8::gemm_phase<EpiMoe1, MoeOrder1, true>(L + RING_OFF, D_, S, E);
    }
    SEAM(7);
    if (IN(8)) {
        const LAS int* pref = (const LAS int*)(L + XTRA_OFF + 1024);
        MoeOrder2 S{(const char*)A2, (const char*)WD, pref, G, bx};
        EpiMoe2 E{YS, LTOK};
        pg8::gemm_phase<EpiMoe2, MoeOrder2, true>(L + RING_OFF, DFF, S, E);
    }
    SEAM(8);
    if (IN(9)) {
        const int gw = vcu * NWAVES + wave, NGW = G * NWAVES;
        for (int m = gw; m < T_; m += NGW) {
            GAS f32x4* hr = (GAS f32x4*)(OUT + (size_t)m * D_) + lane;
            const GAS v2u* y0 = (const GAS v2u*)(YS + (size_t)m * D_) + lane; const GAS v2u* y1 = (const GAS v2u*)(YS + (size_t)(T_ + m) * D_) + lane;
            GAS v2u* hb = (GAS v2u*)(H2B + (size_t)m * D_) + lane;
            float s = 0.f;
#pragma unroll
            for (int j = 0; j < 4; ++j) {
                f32x4 v = hr[64 * j]; const v2u a = y0[64 * j], b = y1[64 * j];
                v.x += __uint_as_float(a.x << 16) + __uint_as_float(b.x << 16); v.y += __uint_as_float(a.x & 0xffff0000u) + __uint_as_float(b.x & 0xffff0000u);
                v.z += __uint_as_float(a.y << 16) + __uint_as_float(b.y << 16); v.w += __uint_as_float(a.y & 0xffff0000u) + __uint_as_float(b.y & 0xffff0000u);
                hr[64 * j] = v; v2u w; w.x = pk2(v.x, v.y); w.y = pk2(v.z, v.w); hb[64 * j] = w;
                s += (v.x * v.x + v.y * v.y) + (v.z * v.z + v.w * v.w);
            }
            s = wave_sum_x(s);
            if (lane == 0) RSTD2[m] = rsqrtf(s * (1.f / D_) + EPS);
        }
    }
    SEAM(9);
    if (IN(10)) {
        pg8::StaticOrder S; S.init(H2B, WPG, T_, D_, D_, G, bx);
        EpiPleGate E{OUT, PW, RSTD2};
        pg8::gemm_phase<EpiPleGate, pg8::StaticOrder, true>(L + RING_OFF, D_, S, E);
    }
#undef IN
#undef SEAM
}

extern "C" void kernel_launch(void* const* d_in, const int* in_sizes, int n_in, void* d_out, int out_size, void* d_ws, size_t ws_size, hipStream_t stream) {
    using namespace orc;
    const float* x = (const float*)d_in[0];
    const float* p = (const float*)d_in[1];
    const float* g_mix = (const float*)d_in[2];
    const float* w_in = (const float*)d_in[3];
    const float* g_v_a = (const float*)d_in[4];
    const float* w_s = (const float*)d_in[5];
    const float* b_s = (const float*)d_in[6];
    const float* g_q = (const float*)d_in[7];
    const float* g_k = (const float*)d_in[8];
    const float* g_out_a = (const float*)d_in[9];
    const float* g_out_b = (const float*)d_in[10];
    const float* w_out = (const float*)d_in[11];
    const float* g_ffn = (const float*)d_in[12];
    const float* w_group = (const float*)d_in[13];
    const float* w_expert = (const float*)d_in[14];
    const float* w_gate_e = (const float*)d_in[15];
    const float* w_up_e = (const float*)d_in[16];
    const float* w_down_e = (const float*)d_in[17];
    const float* g_ple = (const float*)d_in[18];
    const float* w_ple = (const float*)d_in[19];
    const float* w_ple_gate = (const float*)d_in[20];
    float* out = (float*)d_out;
    char* ws = (char*)d_ws;
    (void)g_mix; (void)w_in; (void)p; (void)w_ple; (void)w_out; (void)g_ffn; (void)w_group; (void)w_expert; (void)w_gate_e; (void)w_up_e; (void)w_down_e; (void)g_ple; (void)w_ple_gate; (void)x;

    static int grid = 0;
    if (grid == 0) {
        int dev = 0, cus = 0, per_cu = 0;
        if (hipGetDevice(&dev) != hipSuccess || hipDeviceGetAttribute(&cus, hipDeviceAttributeMultiprocessorCount, dev) != hipSuccess) { fprintf(stderr, "kernel_launch: device query failed\n"); grid = -1; return; }
        if (hipFuncSetAttribute((const void*)mk_fwd, hipFuncAttributeMaxDynamicSharedMemorySize, LDS_BYTES) != hipSuccess) { fprintf(stderr, "kernel_launch: hipFuncSetAttribute(%d) failed\n", LDS_BYTES); grid = -1; return; }
        if (hipOccupancyMaxActiveBlocksPerMultiprocessor(&per_cu, (const void*)mk_fwd, NWAVES * 64, LDS_BYTES) != hipSuccess || per_cu < 1) { fprintf(stderr, "kernel_launch: occupancy query says %d\n", per_cu); per_cu = 1; }
        (void)hipGetLastError();
        grid = cus * 1;
        if (ws_size < 256 * MiB) { fprintf(stderr, "kernel_launch: workspace too small\n"); grid = -1; return; }
    }
    if (grid < 0) return;
    hipMemsetAsync(ws + WS_CTL, 0, ZERO_BYTES, stream);
    Args a{};
    for (int i = 0; i < 21; ++i) a.in[i] = (const float*)d_in[i];
    a.out = out; a.ws = (unsigned char*)d_ws; a.li = 0; a.pad = 0;

    float* rstd_va = (float*)(ws + WS_ORC);
    int* sel = (int*)(ws + WS_ORC + 512 * 1024);
    Route* route = (Route*)(ws + WS_ORC + 2 * MiB);
    float* rstd_h = (float*)(ws + WS_ORC + 2 * MiB + 512 * 1024);
    float* rstd_h2 = (float*)(ws + WS_ORC + 3 * MiB);
    float* kmean = (float*)(ws + WS_KMEAN);
    const bf16_t* ua = (const bf16_t*)(ws + WS_ARR); const bf16_t* va = ua + ARR; const bf16_t* qn = ua + 2 * ARR; const bf16_t* kn = ua + 3 * ARR; const bf16_t* vb = ua + 4 * ARR;
    const bf16_t* pwb = (const bf16_t*)(ws + WS_PW);

#ifndef ONE_LAUNCH
#define ONE_LAUNCH 1
#endif
#ifndef LEVEL
#define LEVEL 4
#endif
#ifndef ATT_ORACLE
#define ATT_ORACLE 0
#endif
#define LAUNCH_PH(lo_, hi_) do { a.ph_lo = (lo_); a.ph_hi = (hi_); hipLaunchKernelGGL(mk_fwd, dim3(grid), dim3(NWAVES * 64), LDS_BYTES, stream, a); } while (0)
#if ONE_LAUNCH
    LAUNCH_PH(0, 11);
    (void)ua; (void)va; (void)qn; (void)kn; (void)vb; (void)sel; (void)kmean; (void)rstd_va; (void)route; (void)rstd_h; (void)rstd_h2; (void)pwb; (void)g_v_a; (void)w_s; (void)b_s; (void)g_q; (void)g_k; (void)g_out_a; (void)g_out_b;
#else
    LAUNCH_PH(0, 1); LAUNCH_PH(1, 2);
    LAUNCH_PH(2, 3);
#if ATT_ORACLE
    bf16_t* op = (bf16_t*)out; float* lp = (float*)(ws + WS_LP);
    hipMemsetAsync(op, 0, (size_t)3 * T_ * 512 * 2, stream);
    hipMemsetAsync(lp, 0, (size_t)3 * T_ * 8 * 4, stream);
    k_fill<<<T_ * 8 / 256, 256, 0, stream>>>(lp + (size_t)3 * T_ * 8, 1.0f, T_ * 8, 0);
    k_gate<bf16_t><<<T_ * NH / 256, 256, 0, stream>>>(qn, kmean, sel);
    k_attn<bf16_t, bf16_t><<<T_ * NH, 256, 0, stream>>>(qn, kn, vb, sel, op + (size_t)3 * T_ * 512, 512, 0);
#else
    LAUNCH_PH(3, 4);
    (void)qn; (void)kn; (void)vb; (void)sel; (void)kmean;
#endif
    LAUNCH_PH(4, 5);
    (void)ua; (void)va; (void)rstd_va; (void)g_v_a; (void)w_s; (void)b_s; (void)g_out_a; (void)g_out_b;
#if LEVEL >= 2
    LAUNCH_PH(5, 6);
#else
    k_sgemm<<<dim3(D_ / 64, T_ / 64), 256, 0, stream>>>((long)D_, ALPlain<bf16_t>{ycat, D_, 0}, BLPlain{w_out, D_, 0}, EPResid{x, out, D_, 0});
#endif
#if LEVEL >= 3
    LAUNCH_PH(6, 7); LAUNCH_PH(7, 8); LAUNCH_PH(8, 9); LAUNCH_PH(9, 10);
#if LEVEL >= 4
    LAUNCH_PH(10, 11);
#else
    float* h2 = (float*)(ws);
    hipMemcpyAsync(h2, out, (size_t)T_ * D_ * 4, hipMemcpyDeviceToDevice, stream);
    k_row_rstd<float><<<T_ / 4, 256, 0, stream>>>(h2, rstd_h2, T_, D_, D_, 0);
    k_sgemm<<<dim3(D_ / 64, T_ / 64), 256, 0, stream>>>((long)D_, ALScaled<float>{h2, rstd_h2, g_ple, D_, 0}, BLPlain{w_ple_gate, D_, 0}, EPPle<bf16_t>{h2, pwb, out, D_, 0});
#endif
#else
    float* h2 = (float*)(ws + 90 * MiB);
    k_row_rstd<float><<<T_ / 4, 256, 0, stream>>>(out, rstd_h, T_, D_, D_, 0);
    k_route<<<T_ / 4, 256, 0, stream>>>(out, rstd_h, g_ffn, w_group, w_expert, route);
    k_moe<<<T_, 256, 0, stream>>>(out, rstd_h, g_ffn, route, w_gate_e, w_up_e, w_down_e, h2);
    k_row_rstd<float><<<T_ / 4, 256, 0, stream>>>(h2, rstd_h2, T_, D_, D_, 0);
    k_sgemm<<<dim3(D_ / 64, T_ / 64), 256, 0, stream>>>((long)D_, ALScaled<float>{h2, rstd_h2, g_ple, D_, 0}, BLPlain{w_ple_gate, D_, 0}, EPPle<bf16_t>{h2, pwb, out, D_, 0});
#endif
#endif
}
```

```cpp
#include <hip/hip_runtime.h>
#include <math.h>
#include <stdint.h>
#include <cstdio>

#ifndef MODE
#define MODE 1
#endif

typedef unsigned short bf16_t;
constexpr int NB_ = 4, S_ = 4096, D_ = 1024, T_ = NB_ * S_;
constexpr int DIN = 2560, NH = 8, DH = 64, BLK = 256, NBLK = 16;
constexpr int NE = 32, DFF = 256, DPLE = 256;
constexpr float EPS = 1e-6f;
constexpr size_t MiB = 1u << 20;
constexpr size_t ARR = (size_t)T_ * 512;

__host__ __device__ __forceinline__ unsigned f2bf(float f) { unsigned u = __builtin_bit_cast(unsigned, f); return (u + 0x7fffu + ((u >> 16) & 1u)) >> 16; }
__device__ __forceinline__ float bf2f(unsigned h) { return __uint_as_float(h << 16); }
__device__ __forceinline__ float ldv(const float* p, size_t i) { return p[i]; }
__device__ __forceinline__ float ldv(const bf16_t* p, size_t i) { return bf2f((unsigned)p[i]); }
__device__ __forceinline__ void stv(float* p, size_t i, float v) { p[i] = v; }
__device__ __forceinline__ void stv(bf16_t* p, size_t i, float v) { p[i] = (bf16_t)f2bf(v); }

namespace orc {
__device__ __forceinline__ float gelu_tanh(float x) {
    const float c = 0.7978845608028654f;
    return 0.5f * x * (1.f + tanhf(c * (x + 0.044715f * x * x * x)));
}
__device__ __forceinline__ float sigmoidf_(float x) { return 1.f / (1.f + expf(-x)); }
__device__ __forceinline__ float wave_sum(float v) {
#pragma unroll
    for (int o = 32; o > 0; o >>= 1) v += __shfl_xor(v, o);
    return v;
}
template <class TI>
__global__ void __launch_bounds__(256) k_row_rstd(const TI* __restrict__ x, float* __restrict__ rstd, int nrows, int ncols, int ld, int pad_) {
    const int row = blockIdx.x * 4 + (threadIdx.x >> 6), lane = threadIdx.x & 63;
    if (row >= nrows) return;
    float s = 0.f;
    for (int c = lane; c < ncols; c += 64) { const float v = ldv(x, (size_t)row * ld + c); s += v * v; }
    s = wave_sum(s);
    if (lane == 0) rstd[row] = rsqrtf(s / (float)ncols + EPS);
}
template <class TO>
__global__ void __launch_bounds__(256) k_rownorm_inplace(TO* __restrict__ y, const float* __restrict__ g, int nrows, int ncols, int ld, int c0) {
    const int row = blockIdx.x * 4 + (threadIdx.x >> 6), lane = threadIdx.x & 63;
    if (row >= nrows) return;
    float s = 0.f;
    for (int c = lane; c < ncols; c += 64) { const float v = ldv(y, (size_t)row * ld + c0 + c); s += v * v; }
    s = wave_sum(s);
    const float r = rsqrtf(s / (float)ncols + EPS);
    for (int c = lane; c < ncols; c += 64) { const size_t i = (size_t)row * ld + c0 + c; stv(y, i, ldv(y, i) * r * g[c]); }
}
template <class AL, class BL, class EP>
__global__ void __launch_bounds__(256) k_sgemm(long K, AL al, BL bl, EP ep) {
    __shared__ float As[16][65];
    __shared__ float Bs[16][65];
    const int tx = threadIdx.x & 15, ty = threadIdx.x >> 4;
    const int m0 = blockIdx.y * 64, n0 = blockIdx.x * 64;
    float acc[4][4];
#pragma unroll
    for (int i = 0; i < 4; ++i)
#pragma unroll
        for (int j = 0; j < 4; ++j) acc[i][j] = 0.f;
    for (int k0 = 0; k0 < K; k0 += 16) {
#pragma unroll
        for (int r = 0; r < 4; ++r) { const int i = threadIdx.x + r * 256; const int m = i >> 4, k = i & 15; As[k][m] = al(m0 + m, k0 + k); }
#pragma unroll
        for (int r = 0; r < 4; ++r) { const int i = threadIdx.x + r * 256; const int k = i >> 6, n = i & 63; Bs[k][n] = bl(k0 + k, n0 + n); }
        __syncthreads();
#pragma unroll
        for (int k = 0; k < 16; ++k) {
            float a[4], b[4];
#pragma unroll
            for (int i = 0; i < 4; ++i) a[i] = As[k][ty * 4 + i];
#pragma unroll
            for (int j = 0; j < 4; ++j) b[j] = Bs[k][tx * 4 + j];
#pragma unroll
            for (int i = 0; i < 4; ++i)
#pragma unroll
                for (int j = 0; j < 4; ++j) acc[i][j] += a[i] * b[j];
        }
        __syncthreads();
    }
#pragma unroll
    for (int i = 0; i < 4; ++i)
#pragma unroll
        for (int j = 0; j < 4; ++j) ep(m0 + ty * 4 + i, n0 + tx * 4 + j, acc[i][j]);
}
template <class TI> struct ALScaled { const TI* x; const float* rstd; const float* g; int ld; int pad;
    __device__ float operator()(int m, int k) const { return ldv(x, (size_t)m * ld + k) * rstd[m] * g[k]; } };
template <class TI> struct ALPlain { const TI* x; int ld; int pad;
    __device__ float operator()(int m, int k) const { return ldv(x, (size_t)m * ld + k); } };
struct BLPlain { const float* w; int ld; int pad;
    __device__ float operator()(int k, int n) const { return w[(size_t)k * ld + n]; } };
struct EPStore { float* c; int ld; int pad;
    __device__ void operator()(int m, int n, float v) const { c[(size_t)m * ld + n] = v; } };
struct EPSplit5 { float* a0;
    __device__ void operator()(int m, int n, float v) const { a0[(size_t)(n >> 9) * ARR + (size_t)m * 512 + (n & 511)] = v; } };
struct EPResid { const float* r; float* c; int ld; int pad;
    __device__ void operator()(int m, int n, float v) const { c[(size_t)m * ld + n] = r[(size_t)m * ld + n] + v; } };
template <class TP> struct EPPle { const float* h; const TP* pw; float* c; int ld; int pad;
    __device__ void operator()(int m, int n, float v) const { const size_t i = (size_t)m * ld + n; c[i] = h[i] + ldv(pw, i) * sigmoidf_(v); } };

__global__ void __launch_bounds__(256) k_post_gelu(float* __restrict__ a0) {
    const size_t i = (size_t)blockIdx.x * 256 + threadIdx.x;
    a0[i] = gelu_tanh(a0[i]);
}
__global__ void __launch_bounds__(256) k_qknorm(float* __restrict__ a0, const float* __restrict__ g_q, const float* __restrict__ g_k) {
    const int idx = blockIdx.x * 256 + threadIdx.x;
    if (idx >= T_ * 16) return;
    const int t = idx >> 4, which = (idx >> 3) & 1, h = idx & 7;
    float* p = a0 + (size_t)(2 + which) * ARR + (size_t)t * 512 + h * 64;
    const float* g = which ? g_k : g_q;
    float s = 0.f;
    for (int d = 0; d < 64; ++d) s += p[d] * p[d];
    const float r = rsqrtf(s / 64.f + EPS);
    for (int d = 0; d < 64; ++d) p[d] = p[d] * r * g[d];
}
template <class TI>
__global__ void __launch_bounds__(256) k_va_rstd(const TI* __restrict__ va, float* __restrict__ rstd_va) {
    const int idx = blockIdx.x * 4 + (threadIdx.x >> 6), lane = threadIdx.x & 63;
    const int t = idx >> 2, g = idx & 3;
    float s = 0.f;
    for (int d = lane; d < 128; d += 64) { const float v = ldv(va, (size_t)t * 512 + g * 128 + d); s += v * v; }
    s = wave_sum(s);
    if (lane == 0) rstd_va[idx] = rsqrtf(s / 128.f + EPS);
}
template <class TI, class TO>
__global__ void __launch_bounds__(256) k_mixa(const TI* __restrict__ ua, const TI* __restrict__ va, const float* __restrict__ rstd_va, const float* __restrict__ g_v,
                                              const float* __restrict__ w_s, const float* __restrict__ b_s, TO* __restrict__ ycat) {
    const int bc = blockIdx.x, g = blockIdx.y;
    const int t0 = bc * 128;
    for (int o = threadIdx.x; o < 128 * 128; o += 256) {
        const int tl = o >> 7, d = o & 127;
        float acc = 0.f;
        for (int s = 0; s <= tl; ++s) {
            const float v = ldv(va, (size_t)(t0 + s) * 512 + g * 128 + d) * rstd_va[(t0 + s) * 4 + g] * g_v[g * 128 + d];
            acc += w_s[((size_t)g * 128 + tl) * 128 + s] * v;
        }
        acc += b_s[g * 128 + tl];
        const float u = ldv(ua, (size_t)(t0 + tl) * 512 + g * 128 + d);
        stv(ycat, (size_t)(t0 + tl) * D_ + g * 128 + d, u * acc);
    }
}
template <class TI>
__global__ void __launch_bounds__(256) k_kmean(const TI* __restrict__ kn, float* __restrict__ kmean) {
    const int idx = blockIdx.x * 256 + threadIdx.x;
    if (idx >= NB_ * NH * NBLK * DH) return;
    const int d = idx & 63, n = (idx >> 6) & 15, h = (idx >> 10) & 7, b = idx >> 13;
    float s = 0.f;
    for (int r = 0; r < BLK; ++r) s += ldv(kn, (size_t)(b * S_ + n * BLK + r) * 512 + h * 64 + d);
    kmean[idx] = s / (float)BLK;
}
template <class TI>
__global__ void __launch_bounds__(256) k_gate(const TI* __restrict__ qn, const float* __restrict__ kmean, int* __restrict__ sel) {
    const int idx = blockIdx.x * 256 + threadIdx.x;
    if (idx >= T_ * NH) return;
    const int t = idx >> 3, h = idx & 7, b = t / S_, s = t % S_, qb = s / BLK;
    float v0 = -INFINITY, v1 = -INFINITY, v2 = -INFINITY; int i0 = -1, i1 = -1, i2 = -1;
    for (int n = 0; n < qb; ++n) {
        const float* km = kmean + ((size_t)(b * NH + h) * NBLK + n) * DH;
        float sc = 0.f;
        for (int d = 0; d < 64; ++d) sc += ldv(qn, (size_t)t * 512 + h * 64 + d) * km[d];
        if (sc > v0) { v2 = v1; i2 = i1; v1 = v0; i1 = i0; v0 = sc; i0 = n; }
        else if (sc > v1) { v2 = v1; i2 = i1; v1 = sc; i1 = n; }
        else if (sc > v2) { v2 = sc; i2 = n; }
    }
    sel[idx * 3 + 0] = i0; sel[idx * 3 + 1] = i1; sel[idx * 3 + 2] = i2;
}
template <class TI, class TO>
__global__ void __launch_bounds__(256) k_attn(const TI* __restrict__ qn, const TI* __restrict__ kn, const TI* __restrict__ vb, const int* __restrict__ sel, TO* __restrict__ ycat, int ldo, int coff) {
    __shared__ float qs[64];
    __shared__ float ps[4][256];
    __shared__ float red[4];
    __shared__ float part[4][64];
    const int idx = blockIdx.x;
    const int t = idx >> 3, h = idx & 7, b = t / S_, s = t % S_, qb = s / BLK;
    const int tid = threadIdx.x, lane = tid & 63, wid = tid >> 6;
    if (tid < 64) qs[tid] = ldv(qn, (size_t)t * 512 + h * 64 + tid);
    __syncthreads();
    const int b0 = sel[idx * 3 + 0], b1 = sel[idx * 3 + 1], b2 = sel[idx * 3 + 2], b3 = qb;
    float sc[4];
    float mx = -INFINITY;
#pragma unroll
    for (int j = 0; j < 4; ++j) {
        const int bj = (j == 0) ? b0 : (j == 1) ? b1 : (j == 2) ? b2 : b3;
        sc[j] = -INFINITY;
        if (bj >= 0) {
            const int kpos = bj * BLK + tid;
            if (j < 3 || kpos <= s) {
                float a = 0.f;
                for (int d = 0; d < 64; ++d) a += qs[d] * ldv(kn, (size_t)(b * S_ + kpos) * 512 + h * 64 + d);
                sc[j] = a * 0.125f;
            }
        }
        mx = fmaxf(mx, sc[j]);
    }
#pragma unroll
    for (int o = 32; o > 0; o >>= 1) mx = fmaxf(mx, __shfl_xor(mx, o));
    if (lane == 0) red[wid] = mx;
    __syncthreads();
    mx = fmaxf(fmaxf(red[0], red[1]), fmaxf(red[2], red[3]));
    __syncthreads();
    float sum = 0.f;
#pragma unroll
    for (int j = 0; j < 4; ++j) { const float p = (sc[j] == -INFINITY) ? 0.f : expf(sc[j] - mx); ps[j][tid] = p; sum += p; }
    sum = wave_sum(sum);
    if (lane == 0) red[wid] = sum;
    __syncthreads();
    sum = red[0] + red[1] + red[2] + red[3];
    float o = 0.f;
    {
        const int j = wid;
        const int bj = (j == 0) ? b0 : (j == 1) ? b1 : (j == 2) ? b2 : b3;
        if (bj >= 0) {
            for (int k = 0; k < 256; ++k) {
                const float p = ps[j][k];
                if (p != 0.f) o += p * ldv(vb, (size_t)(b * S_ + bj * BLK + k) * 512 + h * 64 + lane);
            }
        }
    }
    part[wid][lane] = o;
    __syncthreads();
    if (tid < 64) stv(ycat, (size_t)t * ldo + coff + h * 64 + tid, (part[0][tid] + part[1][tid] + part[2][tid] + part[3][tid]) / sum);
}
__global__ void __launch_bounds__(256) k_fill(float* __restrict__ p, float v, int n, int pad_) { const int i = blockIdx.x * 256 + threadIdx.x; if (i < n) p[i] = v; }
struct Route { int e1, e2; float c1, c2; };
__global__ void __launch_bounds__(256) k_route(const float* __restrict__ h, const float* __restrict__ rstd, const float* __restrict__ g,
                                               const float* __restrict__ w_group, const float* __restrict__ w_expert, Route* __restrict__ route) {
    const int t = blockIdx.x * 4 + (threadIdx.x >> 6), lane = threadIdx.x & 63;
    float acc[36];
#pragma unroll
    for (int j = 0; j < 36; ++j) acc[j] = 0.f;
    const float r = rstd[t];
    for (int k = lane; k < D_; k += 64) {
        const float xv = h[(size_t)t * D_ + k] * r * g[k];
#pragma unroll
        for (int j = 0; j < 4; ++j) acc[j] += xv * w_group[k * 4 + j];
#pragma unroll
        for (int j = 0; j < 32; ++j) acc[4 + j] += xv * w_expert[k * 32 + j];
    }
#pragma unroll
    for (int j = 0; j < 36; ++j) acc[j] = wave_sum(acc[j]);
    if (lane == 0) {
        int gs = 0; float gm = acc[0];
#pragma unroll
        for (int j = 1; j < 4; ++j) if (acc[j] > gm) { gm = acc[j]; gs = j; }
        float den = 0.f;
#pragma unroll
        for (int j = 0; j < 4; ++j) den += expf(acc[j] - gm);
        const float pg = 1.f / den;
        float el[8];
#pragma unroll
        for (int j = 0; j < 8; ++j) {
            float v = acc[4 + j];
#pragma unroll
            for (int gg = 1; gg < 4; ++gg) v = (gs == gg) ? acc[4 + gg * 8 + j] : v;
            el[j] = v;
        }
        int a1 = 0; float m1 = el[0];
#pragma unroll
        for (int j = 1; j < 8; ++j) if (el[j] > m1) { m1 = el[j]; a1 = j; }
        int a2 = -1; float m2 = -INFINITY;
#pragma unroll
        for (int j = 0; j < 8; ++j) if (j != a1 && el[j] > m2) { m2 = el[j]; a2 = j; }
        const float e2 = expf(m2 - m1);
        Route rt; rt.e1 = gs * 8 + a1; rt.e2 = gs * 8 + a2; rt.c1 = pg / (1.f + e2); rt.c2 = pg * e2 / (1.f + e2);
        route[t] = rt;
    }
}
__global__ void __launch_bounds__(256) k_moe(const float* __restrict__ h, const float* __restrict__ rstd, const float* __restrict__ g, const Route* __restrict__ route,
                                             const float* __restrict__ wg, const float* __restrict__ wu, const float* __restrict__ wd, float* __restrict__ h2) {
    __shared__ float xs[D_];
    __shared__ float as[DFF];
    const int t = blockIdx.x, tid = threadIdx.x;
    const float r = rstd[t];
    for (int k = tid; k < D_; k += 256) xs[k] = h[(size_t)t * D_ + k] * r * g[k];
    __syncthreads();
    const Route rt = route[t];
    float out[4] = {0.f, 0.f, 0.f, 0.f};
    for (int slot = 0; slot < 2; ++slot) {
        const int e = slot ? rt.e2 : rt.e1; const float cw = slot ? rt.c2 : rt.c1;
        const float* pg_ = wg + (size_t)e * D_ * DFF; const float* pu_ = wu + (size_t)e * D_ * DFF; const float* pd_ = wd + (size_t)e * DFF * D_;
        float hh = 0.f, uu = 0.f;
        for (int k = 0; k < D_; ++k) { const float xv = xs[k]; hh += xv * pg_[(size_t)k * DFF + tid]; uu += xv * pu_[(size_t)k * DFF + tid]; }
        __syncthreads();
        as[tid] = hh * sigmoidf_(hh) * uu * cw;
        __syncthreads();
        for (int f = 0; f < DFF; ++f) {
            const float a = as[f];
#pragma unroll
            for (int i = 0; i < 4; ++i) out[i] += a * pd_[(size_t)f * D_ + tid + 256 * i];
        }
    }
#pragma unroll
    for (int i = 0; i < 4; ++i) h2[(size_t)t * D_ + tid + 256 * i] = h[(size_t)t * D_ + tid + 256 * i] + out[i];
}
}

namespace pg8 {
#define PG8_LAS __attribute__((address_space(3)))
typedef short bf16x8 __attribute__((ext_vector_type(8)));
typedef float f32x4 __attribute__((ext_vector_type(4)));
typedef float f32x2 __attribute__((ext_vector_type(2)));
typedef unsigned u32x4 __attribute__((ext_vector_type(4)));
typedef unsigned u32x2 __attribute__((ext_vector_type(2)));
constexpr int BM = 256, BK = 64, HALF = 128, HTB = HALF * BK * 2, STAGE_BYTES = 8 * HTB, NXCD = 8, WGM = 8;

__host__ __device__ __forceinline__ int lds_byte(int r, int c) { const int st = (r >> 4) * 2 + (c >> 5), rr = r & 15, cc = c & 31, ob = rr * 64 + cc * 2; return st * 1024 + (ob ^ (((ob >> 9) & 1) << 5)); }
__host__ __device__ __forceinline__ void stage_rc(int b, int& R, int& C) { const int st = b / 1024, sb = b % 1024, swz = sb ^ (((sb >> 9) & 1) << 5); R = (st >> 1) * 16 + swz / 64; C = (st & 1) * 32 + (swz % 64) / 2; }
__host__ __device__ __forceinline__ int perm32(int rho) { const int n = rho >> 4, i = rho & 15; return 8 * (i >> 2) + 4 * n + (i & 3); }

struct Unit { int pm, pn, e, aux; };

__device__ __forceinline__ unsigned cvt_pk_bf16(float lo, float hi) { unsigned r; asm volatile("v_cvt_pk_bf16_f32 %0, %1, %2" : "=v"(r) : "v"(lo), "v"(hi)); return r; }

struct StaticOrder {
    static constexpr bool GATHER = false;
    const char* A; const char* Bt; int K; int nM, nN, nwg, G, c;
    __device__ void init(const void* A_, const void* Bt_, int M, int N, int K_, int G_, int c_) { A = (const char*)A_; Bt = (const char*)Bt_; K = K_; nM = M / BM; nN = N / BM; nwg = nM * nN; G = G_; c = c_; }
    __device__ bool next(int i, Unit& u) const {
        const long L = (long)i * G + c; if (L >= nwg) return false;
        int wgid = (int)L; { const int q = nwg / NXCD, r = nwg % NXCD, xcd = wgid % NXCD, off = wgid / NXCD; wgid = (xcd < r ? xcd * (q + 1) : r * (q + 1) + (xcd - r) * q) + off; }
        const int nig = WGM * nN, gid = wgid / nig, fm = gid * WGM, gsz = (nM - fm) < WGM ? (nM - fm) : WGM;
        u.pm = fm + ((wgid % nig) % gsz); u.pn = (wgid % nig) / gsz; u.e = 0; u.aux = 0; return true;
    }
    __device__ __forceinline__ const char* a_base(const Unit& u) const { return A + (size_t)u.pm * BM * K * 2; }
    __device__ __forceinline__ const char* b_base(const Unit& u) const { return Bt + (size_t)u.pn * BM * K * 2; }
    __device__ __forceinline__ int row(const Unit&, int r) const { return r; }
    __device__ __forceinline__ void a_ready(const Unit&) const {}
    __device__ __forceinline__ void done(const Unit&) const {}
};

template <class Epi, class Sched, bool ALIGN_EPI>
__device__ __forceinline__ void gemm_phase(PG8_LAS unsigned char* lds, const int K, const Sched& S, const Epi& E) {
    const int tid = threadIdx.x, wid = __builtin_amdgcn_readfirstlane(tid >> 6), lane = tid & 63, wr = wid >> 2, wc = wid & 3, fr = lane & 15, fq = lane >> 4;
    const int nt = K / BK;
    unsigned voffB[2]; unsigned cv0[2], cv1[2], nv0[2], nv1[2];
    const size_t kstep = (size_t)(BK * 2);
    const size_t hstep = (size_t)HALF * K * 2;
    const unsigned ldsw = (unsigned)wid * 1024u;
    const int aoff = lds_byte(wr * 64 + fr, fq * 8), boff = lds_byte(wc * 32 + fr, fq * 8);
#define PG8_SA(b, h) (((b) * 2 + (h)) * HTB)
#define PG8_SB(b, h) ((4 + (b) * 2 + (h)) * HTB)
#define PG8_STAGE(bufoff, gbase, voff) do { _Pragma("unroll") for (int _i = 0; _i < 2; ++_i) \
        __builtin_amdgcn_global_load_lds((const unsigned*)((const char*)(gbase) + (voff)[_i]), (PG8_LAS unsigned*)(lds + (bufoff) + ldsw + _i * 8192), 16, 0, 0); } while (0)
#define PG8_STAGE_A1(bufoff, gbase, v0_, v1_) do { if constexpr (Sched::GATHER) { PG8_STAGE(bufoff, gbase, v1_); } else { PG8_STAGE(bufoff, (gbase) + hstep, v0_); } } while (0)
#define PG8_LDA(dst, b, h) do { _Pragma("unroll") for (int m = 0; m < 4; ++m) _Pragma("unroll") for (int k = 0; k < 2; ++k) dst[m][k] = *(const PG8_LAS bf16x8*)(lds + PG8_SA(b, h) + aoff + m * 2048 + k * 1024); } while (0)
#define PG8_LDB(dst, b, h) do { _Pragma("unroll") for (int n = 0; n < 2; ++n) _Pragma("unroll") for (int k = 0; k < 2; ++k) dst[n][k] = *(const PG8_LAS bf16x8*)(lds + PG8_SB(b, h) + boff + n * 2048 + k * 1024); } while (0)
#define PG8_MMA(ai, bj, At, Bt) do { __builtin_amdgcn_s_setprio(1); _Pragma("unroll") for (int m = 0; m < 4; ++m) _Pragma("unroll") for (int n = 0; n < 2; ++n) _Pragma("unroll") for (int k = 0; k < 2; ++k) \
        acc[ai][bj][m][n] = __builtin_amdgcn_mfma_f32_16x16x32_bf16(Bt[n][k], At[m][k], acc[ai][bj][m][n], 0, 0, 0); __builtin_amdgcn_s_setprio(0); } while (0)
#define PG8_WAIT_V(n) asm volatile("s_waitcnt vmcnt(" #n ")" ::: "memory")
#define PG8_WAIT_L(n) asm volatile("s_waitcnt lgkmcnt(" #n ")" ::: "memory")
#define PG8_BAR __builtin_amdgcn_s_barrier()
#define PG8_SCHED __builtin_amdgcn_sched_barrier(0)
#define PG8_AOFFS(v0, v1, U) do { _Pragma("unroll") for (int _i = 0; _i < 2; ++_i) { int R_, C_; stage_rc(tid * 16 + _i * 8192, R_, C_); \
        v0[_i] = (unsigned)(S.row(U, R_) * K + C_) * 2u; v1[_i] = (unsigned)(S.row(U, HALF + R_) * K + C_) * 2u; } } while (0)
    Unit cur, nxt; int ui = 0;
    if (!S.next(0, cur)) return;
#pragma unroll
    for (int i = 0; i < 2; ++i) { int R, C; stage_rc(tid * 16 + i * 8192, R, C); const int Rb = Epi::PERM ? ((R & ~31) + perm32(R & 31)) : R; voffB[i] = (unsigned)(Rb * K + C) * 2u; }
    PG8_AOFFS(cv0, cv1, cur);
    f32x4 acc[2][2][4][2];
#pragma unroll
    for (int a = 0; a < 2; ++a)
#pragma unroll
        for (int b = 0; b < 2; ++b)
#pragma unroll
            for (int m = 0; m < 4; ++m)
#pragma unroll
                for (int n = 0; n < 2; ++n) acc[a][b][m][n] = (f32x4){0.f, 0.f, 0.f, 0.f};
    bf16x8 At[4][2], B0[2][2], B1[2][2];
    const char* cA = S.a_base(cur); const char* cB = S.b_base(cur);
    S.a_ready(cur);
    PG8_STAGE(PG8_SB(0, 0), cB, voffB); PG8_STAGE(PG8_SB(0, 1), cB + hstep, voffB); PG8_STAGE(PG8_SA(0, 0), cA, cv0); PG8_STAGE_A1(PG8_SA(0, 1), cA, cv0, cv1);
    if (wr == 1) PG8_BAR;
    PG8_WAIT_V(2); PG8_BAR;
    PG8_STAGE(PG8_SB(1, 0), cB + kstep, voffB); PG8_STAGE(PG8_SA(1, 0), cA + kstep, cv0); PG8_STAGE(PG8_SB(1, 1), cB + hstep + kstep, voffB);
    PG8_WAIT_V(6); PG8_BAR;
    for (;;) {
        const bool has_next = S.next(ui + 1, nxt);
        const char* nA = has_next ? S.a_base(nxt) : cA; const char* nB = has_next ? S.b_base(nxt) : cB;
        if constexpr (Sched::GATHER) { if (has_next) { PG8_AOFFS(nv0, nv1, nxt); } else { nv0[0] = cv0[0]; nv0[1] = cv0[1]; nv1[0] = cv1[0]; nv1[1] = cv1[1]; } }
        for (int t = 0; t < nt; t += 2) {
            const bool last = (t == nt - 2);
            const char* a1 = cA + (size_t)(t + 1) * kstep;
            const char* a2 = last ? nA : cA + (size_t)(t + 2) * kstep; const char* b2 = last ? nB : cB + (size_t)(t + 2) * kstep;
            const char* a3 = a2 + kstep; const char* b3 = b2 + kstep;
            unsigned s0[2], s1[2];
            if constexpr (Sched::GATHER) { s0[0] = last ? nv0[0] : cv0[0]; s0[1] = last ? nv0[1] : cv0[1]; s1[0] = last ? nv1[0] : cv1[0]; s1[1] = last ? nv1[1] : cv1[1]; }
            else { s0[0] = cv0[0]; s0[1] = cv0[1]; s1[0] = 0u; s1[1] = 0u; }
            if (last && has_next) S.a_ready(nxt);
            PG8_LDB(B0, 0, 0); PG8_LDB(B1, 0, 1); PG8_SCHED; PG8_LDA(At, 0, 0); PG8_STAGE_A1(PG8_SA(1, 1), a1, cv0, cv1);
            PG8_WAIT_V(8); PG8_WAIT_L(0); PG8_BAR; PG8_MMA(0, 0, At, B0); PG8_MMA(0, 1, At, B1); PG8_BAR; PG8_SCHED;
            PG8_LDA(At, 0, 1); PG8_STAGE(PG8_SB(0, 0), b2, voffB); PG8_STAGE(PG8_SB(0, 1), b2 + hstep, voffB); PG8_STAGE(PG8_SA(0, 0), a2, s0);
            PG8_WAIT_V(8); PG8_WAIT_L(0); PG8_BAR; PG8_MMA(1, 0, At, B0); PG8_MMA(1, 1, At, B1); PG8_BAR; PG8_SCHED;
            PG8_LDB(B0, 1, 0); PG8_LDB(B1, 1, 1); PG8_SCHED; PG8_LDA(At, 1, 0); PG8_STAGE_A1(PG8_SA(0, 1), a2, s0, s1);
            PG8_WAIT_V(8); PG8_WAIT_L(0); PG8_BAR; PG8_MMA(0, 0, At, B0); PG8_MMA(0, 1, At, B1); PG8_BAR; PG8_SCHED;
            PG8_LDA(At, 1, 1); PG8_STAGE(PG8_SB(1, 0), b3, voffB); PG8_STAGE(PG8_SB(1, 1), b3 + hstep, voffB); PG8_STAGE(PG8_SA(1, 0), a3, s0);
            PG8_WAIT_V(8); PG8_WAIT_L(0); PG8_BAR; PG8_MMA(1, 0, At, B0); PG8_MMA(1, 1, At, B1); PG8_BAR; PG8_SCHED;
        }
        if constexpr (ALIGN_EPI) { if (wr == 0) PG8_BAR; }
        { int l2 = lane; asm volatile("" : "+v"(l2)); E(acc, cur, wr, wc, l2 & 15, l2 >> 4); } S.done(cur);
        if (!has_next) break;
#pragma unroll
        for (int a = 0; a < 2; ++a)
#pragma unroll
            for (int b = 0; b < 2; ++b)
#pragma unroll
                for (int m = 0; m < 4; ++m)
#pragma unroll
                    for (int n = 0; n < 2; ++n) acc[a][b][m][n] = (f32x4){0.f, 0.f, 0.f, 0.f};
        cur = nxt; cA = nA; cB = nB; ++ui;
        if constexpr (Sched::GATHER) { cv0[0] = nv0[0]; cv0[1] = nv0[1]; cv1[0] = nv1[0]; cv1[1] = nv1[1]; }
        if constexpr (ALIGN_EPI) { if (wr == 1) PG8_BAR; }
    }
    PG8_WAIT_V(0);
    if constexpr (!ALIGN_EPI) { if (wr == 0) PG8_BAR; }
    PG8_BAR;
#undef PG8_SA
#undef PG8_SB
#undef PG8_STAGE
#undef PG8_STAGE_A1
#undef PG8_LDA
#undef PG8_LDB
#undef PG8_MMA
#undef PG8_WAIT_V
#undef PG8_WAIT_L
#undef PG8_BAR
#undef PG8_SCHED
#undef PG8_AOFFS
}
}

#define GAS __attribute__((address_space(1)))
#define LAS __attribute__((address_space(3)))
typedef unsigned v4u __attribute__((ext_vector_type(4)));
typedef unsigned v2u __attribute__((ext_vector_type(2)));
typedef float f32x4 __attribute__((ext_vector_type(4)));
typedef float f32x2 __attribute__((ext_vector_type(2)));
typedef short bf16x8 __attribute__((ext_vector_type(8)));
typedef GAS unsigned gu32;
#define RLX_AGENT __ATOMIC_RELAXED, __HIP_MEMORY_SCOPE_AGENT
#define LDS_WAIT() asm volatile("s_waitcnt lgkmcnt(0)" ::: "memory")
#define VM_WAIT() asm volatile("s_waitcnt vmcnt(0)" ::: "memory")
constexpr int NWAVES = 8;
constexpr int PH_COMB = 4;

constexpr size_t WS_WIN = 0;
constexpr size_t WS_WOUT = 5 * MiB;
constexpr size_t WS_WGU = 7 * MiB;
constexpr size_t WS_WD = 39 * MiB;
constexpr size_t WS_WPLE = 55 * MiB;
constexpr size_t WS_WPG = 56 * MiB;
constexpr size_t WS_XN = 58 * MiB;
constexpr size_t WS_PB = 90 * MiB;
constexpr size_t WS_ARR = 98 * MiB;
constexpr size_t WS_PW = 211 * MiB;
constexpr size_t WS_CTL = 243 * MiB;
constexpr size_t WS_ACC = 244 * MiB;
constexpr size_t ZERO_BYTES = 2 * MiB;
constexpr size_t WS_KMEAN = WS_ACC, WS_SSQ1 = WS_ACC + 128 * 1024, WS_SSQ2 = WS_ACC + 192 * 1024;
constexpr size_t WS_YCAT = 58 * MiB;
constexpr size_t WS_H1B = 90 * MiB;
constexpr size_t WS_A2 = 122 * MiB;
constexpr size_t WS_YS = 142 * MiB;
constexpr size_t WS_H2B = 58 * MiB;
constexpr size_t WS_YA = 178 * MiB;
constexpr size_t WS_LP = 194 * MiB;
constexpr size_t WS_QL = 196 * MiB;
constexpr int CW_QCNT = 8192;
constexpr size_t WS_LTOK = 245 * MiB;
constexpr size_t WS_LSC = 247 * MiB;
constexpr size_t WS_RSTD2 = 251 * MiB;
constexpr size_t WS_WR = 251 * MiB + 512 * 1024;
constexpr size_t WS_ORC = 252 * MiB;
constexpr int CW_CNT = 1024;
constexpr int LCAP = 16384;
constexpr int CW_BAR = 4096;

constexpr int RING_OFF = 0, RING_BYTES = 131072;
constexpr int XTRA_OFF = 131072;
constexpr int LDS_BYTES = 163840;
constexpr int LDSCTL_OFF = LDS_BYTES - 512, MISC_OFF = LDSCTL_OFF + 320;

#define XB_TMO      128
#define XB_XCNT(j)  (256  + 64 * (j))
#define XB_XSUB(j)  (1280 + 64 * (j))
#define XB_XGEN(j)  (2304 + 64 * (j))
#define XB_TOP      3328
#define XB_TOPGEN   3392
#define XCD_BAR_WORDS 3456
#define XB_SPIN_CAP (1u << 18)
__device__ __forceinline__ unsigned xb_ld(unsigned* p)              { return __hip_atomic_load(p, __ATOMIC_RELAXED, __HIP_MEMORY_SCOPE_AGENT); }
__device__ __forceinline__ unsigned xb_add(unsigned* p, unsigned v) { return __hip_atomic_fetch_add(p, v, __ATOMIC_RELAXED, __HIP_MEMORY_SCOPE_AGENT); }
__device__ __forceinline__ unsigned xb_xcc_id() { return (unsigned)__builtin_amdgcn_s_getreg((3 << 11) | 20) & 0xFu; }
#define XB_SPIN(cond, bar) do { unsigned _sp = 0; while (cond) { __builtin_amdgcn_s_sleep(1); \
    if ((++_sp & 255u) == 0u) { if (xb_ld(&(bar)[XB_TMO])) break; if (_sp > XB_SPIN_CAP) { atomicAdd(&(bar)[XB_TMO], 1u); break; } } } } while (0)
struct XcdBarrier { unsigned* bar; unsigned x; volatile LAS unsigned* st; };
__device__ __forceinline__ XcdBarrier xcd_barrier_post(unsigned* bar, volatile LAS unsigned* st) {
    XcdBarrier b; b.bar = bar; b.x = xb_xcc_id(); b.st = st;
    if (threadIdx.x == 0) (void)xb_add(&bar[XB_XCNT(b.x)], 1u);
    return b;
}
__device__ __forceinline__ void xcd_barrier_complete(unsigned* bar, unsigned x, unsigned& nloc, unsigned& nx) {
    const unsigned G = gridDim.x * gridDim.y * gridDim.z;
    unsigned sum, cnt, mine, sp = 0u;
    for (;;) {
        sum = 0u; cnt = 0u; mine = 0u;
#pragma unroll
        for (unsigned j = 0; j < 16; ++j) { const unsigned c = xb_ld(&bar[XB_XCNT(j)]); sum += c; cnt += (c > 0u) ? 1u : 0u; mine = (j == x) ? c : mine; }
        if (sum == G) break;
        __builtin_amdgcn_s_sleep(1);
        if ((++sp & 255u) == 0u) { if (xb_ld(&bar[XB_TMO])) break; if (sp > XB_SPIN_CAP) { atomicAdd(&bar[XB_TMO], 1u); break; } }
    }
    nloc = mine > 0u ? mine : 1u; nx = cnt > 0u ? cnt : 1u;
}
__device__ __forceinline__ void xcd_barrier(const XcdBarrier& b) {
    asm volatile("s_waitcnt vmcnt(0)" ::: "memory");
    __syncthreads();
    if (threadIdx.x == 0) {
        unsigned* bar = b.bar;
        __builtin_amdgcn_s_waitcnt(0);
        unsigned nloc = b.st[0], nx = b.st[1];
        if (nloc == 0u) { xcd_barrier_complete(bar, b.x, nloc, nx); b.st[0] = nloc; b.st[1] = nx; }
        const unsigned old = xb_add(&bar[XB_XSUB(b.x)], 1u);
        const unsigned gen = old / nloc;
        if (old + 1u == (gen + 1u) * nloc) {
            __builtin_amdgcn_fence(__ATOMIC_RELEASE, "agent");
            asm volatile("s_waitcnt vmcnt(0)" ::: "memory");
            const unsigned og = xb_add(&bar[XB_TOP], 1u);
            const unsigned tg = og / nx;
            if (og + 1u == (tg + 1u) * nx) xb_add(&bar[XB_TOPGEN], 1u);
            else XB_SPIN(xb_ld(&bar[XB_TOPGEN]) == tg, bar);
            __builtin_amdgcn_fence(__ATOMIC_ACQUIRE, "agent");
            xb_add(&bar[XB_XGEN(b.x)], 1u);
            asm volatile("s_waitcnt vmcnt(0)" ::: "memory");
        } else {
            XB_SPIN(xb_ld(&bar[XB_XGEN(b.x)]) == gen, bar);
            __builtin_amdgcn_fence(__ATOMIC_ACQUIRE, "agent");
            asm volatile("s_waitcnt vmcnt(0)" ::: "memory");
        }
    }
    __syncthreads();
}

struct Args { const float* in[21]; float* out; unsigned char* ws; int ph_lo, ph_hi, li, pad; };

__device__ __forceinline__ float gelu_fast(float x) {
    const float z = x * (0.7978845608f + 0.0356774081f * x * x);
    const float e = __builtin_amdgcn_exp2f(-2.885390082f * z);
    return x * __builtin_amdgcn_rcpf(1.f + e);
}
struct EpiInProj {
    static constexpr bool PERM = true;
    bf16_t* arr0; float* kmean; const float* gq; const float* gk;
    __device__ __forceinline__ void operator()(const pg8::f32x4 (&acc)[2][2][4][2], const pg8::Unit& u, int wr, int wc, int fr, int fq) const {
        using namespace pg8;
        const int kind = u.pn >> 1;
        bf16_t* base = arr0 + (size_t)kind * ARR + (size_t)(u.pm * 256 + wr * 64 + fr) * 512 + (u.pn & 1) * 256;
        if (kind == 2 || kind == 3) {
            const float* g = (kind == 2) ? gq : gk;
            f32x4 gv[2][2], ks[2][2];
#pragma unroll
            for (int bj = 0; bj < 2; ++bj)
#pragma unroll
                for (int n = 0; n < 2; ++n) { gv[bj][n] = *(const f32x4*)(g + 32 * bj + 8 * fq + 4 * n); ks[bj][n] = (f32x4){0.f, 0.f, 0.f, 0.f}; }
#pragma unroll
            for (int ai = 0; ai < 2; ++ai)
#pragma unroll
                for (int m = 0; m < 4; ++m) {
                    float ss = 0.f;
#pragma unroll
                    for (int bj = 0; bj < 2; ++bj)
#pragma unroll
                        for (int n = 0; n < 2; ++n) { const f32x4 x = acc[ai][bj][m][n]; ss += (x[0] * x[0] + x[1] * x[1]) + (x[2] * x[2] + x[3] * x[3]); }
                    ss += __shfl_xor(ss, 16); ss += __shfl_xor(ss, 32);
                    const float rs = rsqrtf(ss * (1.f / 64.f) + EPS);
                    bf16_t* rowp = arr0 + (size_t)kind * ARR + ((size_t)((u.pm >> 4) * NH + (u.pn & 1) * 4 + wc) * S_ + (u.pm & 15) * 256 + ai * HALF + wr * 64 + m * 16 + fr) * DH + 8 * fq;
#pragma unroll
                    for (int bj = 0; bj < 2; ++bj) {
                        const f32x4 v0 = acc[ai][bj][m][0] * rs * gv[bj][0], v1 = acc[ai][bj][m][1] * rs * gv[bj][1];
                        ks[bj][0] += v0; ks[bj][1] += v1;
                        u32x4 w; w.x = cvt_pk_bf16(v0[0], v0[1]); w.y = cvt_pk_bf16(v0[2], v0[3]); w.z = cvt_pk_bf16(v1[0], v1[1]); w.w = cvt_pk_bf16(v1[2], v1[3]);
                        *(u32x4*)(rowp + 32 * bj) = w;
                    }
                }
            if (kind == 3) {
                float* km = kmean + ((size_t)((u.pm >> 4) * NH + (u.pn & 1) * 4 + wc) * NBLK + (u.pm & 15)) * DH + 8 * fq;
#pragma unroll
                for (int bj = 0; bj < 2; ++bj)
#pragma unroll
                    for (int n = 0; n < 2; ++n)
#pragma unroll
                        for (int r = 0; r < 4; ++r) {
                            float v = ks[bj][n][r];
                            v += __shfl_xor(v, 1); v += __shfl_xor(v, 2); v += __shfl_xor(v, 4); v += __shfl_xor(v, 8);
                            if (fr == 0) atomicAdd(km + 32 * bj + 4 * n + r, v * (1.f / 256.f));
                        }
            }
        } else {
#pragma unroll
            for (int ai = 0; ai < 2; ++ai)
#pragma unroll
                for (int m = 0; m < 4; ++m) {
                    bf16_t* rowp = base + (size_t)(ai * HALF + m * 16) * 512 + wc * 32 + 8 * fq;
                    const size_t vrow = (size_t)(u.pm & 15) * 256 + ai * HALF + wr * 64 + m * 16 + fr;
#pragma unroll
                    for (int bj = 0; bj < 2; ++bj) {
                        f32x4 v0 = acc[ai][bj][m][0], v1 = acc[ai][bj][m][1];
                        if (kind <= 1) {
#pragma unroll
                            for (int r = 0; r < 4; ++r) { v0[r] = gelu_fast(v0[r]); v1[r] = gelu_fast(v1[r]); }
                        }
                        u32x4 w; w.x = cvt_pk_bf16(v0[0], v0[1]); w.y = cvt_pk_bf16(v0[2], v0[3]); w.z = cvt_pk_bf16(v1[0], v1[1]); w.w = cvt_pk_bf16(v1[2], v1[3]);
                        if (kind == 4) *(u32x4*)(arr0 + (size_t)4 * ARR + ((size_t)((u.pm >> 4) * NH + (u.pn & 1) * 4 + 2 * bj + (wc >> 1)) * S_ + vrow) * DH + (wc & 1) * 32 + 8 * fq) = w;
                        else *(u32x4*)(rowp + bj * HALF) = w;
                    }
                }
        }
    }
};
struct EpiBf16Plain {
    static constexpr bool PERM = true;
    bf16_t* O; int ldc;
    __device__ __forceinline__ void operator()(const pg8::f32x4 (&acc)[2][2][4][2], const pg8::Unit& u, int wr, int wc, int fr, int fq) const {
        using namespace pg8;
        bf16_t* base = O + (size_t)(u.pm * 256 + wr * 64 + fr) * ldc + u.pn * 256 + wc * 32 + 8 * fq;
#pragma unroll
        for (int ai = 0; ai < 2; ++ai)
#pragma unroll
            for (int m = 0; m < 4; ++m) {
                bf16_t* rowp = base + (size_t)(ai * HALF + m * 16) * ldc;
#pragma unroll
                for (int bj = 0; bj < 2; ++bj) {
                    const f32x4 v0 = acc[ai][bj][m][0], v1 = acc[ai][bj][m][1];
                    u32x4 w; w.x = cvt_pk_bf16(v0[0], v0[1]); w.y = cvt_pk_bf16(v0[2], v0[3]); w.z = cvt_pk_bf16(v1[0], v1[1]); w.w = cvt_pk_bf16(v1[2], v1[3]);
                    *(u32x4*)(rowp + bj * HALF) = w;
                }
            }
    }
};

struct EpiOutProj {
    static constexpr bool PERM = true;
    const float* x; bf16_t* h1b; float* ssq;
    __device__ __forceinline__ void operator()(const pg8::f32x4 (&acc)[2][2][4][2], const pg8::Unit& u, int wr, int wc, int fr, int fq) const {
        using namespace pg8;
        const int row0 = u.pm * 256 + wr * 64 + fr, col0 = u.pn * 256 + wc * 32 + 8 * fq;
#pragma unroll
        for (int ai = 0; ai < 2; ++ai)
#pragma unroll
            for (int m = 0; m < 4; ++m) {
                const int row = row0 + ai * HALF + m * 16; const size_t off = (size_t)row * D_ + col0;
                float ss = 0.f;
#pragma unroll
                for (int bj = 0; bj < 2; ++bj) {
                    const f32x4 x0 = *(const f32x4*)(x + off + bj * HALF), x1 = *(const f32x4*)(x + off + bj * HALF + 4);
                    const f32x4 v0 = acc[ai][bj][m][0] + x0, v1 = acc[ai][bj][m][1] + x1;
                    u32x4 w; w.x = cvt_pk_bf16(v0[0], v0[1]); w.y = cvt_pk_bf16(v0[2], v0[3]); w.z = cvt_pk_bf16(v1[0], v1[1]); w.w = cvt_pk_bf16(v1[2], v1[3]);
                    *(u32x4*)(h1b + off + bj * HALF) = w;
                    ss += (v0[0] * v0[0] + v0[1] * v0[1]) + (v0[2] * v0[2] + v0[3] * v0[3]) + (v1[0] * v1[0] + v1[1] * v1[1]) + (v1[2] * v1[2] + v1[3] * v1[3]);
                }
                ss += __shfl_xor(ss, 16); ss += __shfl_xor(ss, 32);
                if (fq == 0) atomicAdd(ssq + row, ss);
                if (m & 1) asm volatile("" ::: "memory");
            }
    }
};
struct EpiPleGate {
    static constexpr bool PERM = true;
    float* out; const bf16_t* pw; const float* rstd2; const bf16_t* h2b;
    __device__ __forceinline__ void operator()(const pg8::f32x4 (&acc)[2][2][4][2], const pg8::Unit& u, int wr, int wc, int fr, int fq) const {
        using namespace pg8;
        const int row0 = u.pm * 256 + wr * 64 + fr, col0 = u.pn * 256 + wc * 32 + 8 * fq;
#pragma unroll
        for (int ai = 0; ai < 2; ++ai)
#pragma unroll
            for (int m = 0; m < 4; ++m) {
                const int row = row0 + ai * HALF + m * 16; const size_t off = (size_t)row * D_ + col0;
                const float rs = rstd2[row] * -1.4426950408889634f;
#pragma unroll
                for (int bj = 0; bj < 2; ++bj) {
                    const u32x4 hv = *(const u32x4*)(h2b + off + bj * HALF);
                    const u32x4 pv = *(const u32x4*)(pw + off + bj * HALF);
                    f32x4 v0, v1;
#pragma unroll
                    for (int r = 0; r < 4; ++r) {
                        const unsigned pw0 = (r & 1) ? (pv[r >> 1] & 0xffff0000u) : (pv[r >> 1] << 16);
                        const unsigned pw1 = (r & 1) ? (pv[2 + (r >> 1)] & 0xffff0000u) : (pv[2 + (r >> 1)] << 16);
                        const float s0 = __builtin_amdgcn_rcpf(1.f + __builtin_amdgcn_exp2f(acc[ai][bj][m][0][r] * rs));
                        const float s1 = __builtin_amdgcn_rcpf(1.f + __builtin_amdgcn_exp2f(acc[ai][bj][m][1][r] * rs));
                        const unsigned hw0 = (r & 1) ? (hv[r >> 1] & 0xffff0000u) : (hv[r >> 1] << 16);
                        const unsigned hw1 = (r & 1) ? (hv[2 + (r >> 1)] & 0xffff0000u) : (hv[2 + (r >> 1)] << 16);
                        v0[r] = __uint_as_float(hw0) + __uint_as_float(pw0) * s0; v1[r] = __uint_as_float(hw1) + __uint_as_float(pw1) * s1;
                    }
                    *(f32x4*)(out + off + bj * HALF) = v0; *(f32x4*)(out + off + bj * HALF + 4) = v1;
                }
                if (m & 1) asm volatile("" ::: "memory");
            }
    }
};
struct MoeOrder1 {
    static constexpr bool GATHER = true;
    const char* A; const char* Bt; const unsigned* ltok; const LAS int* pref; int G, c, Lbeg, Lend;
    __device__ bool next(int i, pg8::Unit& u) const {
        const int L = Lbeg + i * G + c;
        if (c < 0 || L >= Lend) return false;
        const int tile = L >> 1; int e = 0;
#pragma unroll 1
        for (int j = 16; j > 0; j >>= 1) if (pref[e + j] <= tile) e += j;
        const int rt = tile - pref[e]; const int valid = min(256, pref[33 + e] - rt * 256);
        u.pm = tile; u.pn = L & 1; u.e = e; u.aux = valid | (rt << 16); return true;
    }
    __device__ __forceinline__ const char* a_base(const pg8::Unit&) const { return A; }
    __device__ __forceinline__ const char* b_base(const pg8::Unit& u) const { return Bt + ((size_t)u.e * 512 + u.pn * 256) * 1024 * 2; }
    __device__ __forceinline__ int row(const pg8::Unit& u, int r) const { const int valid = u.aux & 0xffff ? (u.aux & 0xffff) : 256; const int rr = r < valid ? r : valid - 1;
        return (int)(ltok[(size_t)u.e * LCAP + (u.aux >> 16) * 256 + rr] & 0x3fffu); }
    __device__ __forceinline__ void a_ready(const pg8::Unit&) const {}
    __device__ __forceinline__ void done(const pg8::Unit&) const {}
};
struct MoeOrder2 {
    static constexpr bool GATHER = false;
    const char* A; const char* Bt; const LAS int* pref; int G, c, Lbeg, Lend;
    __device__ bool next(int i, pg8::Unit& u) const {
        const int L = Lbeg + i * G + c;
        if (c < 0 || L >= Lend) return false;
        const int tile = L >> 2; int e = 0;
#pragma unroll 1
        for (int j = 16; j > 0; j >>= 1) if (pref[e + j] <= tile) e += j;
        const int rt = tile - pref[e]; const int valid = min(256, pref[33 + e] - rt * 256);
        u.pm = tile; u.pn = L & 3; u.e = e; u.aux = valid | (rt << 16); return true;
    }
    __device__ __forceinline__ const char* a_base(const pg8::Unit& u) const { return A + (size_t)u.pm * 256 * 256 * 2; }
    __device__ __forceinline__ const char* b_base(const pg8::Unit& u) const { return Bt + ((size_t)u.e * 1024 + u.pn * 256) * 256 * 2; }
    __device__ __forceinline__ int row(const pg8::Unit&, int r) const { return r; }
    __device__ __forceinline__ void a_ready(const pg8::Unit&) const {}
    __device__ __forceinline__ void done(const pg8::Unit&) const {}
};
struct EpiMoe1 {
    static constexpr bool PERM = true;
    bf16_t* a2; const f32x2* lsc;
    __device__ __forceinline__ void operator()(const pg8::f32x4 (&acc)[2][2][4][2], const pg8::Unit& u, int wr, int wc, int fr, int fq) const {
        using namespace pg8;
        const int rt = u.aux >> 16;
#pragma unroll
        for (int ai = 0; ai < 2; ++ai)
#pragma unroll
            for (int m = 0; m < 4; ++m) {
                const int rl = ai * HALF + wr * 64 + m * 16 + fr;
                const f32x2 sc = lsc[(size_t)u.e * LCAP + rt * 256 + rl];
                const float rs = sc.x, cw = sc.y * sc.x;
                f32x4 o0, o1;
#pragma unroll
                for (int r = 0; r < 4; ++r) {
                    const float g0 = acc[ai][0][m][0][r] * rs, g1 = acc[ai][0][m][1][r] * rs;
                    o0[r] = g0 * __builtin_amdgcn_rcpf(1.f + __builtin_amdgcn_exp2f(-1.4426950408889634f * g0)) * acc[ai][1][m][0][r] * cw;
                    o1[r] = g1 * __builtin_amdgcn_rcpf(1.f + __builtin_amdgcn_exp2f(-1.4426950408889634f * g1)) * acc[ai][1][m][1][r] * cw;
                }
                u32x4 w; w.x = cvt_pk_bf16(o0[0], o0[1]); w.y = cvt_pk_bf16(o0[2], o0[3]); w.z = cvt_pk_bf16(o1[0], o1[1]); w.w = cvt_pk_bf16(o1[2], o1[3]);
                *(u32x4*)(a2 + ((size_t)u.pm * 256 + rl) * 256 + u.pn * 128 + wc * 32 + 8 * fq) = w;
            }
    }
};
struct EpiMoe2 {
    static constexpr bool PERM = true;
    bf16_t* ys; const unsigned* ltok;
    __device__ __forceinline__ void operator()(const pg8::f32x4 (&acc)[2][2][4][2], const pg8::Unit& u, int wr, int wc, int fr, int fq) const {
        using namespace pg8;
        const int rt = u.aux >> 16, valid = u.aux & 0xffff;
#pragma unroll
        for (int ai = 0; ai < 2; ++ai)
#pragma unroll
            for (int m = 0; m < 4; ++m) {
                const int rl = ai * HALF + wr * 64 + m * 16 + fr;
                if (rl < valid) {
                    const unsigned ts = ltok[(size_t)u.e * LCAP + rt * 256 + rl];
                    bf16_t* rowp = ys + ((size_t)(ts >> 16) * T_ + (ts & 0x3fffu)) * D_ + u.pn * 256 + wc * 32 + 8 * fq;
#pragma unroll
                    for (int bj = 0; bj < 2; ++bj) {
                        const f32x4 v0 = acc[ai][bj][m][0], v1 = acc[ai][bj][m][1];
                        u32x4 w; w.x = cvt_pk_bf16(v0[0], v0[1]); w.y = cvt_pk_bf16(v0[2], v0[3]); w.z = cvt_pk_bf16(v1[0], v1[1]); w.w = cvt_pk_bf16(v1[2], v1[3]);
                        *(u32x4*)(rowp + bj * HALF) = w;
                    }
                }
            }
    }
};

__device__ __forceinline__ float wave_sum_x(float v) {
#pragma unroll
    for (int o = 1; o < 64; o <<= 1) v += __shfl_xor(v, o);
    return v;
}
__device__ __forceinline__ unsigned pk2(float lo, float hi) { return f2bf(lo) | (f2bf(hi) << 16); }
__device__ __forceinline__ void p0_transpose_item(const float* W, int K, int N, bf16_t* WT, const float* gain, int mapmode, LAS float* scr, int item, int lane) {
    const int nblk = N / 32, kb = item / nblk, nb = item % nblk, k0 = 64 * kb, n0 = 32 * nb;
#pragma unroll 8
    for (int i = 0; i < 32; ++i) { const int kk = 2 * i + (lane >> 5); float v = W[(size_t)(k0 + kk) * N + n0 + (lane & 31)]; if (gain) v *= gain[k0 + kk]; scr[kk * 33 + (lane & 31)] = v; }
    LDS_WAIT(); asm volatile("" ::: "memory");
    int r0 = n0;
    if (mapmode == 1) { if (n0 >= 1024 && n0 < 2048) { const int cc = n0 & 255; r0 = (n0 & ~255) + 128 * ((cc >> 5) & 1) + 32 * (cc >> 6); } }
    else if (mapmode == 2) r0 = (n0 >> 7) * 256 + (n0 & 127);
    else if (mapmode == 3) r0 = (n0 >> 7) * 256 + 128 + (n0 & 127);
    const int c = lane & 7;
#pragma unroll
    for (int j = 0; j < 4; ++j) { const int n = (lane >> 3) + 8 * j; const LAS float* s = scr + (8 * c) * 33 + n;
        v4u o; o.x = pk2(s[0 * 33], s[1 * 33]); o.y = pk2(s[2 * 33], s[3 * 33]); o.z = pk2(s[4 * 33], s[5 * 33]); o.w = pk2(s[6 * 33], s[7 * 33]);
        *(GAS v4u*)(WT + (size_t)(r0 + n) * K + k0 + 8 * c) = o; }
    LDS_WAIT(); asm volatile("" ::: "memory");
}

typedef short s16x4 __attribute__((ext_vector_type(4)));
__device__ __forceinline__ s16x4 lds_tr16(LAS const void* p) { return __builtin_bit_cast(s16x4, __builtin_amdgcn_ds_read_tr16_b64_v4i16((LAS s16x4*)p)); }
typedef float f32x2_t __attribute__((ext_vector_type(2))); typedef __bf16 bf16x2_t __attribute__((ext_vector_type(2)));
__device__ __forceinline__ unsigned cvt_pk(float lo, float hi) { f32x2_t v = {lo, hi}; bf16x2_t b = __builtin_convertvector(v, bf16x2_t); return __builtin_bit_cast(unsigned, b); }

constexpr int MA_WS_STRIDE = 136, MA_VS_STRIDE = 144, MA_VS_OFF = 128 * MA_WS_STRIDE * 2;
__device__ __forceinline__ void mixa_load_w(LAS unsigned char* lds, const float* wsg, int tid) {
    for (int i = tid; i < 128 * 16; i += NWAVES * 64) {
        const int t = i >> 4, c = i & 15;
        const f32x4 a = *(const f32x4*)(wsg + t * 128 + 8 * c), b = *(const f32x4*)(wsg + t * 128 + 8 * c + 4);
        float v[8] = {a.x, a.y, a.z, a.w, b.x, b.y, b.z, b.w};
#pragma unroll
        for (int j = 0; j < 8; ++j) if (8 * c + j > t) v[j] = 0.f;
        v4u o; o.x = pk2(v[0], v[1]); o.y = pk2(v[2], v[3]); o.z = pk2(v[4], v[5]); o.w = pk2(v[6], v[7]);
        *(LAS v4u*)(lds + (t * MA_WS_STRIDE + 8 * c) * 2) = o;
    }
}
__device__ __forceinline__ void mixa_unit(LAS unsigned char* lds, int u, const bf16_t* UA, const bf16_t* VA, const float* g_v, const float* b_s, bf16_t* YA, int tid, int lane, int wave) {
    const int g = u & 3, bn = u >> 2, t0 = bn * 128, c0 = g * 128;
#pragma unroll
    for (int i = 0; i < 4; ++i) {
        const int s_ = (tid >> 4) + 32 * i, c = tid & 15;
        const v4u raw = *(const GAS v4u*)(VA + (size_t)(t0 + s_) * 512 + c0 + 8 * c);
        float v[8];
#pragma unroll
        for (int j = 0; j < 4; ++j) { v[2 * j] = __uint_as_float(raw[j] << 16); v[2 * j + 1] = __uint_as_float(raw[j] & 0xffff0000u); }
        float ss = 0.f;
#pragma unroll
        for (int j = 0; j < 8; ++j) ss += v[j] * v[j];
        ss += __shfl_xor(ss, 1); ss += __shfl_xor(ss, 2); ss += __shfl_xor(ss, 4); ss += __shfl_xor(ss, 8);
        const float rs = rsqrtf(ss * (1.f / 128.f) + EPS);
        v4u o; o.x = pk2(v[0] * rs, v[1] * rs); o.y = pk2(v[2] * rs, v[3] * rs); o.z = pk2(v[4] * rs, v[5] * rs); o.w = pk2(v[6] * rs, v[7] * rs);
        *(LAS v4u*)(lds + MA_VS_OFF + (s_ * MA_VS_STRIDE + 8 * c) * 2) = o;
    }
    LDS_WAIT(); __syncthreads();
    const int fr = lane & 15, fq = lane >> 4;
    bf16x8 vf[4];
#pragma unroll
    for (int ks = 0; ks < 4; ++ks) {
        LAS const unsigned char* p = lds + MA_VS_OFF + ((32 * ks + 8 * fq + (fr >> 2)) * MA_VS_STRIDE + 16 * wave + 4 * (lane & 3)) * 2;
        const s16x4 lo = lds_tr16(p), hi = lds_tr16(p + 4 * MA_VS_STRIDE * 2);
        vf[ks] = (bf16x8){lo[0], lo[1], lo[2], lo[3], hi[0], hi[1], hi[2], hi[3]};
    }
    const f32x4 gv = *(const f32x4*)(g_v + c0 + 16 * wave + 4 * fq);
#pragma unroll
    for (int j = 0; j < 8; ++j) {
        f32x4 acc = {0.f, 0.f, 0.f, 0.f};
#pragma unroll
        for (int ks = 0; ks < 4; ++ks) if (ks <= (j >> 1)) {
            const bf16x8 wf = *(const LAS bf16x8*)(lds + ((16 * j + fr) * MA_WS_STRIDE + 32 * ks + 8 * fq) * 2);
            acc = __builtin_amdgcn_mfma_f32_16x16x32_bf16(vf[ks], wf, acc, 0, 0, 0);
        }
        const int t = 16 * j + fr;
        const float bias = b_s[g * 128 + t];
        const size_t off = (size_t)(t0 + t) * 512 + c0 + 16 * wave + 4 * fq;
        const v2u ur = *(const GAS v2u*)(UA + off);
        v2u o;
        o.x = pk2(__uint_as_float(ur.x << 16) * (acc[0] * gv[0] + bias), __uint_as_float(ur.x & 0xffff0000u) * (acc[1] * gv[1] + bias));
        o.y = pk2(__uint_as_float(ur.y << 16) * (acc[2] * gv[2] + bias), __uint_as_float(ur.y & 0xffff0000u) * (acc[3] * gv[3] + bias));
        *(GAS v2u*)(YA + off) = o;
    }
    LDS_WAIT(); __syncthreads();
}

__device__ __forceinline__ void combine_row(int m, const bf16_t* YA, const bf16_t* OP, const float* LP, const float* g_out_a, const float* g_out_b, bf16_t* YCAT, int lane) {
    const int nsel = min((m & (S_ - 1)) >> 8, 3);
    const int h = lane >> 3;
    float o[8], l = 0.f;
#pragma unroll
    for (int j = 0; j < 8; ++j) o[j] = 0.f;
#pragma unroll
    for (int sl = 0; sl < 4; ++sl) {
        if (sl == 3 || sl < nsel) {
            const v4u raw = *(const GAS v4u*)(OP + ((size_t)sl * T_ + m) * 512 + 8 * lane);
#pragma unroll
            for (int j = 0; j < 4; ++j) { o[2 * j] += __uint_as_float(raw[j] << 16); o[2 * j + 1] += __uint_as_float(raw[j] & 0xffff0000u); }
            l += LP[((size_t)sl * T_ + m) * 8 + h];
        }
    }
    const float il = 1.f / l;
    float sb = 0.f;
#pragma unroll
    for (int j = 0; j < 8; ++j) { o[j] *= il; sb += o[j] * o[j]; }
    const v4u ar = *(const GAS v4u*)(YA + (size_t)m * 512 + 8 * lane);
    float a[8], sa = 0.f;
#pragma unroll
    for (int j = 0; j < 4; ++j) { a[2 * j] = __uint_as_float(ar[j] << 16); a[2 * j + 1] = __uint_as_float(ar[j] & 0xffff0000u); }
#pragma unroll
    for (int j = 0; j < 8; ++j) sa += a[j] * a[j];
    sa = wave_sum_x(sa); sb = wave_sum_x(sb);
    const float ra = rsqrtf(sa * (1.f / 512.f) + EPS), rb = rsqrtf(sb * (1.f / 512.f) + EPS);
    const f32x4 ga0 = *(const f32x4*)(g_out_a + 8 * lane), ga1 = *(const f32x4*)(g_out_a + 8 * lane + 4);
    const f32x4 gb0 = *(const f32x4*)(g_out_b + 8 * lane), gb1 = *(const f32x4*)(g_out_b + 8 * lane + 4);
    v4u wa, wb;
    wa.x = pk2(a[0] * ra * ga0[0], a[1] * ra * ga0[1]); wa.y = pk2(a[2] * ra * ga0[2], a[3] * ra * ga0[3]); wa.z = pk2(a[4] * ra * ga1[0], a[5] * ra * ga1[1]); wa.w = pk2(a[6] * ra * ga1[2], a[7] * ra * ga1[3]);
    wb.x = pk2(o[0] * rb * gb0[0], o[1] * rb * gb0[1]); wb.y = pk2(o[2] * rb * gb0[2], o[3] * rb * gb0[3]); wb.z = pk2(o[4] * rb * gb1[0], o[5] * rb * gb1[1]); wb.w = pk2(o[6] * rb * gb1[2], o[7] * rb * gb1[3]);
    *(GAS v4u*)(YCAT + (size_t)m * D_ + 8 * lane) = wa;
    *(GAS v4u*)(YCAT + (size_t)m * D_ + 512 + 8 * lane) = wb;
}

__device__ __forceinline__ void gate_task(int task, const bf16_t* QN, const float* KMEAN, unsigned* qcnt, unsigned short* QL, int lane, LAS float* kml  ) {
    const int qq = task & 3; int r = task >> 2; const int i = (r % 15) + 1; r /= 15; const int h = r & 7, b = r >> 3;
    const int s_ = i * 256 + qq * 64 + lane;
    const bf16_t* qp = QN + ((size_t)(b * NH + h) * S_ + s_) * DH;
    float q[64];
#pragma unroll
    for (int c = 0; c < 8; ++c) { const v4u raw = *(const GAS v4u*)(qp + 8 * c);
#pragma unroll
        for (int j = 0; j < 4; ++j) { q[8 * c + 2 * j] = __uint_as_float(raw[j] << 16); q[8 * c + 2 * j + 1] = __uint_as_float(raw[j] & 0xffff0000u); } }
    float v0 = -INFINITY, v1 = -INFINITY, v2 = -INFINITY; int i0 = -1, i1 = -1, i2 = -1;
    const float* kmb = KMEAN + (size_t)((b * NH + h) * NBLK) * DH;
    {
        f32x4 t4[4];
#pragma unroll
        for (int c = 0; c < 4; ++c) t4[c] = *(const GAS f32x4*)(kmb + c * 256 + lane * 4);
#pragma unroll
        for (int c = 0; c < 4; ++c) *(LAS f32x4*)(kml + c * 256 + lane * 4) = t4[c];
        LDS_WAIT(); asm volatile("" ::: "memory");
    }
#pragma unroll 1
    for (int n = 0; n < i; ++n) {
        const LAS float* km = kml + n * DH;
        float sc = 0.f;
#pragma unroll
        for (int d4 = 0; d4 < 16; ++d4) { const f32x4 kv = *(const LAS f32x4*)(km + 4 * d4); sc += q[4 * d4] * kv.x; sc += q[4 * d4 + 1] * kv.y; sc += q[4 * d4 + 2] * kv.z; sc += q[4 * d4 + 3] * kv.w; }
        if (sc > v0) { v2 = v1; i2 = i1; v1 = v0; i1 = i0; v0 = sc; i0 = n; }
        else if (sc > v1) { v2 = v1; i2 = i1; v1 = sc; i1 = n; }
        else if (sc > v2) { v2 = sc; i2 = n; }
    }
    const int lbase = (b * NH + h) * NBLK;
    int mycount = 0;
#pragma unroll 1
    for (int n = 0; n < i; ++n) {
        const unsigned long long mask = __ballot((i0 == n) | (i1 == n) | (i2 == n));
        if (lane == n) mycount = __popcll(mask);
    }
    unsigned mybase = 0;
    if (lane < i && mycount > 0) mybase = __hip_atomic_fetch_add(qcnt + lbase + lane, (unsigned)mycount, RLX_AGENT);
    const unsigned long long lt = (1ull << lane) - 1ull;
#pragma unroll
    for (int k = 0; k < 3; ++k) {
        const int sel = (k == 0) ? i0 : (k == 1) ? i1 : i2;
        const int selc = sel < 0 ? 0 : sel;
        const unsigned base = (unsigned)__shfl((int)mybase, selc);
        int rank = 0;
#pragma unroll 1
        for (int n = 0; n < i; ++n) {
            const unsigned long long mask = __ballot((i0 == n) | (i1 == n) | (i2 == n));
            if (sel == n) rank = __popcll(mask & lt);
        }
        if (sel >= 0) QL[(size_t)(lbase + sel) * 4096 + base + rank] = (unsigned short)(s_ | (k << 12));
    }
}

constexpr int AT_IPREF = XTRA_OFF + 2048, AT_ICNT = XTRA_OFF + 4352, AT_MYIT = XTRA_OFF + 6400;
__device__ __forceinline__ void attn_stage_tile(LAS unsigned char* dst, const bf16_t* src  , int wave, int lane) {
#pragma unroll
    for (int i = 0; i < 4; ++i) {
        const int key = 8 * (wave * 4 + i) + (lane >> 3), ch = (lane & 7) ^ (key & 7);
        __builtin_amdgcn_global_load_lds((const unsigned*)(src + (size_t)key * DH + ch * 8), (LAS unsigned*)(dst + (wave * 4 + i) * 1024), 16, 0, 0);
    }
}
__device__ __forceinline__ bf16x8 scale_bf16x8(const v4u raw, float c) {
    v4u o;
#pragma unroll
    for (int j = 0; j < 4; ++j) o[j] = cvt_pk(__uint_as_float(raw[j] << 16) * c, __uint_as_float(raw[j] & 0xffff0000u) * c);
    return __builtin_bit_cast(bf16x8, o);
}

template <bool OWN>
__device__ __forceinline__ void attn_item(LAS const unsigned char* Kb, LAS const unsigned char* Vb, const bf16x8 (&qf)[2][2], const float MREF, f32x4 (&O)[4][2], float& lsum0, float& lsum1,
                                          const int fr, const int fq, const int lane, const int ql0, const int ql1) {
    bf16x8 KA[2][2], KB[2][2], VA[4], VB[4], P[2];
    f32x4 SA[2][2], SB[2][2];
    const int kb0 = fr * 128 + ((fq ^ (fr & 7)) << 4), kb1 = fr * 128 + (((4 + fq) ^ (fr & 7)) << 4);
    int vb[4];
    { const int kq = 4 * fq + (fr >> 2);
#pragma unroll
      for (int dt = 0; dt < 4; ++dt) vb[dt] = kq * 128 + (((2 * dt + ((lane & 3) >> 1)) ^ (kq & 7)) << 4) + (lane & 1) * 8; }
    const bf16x8 ones = (bf16x8){0x3f80, 0x3f80, 0x3f80, 0x3f80, 0x3f80, 0x3f80, 0x3f80, 0x3f80};
    f32x4 L0 = {0.f, 0.f, 0.f, 0.f}, L1 = {0.f, 0.f, 0.f, 0.f};
    const int emax0 = OWN ? __builtin_amdgcn_readfirstlane(ql0 >> 5) : 7, emax1 = OWN ? __builtin_amdgcn_readfirstlane(ql1 >> 5) : 7;
#define SBAR() __builtin_amdgcn_sched_barrier(0)
#define LDK(e, KF) do { _Pragma("unroll") for (int kt = 0; kt < 2; ++kt) { \
        KF[kt][0] = *(const LAS bf16x8*)(Kb + kb0 + (32 * (e) + 16 * kt) * 128); KF[kt][1] = *(const LAS bf16x8*)(Kb + kb1 + (32 * (e) + 16 * kt) * 128); } } while (0)
#define MMS(e, KF, S) do { _Pragma("unroll") for (int kt = 0; kt < 2; ++kt) { \
        if (!OWN || (e) <= emax0) { f32x4 a = {-MREF, -MREF, -MREF, -MREF}; a = __builtin_amdgcn_mfma_f32_16x16x32_bf16(KF[kt][0], qf[0][0], a, 0, 0, 0); S[kt][0] = __builtin_amdgcn_mfma_f32_16x16x32_bf16(KF[kt][1], qf[0][1], a, 0, 0, 0); } \
        if (!OWN || (e) <= emax1) { f32x4 a = {-MREF, -MREF, -MREF, -MREF}; a = __builtin_amdgcn_mfma_f32_16x16x32_bf16(KF[kt][0], qf[1][0], a, 0, 0, 0); S[kt][1] = __builtin_amdgcn_mfma_f32_16x16x32_bf16(KF[kt][1], qf[1][1], a, 0, 0, 0); } } } while (0)
#define EXPP1(e, S, qi, QL, EMAX) do { if (!OWN || (e) <= EMAX) { \
        _Pragma("unroll") for (int kt = 0; kt < 2; ++kt) _Pragma("unroll") for (int r = 0; r < 4; ++r) { float x = S[kt][qi][r]; \
            if (OWN) { if (32 * (e) + 16 * kt + 4 * fq + r > QL) x = -INFINITY; } S[kt][qi][r] = __builtin_amdgcn_exp2f(x); } \
        v4u w; w.x = cvt_pk(S[0][qi][0], S[0][qi][1]); w.y = cvt_pk(S[0][qi][2], S[0][qi][3]); w.z = cvt_pk(S[1][qi][0], S[1][qi][1]); w.w = cvt_pk(S[1][qi][2], S[1][qi][3]); P[qi] = __builtin_bit_cast(bf16x8, w); } } while (0)
#define EXPP(e, S) do { EXPP1(e, S, 0, ql0, emax0); EXPP1(e, S, 1, ql1, emax1); } while (0)
#define LDV(e, VF) do { _Pragma("unroll") for (int dt = 0; dt < 4; ++dt) { \
            const s16x4 lo = lds_tr16(Vb + vb[dt] + (32 * (e)) * 128); const s16x4 hi = lds_tr16(Vb + vb[dt] + (32 * (e) + 16) * 128); \
            VF[dt] = (bf16x8){lo[0], lo[1], lo[2], lo[3], hi[0], hi[1], hi[2], hi[3]}; } } while (0)
#define MMV(e, VF) do { if (!OWN || (e) <= emax0) L0 = __builtin_amdgcn_mfma_f32_16x16x32_bf16(ones, P[0], L0, 0, 0, 0); \
        if (!OWN || (e) <= emax1) L1 = __builtin_amdgcn_mfma_f32_16x16x32_bf16(ones, P[1], L1, 0, 0, 0); \
        _Pragma("unroll") for (int dt = 0; dt < 4; ++dt) { \
        if (!OWN || (e) <= emax0) O[dt][0] = __builtin_amdgcn_mfma_f32_16x16x32_bf16(VF[dt], P[0], O[dt][0], 0, 0, 0); \
        if (!OWN || (e) <= emax1) O[dt][1] = __builtin_amdgcn_mfma_f32_16x16x32_bf16(VF[dt], P[1], O[dt][1], 0, 0, 0); } } while (0)
    LDK(0, KA); SBAR();
    LDK(1, KB); SBAR(); MMS(0, KA, SA); SBAR();
    LDK(2, KA); LDV(0, VA); SBAR(); MMS(1, KB, SB); EXPP(0, SA); SBAR();
    LDK(3, KB); LDV(1, VB); SBAR(); MMV(0, VA); MMS(2, KA, SA); EXPP(1, SB); SBAR();
    LDK(4, KA); LDV(2, VA); SBAR(); MMV(1, VB); MMS(3, KB, SB); EXPP(2, SA); SBAR();
    LDK(5, KB); LDV(3, VB); SBAR(); MMV(2, VA); MMS(4, KA, SA); EXPP(3, SB); SBAR();
    LDK(6, KA); LDV(4, VA); SBAR(); MMV(3, VB); MMS(5, KB, SB); EXPP(4, SA); SBAR();
    LDK(7, KB); LDV(5, VB); SBAR(); MMV(4, VA); MMS(6, KA, SA); EXPP(5, SB); SBAR();
    LDV(6, VA); SBAR(); MMV(5, VB); MMS(7, KB, SB); EXPP(6, SA); SBAR();
    LDV(7, VB); SBAR(); MMV(6, VA); EXPP(7, SB); SBAR();
    MMV(7, VB);
#undef SBAR
    lsum0 = L0[0]; lsum1 = L1[0];
#undef LDK
#undef MMS
#undef EXPP1
#undef EXPP
#undef LDV
#undef MMV
}
__device__ __forceinline__ void attn_phase(LAS unsigned char* L, const bf16_t* QN, const bf16_t* KN, const bf16_t* VB, const float* g_q, const float* g_k,
                                           const unsigned* qcnt, const unsigned short* QL, bf16_t* OP, float* LP, bf16_t* DUMMY, int vcu, int G, int tid, int lane, int wave) {
    LAS int* ipref = (LAS int*)(L + AT_IPREF); LAS int* icnt = (LAS int*)(L + AT_ICNT); LAS int* myit = (LAS int*)(L + AT_MYIT);
    {
        const int c = (int)__hip_atomic_load(qcnt + tid, RLX_AGENT);
        const int nit = 1 + ((c + 255) >> 8);
        int incl = nit;
#pragma unroll
        for (int o = 1; o < 64; o <<= 1) { const int v = __shfl_up(incl, o); if (lane >= o) incl += v; }
        icnt[tid] = c;
        if (lane == 63) myit[64 + wave] = incl;
        __syncthreads();
        int woff = 0;
        for (int w = 0; w < wave; ++w) woff += myit[64 + w];
        ipref[tid] = woff + incl - nit;
        if (tid == 511) ipref[512] = woff + incl;
        __syncthreads();
    }
    const int nitems = ipref[512];
    const int nmine = (nitems - vcu + G - 1) / G;
    if (tid < nmine && tid < 64) {
        const int Lx = tid * G + vcu; int t = 0;
#pragma unroll 1
        for (int j = 256; j > 0; j >>= 1) if (ipref[t + j] <= Lx) t += j;
        myit[tid] = (t << 8) | (Lx - ipref[t]);
    }
    __syncthreads();
    float gqm = fabsf(g_q[lane]), gkm = fabsf(g_k[lane]);
#pragma unroll
    for (int o = 1; o < 64; o <<= 1) { gqm = fmaxf(gqm, __shfl_xor(gqm, o)); gkm = fmaxf(gkm, __shfl_xor(gkm, o)); }
    const float MREF = 11.6f * gqm * gkm + 0.125f;
    const float CS = 0.125f * 1.4426950408889634f;
    const int fr = lane & 15, fq = lane >> 4;
    const int nloop = nmine < 64 ? nmine : 64;
    if (nloop <= 0) return;
#define AT_DECODE(itw, E0, E1, V0, V1) do { const int t_ = (itw) >> 8, k_ = (itw) & 255; \
        if (k_ == 0) { int l2_ = lane; asm volatile("" : "+v"(l2_)); const int f2_ = l2_ & 15; E0 = ((t_ & 15) * 256 + 16 * wave + f2_) | (3 << 12); E1 = ((t_ & 15) * 256 + 16 * (15 - wave) + f2_) | (3 << 12); V0 = 1; V1 = 1; } \
        else { const int base_ = (k_ - 1) * 256, nq_ = min(256, icnt[t_] - base_); const int q0 = 32 * wave + fr, q1 = q0 + 16; \
               const unsigned short* ql_ = QL + (size_t)t_ * 4096 + base_; V0 = q0 < nq_; V1 = q1 < nq_; \
               const unsigned short* p0_ = ql_ + (V0 ? q0 : 0); const unsigned short* p1_ = ql_ + (V1 ? q1 : 0); \
               asm volatile("global_load_ushort %0, %1, off" : "=v"(E0) : "v"(p0_) : "memory"); asm volatile("global_load_ushort %0, %1, off" : "=v"(E1) : "v"(p1_) : "memory"); } } while (0)
#define AT_QLOAD(itw, E0, E1, QR) do { const int t_ = (itw) >> 8; const int b_ = t_ >> 7, h_ = (t_ >> 4) & 7; \
        const bf16_t* q0_ = QN + ((size_t)(b_ * NH + h_) * S_ + ((E0) & 0xfff)) * DH + 8 * fq; const bf16_t* q1_ = QN + ((size_t)(b_ * NH + h_) * S_ + ((E1) & 0xfff)) * DH + 8 * fq; \
        const bf16_t* q0b_ = q0_ + 32; const bf16_t* q1b_ = q1_ + 32; \
        asm volatile("global_load_dwordx4 %0, %1, off" : "=v"(QR[0]) : "v"(q0_) : "memory"); asm volatile("global_load_dwordx4 %0, %1, off" : "=v"(QR[1]) : "v"(q0b_) : "memory"); \
        asm volatile("global_load_dwordx4 %0, %1, off" : "=v"(QR[2]) : "v"(q1_) : "memory"); asm volatile("global_load_dwordx4 %0, %1, off" : "=v"(QR[3]) : "v"(q1b_) : "memory"); } while (0)
#define AT_STAGE(itw, bufi) do { const int t_ = (itw) >> 8; const int b_ = t_ >> 7, h_ = (t_ >> 4) & 7, j_ = t_ & 15; const size_t r0_ = ((size_t)(b_ * NH + h_) * S_ + j_ * 256) * DH; \
        attn_stage_tile(L + (bufi) * 65536, KN + r0_, wave, lane); attn_stage_tile(L + (bufi) * 65536 + 32768, VB + r0_, wave, lane); } while (0)
    int it0 = myit[0];
    int ec0, ec1, xl0 = 0, xl1 = 0, vc0, vc1, vn0 = 0, vn1 = 0;
    v4u qn[4];
    AT_STAGE(it0, 0);
    AT_DECODE(it0, ec0, ec1, vc0, vc1);
    asm volatile("s_waitcnt vmcnt(0)" : "+v"(ec0), "+v"(ec1) :: "memory");
    AT_QLOAD(it0, ec0, ec1, qn);
    if (nloop > 1) { const int it1 = myit[1]; AT_DECODE(it1, xl0, xl1, vn0, vn1); }
    f32x4 O[4][2]; float lsum0 = 0.f, lsum1 = 0.f; int pe0 = 0, pe1 = 0, ph_ = 0, pb_ = 0;
    LAS unsigned char* ost = L + XTRA_OFF + 8192 + wave * 2304;
#define AT_STORE_PREV() do { _Pragma("unroll") for (int qi = 0; qi < 2; ++qi) { const int e = qi ? pe1 : pe0; \
            _Pragma("unroll") for (int dt = 0; dt < 4; ++dt) { v2u w; w.x = cvt_pk(O[dt][qi][0], O[dt][qi][1]); w.y = cvt_pk(O[dt][qi][2], O[dt][qi][3]); *(LAS v2u*)(ost + fr * 144 + 32 * dt + 8 * fq) = w; } \
            { const size_t row = (size_t)((e >> 12) & 3) * T_ + (size_t)(pb_ * S_ + (e & 0xfff)); float* lpd = ((e & 0x8000) && fq == 0) ? LP + row * 8 + ph_ : (float*)DUMMY + 1024 + lane; *(GAS float*)lpd = qi ? lsum1 : lsum0; } \
            LDS_WAIT(); asm volatile("" ::: "memory"); \
            _Pragma("unroll") for (int hh = 0; hh < 2; ++hh) { const int rq = (lane >> 3) + 8 * hh; const int er = __shfl(e, rq); \
                const v4u val = *(const LAS v4u*)(ost + rq * 144 + (lane & 7) * 16); \
                const size_t row = (size_t)((er >> 12) & 3) * T_ + (size_t)(pb_ * S_ + (er & 0xfff)); bf16_t* od = (er & 0x8000) ? OP + row * 512 + ph_ * 64 + (lane & 7) * 8 : DUMMY + lane * 8; *(GAS v4u*)od = val; } \
            LDS_WAIT(); asm volatile("" ::: "memory"); } } while (0)
    for (int it = 0; it < nloop; ++it) {
        const int itw = myit[it];
        const int t_ = itw >> 8, own = ((itw & 255) == 0);
        const int h_ = (t_ >> 4) & 7;
        if (it == 0) asm volatile("s_waitcnt vmcnt(0) lgkmcnt(0)" : "+v"(qn[0]), "+v"(qn[1]), "+v"(qn[2]), "+v"(qn[3]), "+v"(xl0), "+v"(xl1) :: "memory");
        else asm volatile("s_waitcnt vmcnt(6) lgkmcnt(0)" : "+v"(qn[0]), "+v"(qn[1]), "+v"(qn[2]), "+v"(qn[3]), "+v"(xl0), "+v"(xl1) :: "memory");
        __builtin_amdgcn_s_barrier(); asm volatile("" ::: "memory");
        const int en0 = xl0, en1 = xl1;
        bf16x8 qf[2][2];
        qf[0][0] = scale_bf16x8(qn[0], CS); qf[0][1] = scale_bf16x8(qn[1], CS); qf[1][0] = scale_bf16x8(qn[2], CS); qf[1][1] = scale_bf16x8(qn[3], CS);
        int vx0 = 0, vx1 = 0;
        if (it + 1 < nloop) {
            const int itn = myit[it + 1];
            AT_STAGE(itn, (it + 1) & 1);
            AT_QLOAD(itn, en0, en1, qn);
            if (it + 2 < nloop) { const int itn2 = myit[it + 2]; AT_DECODE(itn2, xl0, xl1, vx0, vx1); }
        }
        asm volatile("" ::: "memory");
        LAS const unsigned char* Kb = L + (it & 1) * 65536; LAS const unsigned char* Vb = Kb + 32768;
        lsum0 = 0.f; lsum1 = 0.f;
#pragma unroll
        for (int dt = 0; dt < 4; ++dt) { O[dt][0] = (f32x4){0.f, 0.f, 0.f, 0.f}; O[dt][1] = (f32x4){0.f, 0.f, 0.f, 0.f}; }
        const int ql0 = (ec0 & 0xff), ql1 = (ec1 & 0xff);
        if (own) attn_item<true>(Kb, Vb, qf, MREF, O, lsum0, lsum1, fr, fq, lane, ql0, ql1);
        else attn_item<false>(Kb, Vb, qf, MREF, O, lsum0, lsum1, fr, fq, lane, ql0, ql1);
        pe0 = ec0 | (vc0 << 15); pe1 = ec1 | (vc1 << 15); ph_ = h_; pb_ = t_ >> 7;
        AT_STORE_PREV();
        ec0 = en0; ec1 = en1; vc0 = vn0; vc1 = vn1; vn0 = vx0; vn1 = vx1;
    }
    asm volatile("s_waitcnt vmcnt(0) lgkmcnt(0)" ::: "memory"); __builtin_amdgcn_s_barrier();
#undef AT_STORE_PREV
#undef AT_DECODE
#undef AT_QLOAD
#undef AT_STAGE
}

__global__ void __launch_bounds__(NWAVES * 64, 2) mk_fwd(Args args) {
    extern __shared__ __attribute__((aligned(16))) unsigned char lds[];
    LAS unsigned char* L = (LAS unsigned char*)lds;
    volatile LAS unsigned* MISC = (volatile LAS unsigned*)(L + MISC_OFF);
    const int tid = threadIdx.x, lane = tid & 63, wave = __builtin_amdgcn_readfirstlane(tid >> 6);
    const int G = gridDim.x; const int bx = blockIdx.x;
    const int vcu = (G % 8 == 0) ? (bx % 8) * (G / 8) + bx / 8 : bx;
    unsigned char* ws = args.ws;
    gu32* ctl = (gu32*)(ws + WS_CTL);
    const float* x = args.in[0]; const float* p_in = args.in[1]; const float* g_mix = args.in[2]; const float* w_in = args.in[3];
    const float* g_q = args.in[7]; const float* g_k = args.in[8];
    const float* w_out = args.in[11]; const float* g_ffn = args.in[12];
    const float* w_gate_e = args.in[15]; const float* w_up_e = args.in[16]; const float* w_down_e = args.in[17];
    const float* g_ple = args.in[18]; const float* w_ple = args.in[19]; const float* w_ple_gate = args.in[20];
    bf16_t* WIN = (bf16_t*)(ws + WS_WIN); bf16_t* WOUT = (bf16_t*)(ws + WS_WOUT); bf16_t* WGU = (bf16_t*)(ws + WS_WGU); bf16_t* WD = (bf16_t*)(ws + WS_WD);
    bf16_t* WPLE = (bf16_t*)(ws + WS_WPLE); bf16_t* WPG = (bf16_t*)(ws + WS_WPG);
    bf16_t* XN = (bf16_t*)(ws + WS_XN); bf16_t* PB = (bf16_t*)(ws + WS_PB); bf16_t* ARR0 = (bf16_t*)(ws + WS_ARR); bf16_t* PW = (bf16_t*)(ws + WS_PW);
    float* KMEAN = (float*)(ws + WS_KMEAN); float* SSQ1 = (float*)(ws + WS_SSQ1);
    const float* w_group = args.in[13]; const float* w_expert = args.in[14];
    bf16_t* YCAT = (bf16_t*)(ws + WS_YCAT); bf16_t* H1B = (bf16_t*)(ws + WS_H1B); bf16_t* A2 = (bf16_t*)(ws + WS_A2); bf16_t* YS = (bf16_t*)(ws + WS_YS); bf16_t* H2B = (bf16_t*)(ws + WS_H2B);
    unsigned* LTOK = (unsigned*)(ws + WS_LTOK); f32x2* LSC = (f32x2*)(ws + WS_LSC); float* RSTD2 = (float*)(ws + WS_RSTD2); bf16_t* WR = (bf16_t*)(ws + WS_WR);
    float* OUT = args.out;
    const float* g_v_a = args.in[4]; const float* w_s = args.in[5]; const float* b_s = args.in[6]; const float* g_out_a = args.in[9]; const float* g_out_b = args.in[10];
    unsigned short* QLp = (unsigned short*)(ws + WS_QL);
    bf16_t* YA = (bf16_t*)(ws + WS_YA); bf16_t* OP = (bf16_t*)args.out; float* LP = (float*)(ws + WS_LP);

    for (int u = tid; u < (LDS_BYTES - LDSCTL_OFF) / 4; u += NWAVES * 64) ((LAS unsigned*)(L + LDSCTL_OFF))[u] = 0u;
    __syncthreads();
    const int lo = args.ph_lo, hi = args.ph_hi;
    const bool multi = (hi - lo) > 1;
    XcdBarrier bar; bar.bar = (unsigned*)(ctl + CW_BAR); bar.x = 0; bar.st = nullptr;
    if (multi) bar = xcd_barrier_post((unsigned*)(ctl + CW_BAR), MISC + 8);
#ifdef PROBE_PHASE
    unsigned long long* TS = (unsigned long long*)(ws + WS_ORC);
#define STAMP(k) do { if (bx == 0 && tid == 0) TS[k] = __builtin_amdgcn_s_memrealtime(); } while (0)
#else
#define STAMP(k) do {} while (0)
#endif
#define IN(k) (lo <= (k) && (k) < hi)
#define SEAM(k) do { if (IN(k) && IN((k) + 1)) xcd_barrier(bar); STAMP((k) + 1); } while (0)

    STAMP(0);
    if (IN(0)) {
        const int gw = vcu * NWAVES + wave, NGW = G * NWAVES;
        {
            constexpr int T_IN = 16 * 10, T_OUT = 16 * 4, T_G = 32 * 16, T_U = T_G, T_D = 32 * 16, T_PLE = 4 * 4, T_PG = 16 * 4;
            constexpr int NTILES = T_IN + T_OUT + T_G + T_U + T_D + T_PLE + T_PG;
            constexpr int NTP = 257, TBUF = 64 * NTP * 4;
#define P0_DECODE(itv, SRC, DST, GAIN, KK, NN, K0, N0, MM) do { int r_ = (itv); int tl_ = 0; MM = 0; \
                if (r_ < T_IN) { SRC = w_in; DST = WIN; GAIN = g_mix; KK = 1024; NN = 2560; MM = 1; tl_ = r_; } \
                else if ((r_ -= T_IN) < T_OUT) { SRC = w_out; DST = WOUT; GAIN = nullptr; KK = 1024; NN = 1024; tl_ = r_; } \
                else if ((r_ -= T_OUT) < T_G) { const int e_ = r_ >> 4; SRC = w_gate_e + (size_t)e_ * 1024 * 256; DST = WGU + (size_t)e_ * 512 * 1024; GAIN = g_ffn; KK = 1024; NN = 256; MM = 2; tl_ = r_ & 15; } \
                else if ((r_ -= T_G) < T_U) { const int e_ = r_ >> 4; SRC = w_up_e + (size_t)e_ * 1024 * 256; DST = WGU + (size_t)e_ * 512 * 1024; GAIN = g_ffn; KK = 1024; NN = 256; MM = 3; tl_ = r_ & 15; } \
                else if ((r_ -= T_U) < T_D) { const int e_ = r_ >> 4; SRC = w_down_e + (size_t)e_ * 256 * 1024; DST = WD + (size_t)e_ * 1024 * 256; GAIN = nullptr; KK = 256; NN = 1024; tl_ = r_ & 15; } \
                else if ((r_ -= T_D) < T_PLE) { SRC = w_ple; DST = WPLE; GAIN = nullptr; KK = 256; NN = 1024; tl_ = r_; } \
                else { r_ -= T_PLE; SRC = w_ple_gate; DST = WPG; GAIN = g_ple; KK = 1024; NN = 1024; tl_ = r_; } \
                const int nblk_ = NN / 256; K0 = 64 * (tl_ / nblk_); N0 = 256 * (tl_ % nblk_); } while (0)
#define P0_LOAD(SRC, GAIN, NN, K0, N0) do { _Pragma("unroll") for (int i_ = 0; i_ < 8; ++i_) { const int kk_ = 8 * wave + i_; \
                pv[i_] = *(const GAS f32x4*)(SRC + (size_t)(K0 + kk_) * NN + N0 + 4 * lane); pg[i_] = GAIN ? GAIN[K0 + kk_] : 1.f; } } while (0)
            const float* csrc = nullptr; bf16_t* cdst = nullptr; const float* cgain = nullptr; int cK = 0, cN = 0, ck0 = 0, cn0 = 0, cmm = 0;
            f32x4 pv[8]; float pg[8];
            int tl = vcu, pbuf = 0;
            if (tl < NTILES) { P0_DECODE(tl, csrc, cdst, cgain, cK, cN, ck0, cn0, cmm); P0_LOAD(csrc, cgain, cN, ck0, cn0); }
            while (tl < NTILES) {
                LAS float* tb = (LAS float*)(L + pbuf * TBUF);
#pragma unroll
                for (int i = 0; i < 8; ++i) { LAS float* d_ = tb + (8 * wave + i) * NTP + 4 * lane; const f32x4 v = pv[i] * pg[i]; d_[0] = v.x; d_[1] = v.y; d_[2] = v.z; d_[3] = v.w; }
                bf16_t* odst = cdst; const int oK = cK, ok0 = ck0, on0 = cn0, omm = cmm;
                const int tln = tl + G;
                LDS_WAIT(); __syncthreads();
                if (tln < NTILES) { P0_DECODE(tln, csrc, cdst, cgain, cK, cN, ck0, cn0, cmm); P0_LOAD(csrc, cgain, cN, ck0, cn0); }
                asm volatile("" ::: "memory");
                const int kc = lane & 7;
#pragma unroll
                for (int j = 0; j < 4; ++j) {
                    const int c = (tid >> 3) + 64 * j;
                    const LAS float* s_ = tb + (8 * kc) * NTP + c;
                    v4u o; o.x = pk2(s_[0 * NTP], s_[1 * NTP]); o.y = pk2(s_[2 * NTP], s_[3 * NTP]); o.z = pk2(s_[4 * NTP], s_[5 * NTP]); o.w = pk2(s_[6 * NTP], s_[7 * NTP]);
                    int drow = on0 + c;
                    if (omm == 1) { if (on0 >= 1024 && on0 < 2048) drow = on0 + 128 * ((c >> 5) & 1) + 32 * (c >> 6) + (c & 31); }
                    else if (omm == 2) drow = (c >> 7) * 256 + (c & 127);
                    else if (omm == 3) drow = (c >> 7) * 256 + 128 + (c & 127);
                    *(GAS v4u*)(odst + (size_t)drow * oK + ok0 + 8 * kc) = o;
                }
                tl = tln; pbuf ^= 1;
            }
            LDS_WAIT(); __syncthreads();
#undef P0_DECODE
#undef P0_LOAD
        }
        for (int m = gw; m < T_; m += 2 * NGW) {
            const GAS f32x4* xr0 = (const GAS f32x4*)(x + (size_t)m * D_) + lane; const GAS f32x4* xr1 = (const GAS f32x4*)(x + (size_t)(m + NGW) * D_) + lane;
            f32x4 v0[4], v1[4]; float s0 = 0.f, s1 = 0.f;
#pragma unroll
            for (int j = 0; j < 4; ++j) { v0[j] = xr0[64 * j]; v1[j] = xr1[64 * j]; }
#pragma unroll
            for (int j = 0; j < 4; ++j) { s0 += (v0[j].x * v0[j].x + v0[j].y * v0[j].y) + (v0[j].z * v0[j].z + v0[j].w * v0[j].w); s1 += (v1[j].x * v1[j].x + v1[j].y * v1[j].y) + (v1[j].z * v1[j].z + v1[j].w * v1[j].w); }
            const float r0 = rsqrtf(wave_sum_x(s0) * (1.f / D_) + EPS), r1 = rsqrtf(wave_sum_x(s1) * (1.f / D_) + EPS);
            GAS v2u* o0 = (GAS v2u*)(XN + (size_t)m * D_) + lane; GAS v2u* o1 = (GAS v2u*)(XN + (size_t)(m + NGW) * D_) + lane;
#pragma unroll
            for (int j = 0; j < 4; ++j) { v2u w; w.x = pk2(v0[j].x * r0, v0[j].y * r0); w.y = pk2(v0[j].z * r0, v0[j].w * r0); o0[64 * j] = w;
                                          v2u w2; w2.x = pk2(v1[j].x * r1, v1[j].y * r1); w2.y = pk2(v1[j].z * r1, v1[j].w * r1); o1[64 * j] = w2; }
        }
        for (int m = gw; m < T_; m += NGW) {
            const f32x4 v = ((const GAS f32x4*)(p_in + (size_t)m * DPLE))[lane];
            v2u w; w.x = pk2(v.x, v.y); w.y = pk2(v.z, v.w);
            ((GAS v2u*)(PB + (size_t)m * DPLE))[lane] = w;
        }
        for (int i = gw * 64 + lane; i < 48 * 1024; i += NGW * 64) {
            const int jj = i >> 10, k = i & 1023; float v = 0.f;
            if (jj < 4) v = w_group[k * 4 + jj] * g_ffn[k];
            else if (jj >= 16) { const int hi = (jj >= 32), g = ((jj - 16) & 15) >> 2, r = jj & 3; v = w_expert[k * 32 + g * 8 + hi * 4 + r] * g_ffn[k]; }
            WR[i] = (bf16_t)f2bf(v);
        }
    }
    SEAM(0);
    if (IN(1)) {
        { pg8::StaticOrder S; S.init(XN, WIN, T_, DIN, D_, G, bx);
          EpiInProj E{ARR0, KMEAN, g_q, g_k};
          pg8::gemm_phase<EpiInProj, pg8::StaticOrder, true>(L + RING_OFF, D_, S, E); }
        { pg8::StaticOrder S; S.init(PB, WPLE, T_, D_, DPLE, G, bx);
          EpiBf16Plain E{PW, D_};
          pg8::gemm_phase<EpiBf16Plain, pg8::StaticOrder, true>(L + RING_OFF, DPLE, S, E); }
    }
    SEAM(1);
    if (IN(2)) {
        { const int gw = vcu * NWAVES + wave, NGW = G * NWAVES;
          for (int task = gw; task < NB_ * NH * 15 * 4; task += NGW) gate_task(task, ARR0 + 2 * ARR, KMEAN, (unsigned*)ctl + CW_QCNT, QLp, lane, (LAS float*)(L + RING_OFF + 81920 + wave * 4096));
          LDS_WAIT(); }
        int curg = -1;
        for (int u = vcu; u < 512; u += G) {
            const int g = u & 3;
            if (g != curg) { mixa_load_w(L + RING_OFF, w_s + (size_t)g * 128 * 128, tid); curg = g; }
            mixa_unit(L + RING_OFF, u, ARR0, ARR0 + ARR, g_v_a, b_s, YA, tid, lane, wave);
        }
    }
    SEAM(2);
    if (IN(3)) attn_phase(L, ARR0 + 2 * ARR, ARR0 + 3 * ARR, ARR0 + 4 * ARR, g_q, g_k, (const unsigned*)ctl + CW_QCNT, QLp, OP, LP, (bf16_t*)(ws + 200 * MiB), vcu, G, tid, lane, wave);
    SEAM(3);
    if (IN(PH_COMB)) {
        const int gw = vcu * NWAVES + wave, NGW = G * NWAVES;
        for (int m = gw; m < T_; m += NGW) combine_row(m, YA, OP, LP, g_out_a, g_out_b, YCAT, lane);
    }
    SEAM(PH_COMB);
    if (IN(5)) {
        pg8::StaticOrder S; S.init(YCAT, WOUT, T_, D_, D_, G, bx);
        EpiOutProj E{x, H1B, SSQ1};
        pg8::gemm_phase<EpiOutProj, pg8::StaticOrder, true>(L + RING_OFF, D_, S, E);
    }
    SEAM(5);
    if (IN(6)) {
        LAS int* hist = (LAS int*)(L + XTRA_OFF); LAS int* hbase = hist + 32;
        for (int chunk = vcu; chunk < T_ / 64; chunk += G) {
            if (tid < 32) hist[tid] = 0;
            __syncthreads();
            int e1 = -1, e2 = -1, rk1 = 0, rk2 = 0, tok = 0; float c1 = 0.f, c2 = 0.f, rs1 = 0.f;
            LAS float* part = (LAS float*)(L + RING_OFF + 100352);
            {
                const int fr = lane & 15, fq = lane >> 4;
                const int t0 = chunk * 64 + (wave & 3) * 16, kh = wave >> 2;
                f32x4 d0 = {0.f, 0.f, 0.f, 0.f}, d1 = d0, d2 = d0;
                const bf16_t* ap = H1B + (size_t)(t0 + fr) * D_ + 8 * fq + kh * 512;
                bf16x8 hf[16];
#pragma unroll
                for (int ks = 0; ks < 16; ++ks) hf[ks] = *(const bf16x8*)(ap + ks * 32);
                const float ssq_tok = SSQ1[t0 + fr];
#pragma unroll
                for (int i = 0; i < 12; ++i) { const int pc = tid + 512 * i, rr = pc >> 7, cc = pc & 127; *(LAS v4u*)(L + RING_OFF + rr * 2064 + cc * 16) = *(const GAS v4u*)(WR + (size_t)rr * D_ + cc * 8); }
                LDS_WAIT(); __syncthreads();
                LAS const unsigned char* bpl = L + RING_OFF + fr * 2064 + (8 * fq + kh * 512) * 2;
#pragma unroll
                for (int ks = 0; ks < 16; ++ks) {
                    const bf16x8 w0 = *(const LAS bf16x8*)(bpl + ks * 64), w1 = *(const LAS bf16x8*)(bpl + 16 * 2064 + ks * 64), w2 = *(const LAS bf16x8*)(bpl + 32 * 2064 + ks * 64);
                    d0 = __builtin_amdgcn_mfma_f32_16x16x32_bf16(w0, hf[ks], d0, 0, 0, 0);
                    d1 = __builtin_amdgcn_mfma_f32_16x16x32_bf16(w1, hf[ks], d1, 0, 0, 0);
                    d2 = __builtin_amdgcn_mfma_f32_16x16x32_bf16(w2, hf[ks], d2, 0, 0, 0);
                }
                if (kh == 1) {
#pragma unroll
                    for (int r = 0; r < 4; ++r) { part[((wave & 3) * 12 + r) * 64 + lane] = d0[r]; part[((wave & 3) * 12 + 4 + r) * 64 + lane] = d1[r]; part[((wave & 3) * 12 + 8 + r) * 64 + lane] = d2[r]; }
                }
                LDS_WAIT(); __syncthreads();
              if (kh == 0) {
#pragma unroll
                for (int r = 0; r < 4; ++r) { d0[r] += part[(wave * 12 + r) * 64 + lane]; d1[r] += part[(wave * 12 + 4 + r) * 64 + lane]; d2[r] += part[(wave * 12 + 8 + r) * 64 + lane]; }
                tok = t0 + fr;
                rs1 = rsqrtf(ssq_tok * (1.f / D_) + EPS);
                float gl[4];
#pragma unroll
                for (int r = 0; r < 4; ++r) gl[r] = __shfl(d0[r], fr) * rs1;
                int gs = 0; float gm = gl[0];
#pragma unroll
                for (int r = 1; r < 4; ++r) if (gl[r] > gm) { gm = gl[r]; gs = r; }
                float den = 0.f;
#pragma unroll
                for (int r = 0; r < 4; ++r) den += __expf(gl[r] - gm);
                const float pg = 1.f / den;
                float el[8];
#pragma unroll
                for (int r = 0; r < 4; ++r) { el[r] = d1[r] * rs1; el[4 + r] = d2[r] * rs1; }
                int a1 = 0; float m1 = el[0];
#pragma unroll
                for (int j = 1; j < 8; ++j) if (el[j] > m1) { m1 = el[j]; a1 = j; }
                int a2 = -1; float m2 = -INFINITY;
#pragma unroll
                for (int j = 0; j < 8; ++j) if (j != a1 && el[j] > m2) { m2 = el[j]; a2 = j; }
                const float ex2 = __expf(m2 - m1);
                if (fq == gs) {
                    e1 = gs * 8 + a1; e2 = gs * 8 + a2; c1 = pg / (1.f + ex2); c2 = pg * ex2 / (1.f + ex2);
                    rk1 = __hip_atomic_fetch_add(hist + e1, 1, __ATOMIC_RELAXED, __HIP_MEMORY_SCOPE_WORKGROUP);
                    rk2 = __hip_atomic_fetch_add(hist + e2, 1, __ATOMIC_RELAXED, __HIP_MEMORY_SCOPE_WORKGROUP);
                }
              }
            }
            __syncthreads();
            if (tid < 32) { const int hc = hist[tid]; hbase[tid] = hc > 0 ? (int)__hip_atomic_fetch_add((unsigned*)ctl + CW_CNT + 64 * tid, (unsigned)hc, RLX_AGENT) : 0; }
            __syncthreads();
            if (e1 >= 0) {
                const int p1 = hbase[e1] + rk1, p2 = hbase[e2] + rk2;
                LTOK[(size_t)e1 * LCAP + p1] = (unsigned)tok; LSC[(size_t)e1 * LCAP + p1] = (f32x2){rs1, c1};
                LTOK[(size_t)e2 * LCAP + p2] = (unsigned)tok | 0x10000u; LSC[(size_t)e2 * LCAP + p2] = (f32x2){rs1, c2};
            }
            __syncthreads();
        }
    }
    SEAM(6);
    if (IN(7) || IN(8) || IN(9)) {
        LAS int* pref = (LAS int*)(L + XTRA_OFF + 1024);
        __syncthreads();
        if (tid < 32) pref[33 + tid] = (int)__hip_atomic_load((unsigned*)ctl + CW_CNT + 64 * tid, RLX_AGENT);
        __syncthreads();
        if (tid == 0) { int acc_ = 0; for (int e = 0; e < 32; ++e) { pref[e] = acc_; acc_ += (pref[33 + e] + 255) >> 8; } pref[32] = acc_; }
        __syncthreads();
    }
    if (IN(7) || IN(8) || IN(9)) {
        const LAS int* pref = (const LAS int*)(L + XTRA_OFF + 1024);
        const int tot = pref[32], U1 = 2 * tot, first = U1 < G ? U1 : G, rem = U1 - first, T1 = first >> 1;
        if (IN(7)) {
            MoeOrder1 S{(const char*)H1B, (const char*)WGU, LTOK, pref, G, bx, 0, first};
            EpiMoe1 E{A2, LSC};
            pg8::gemm_phase<EpiMoe1, MoeOrder1, true>(L + RING_OFF, D_, S, E);
        }
        SEAM(7);
        if (IN(8)) {
            if (bx < rem) {
                MoeOrder1 S{(const char*)H1B, (const char*)WGU, LTOK, pref, rem, bx, first, U1};
                EpiMoe1 E{A2, LSC};
                pg8::gemm_phase<EpiMoe1, MoeOrder1, true>(L + RING_OFF, D_, S, E);
            } else {
                MoeOrder2 S{(const char*)A2, (const char*)WD, pref, G - rem, bx - rem, 0, 4 * T1};
                EpiMoe2 E{YS, LTOK};
                pg8::gemm_phase<EpiMoe2, MoeOrder2, true>(L + RING_OFF, DFF, S, E);
            }
        }
        SEAM(8);
        if (IN(9)) {
            MoeOrder2 S{(const char*)A2, (const char*)WD, pref, G, bx, 4 * T1, 4 * tot};
            EpiMoe2 E{YS, LTOK};
            pg8::gemm_phase<EpiMoe2, MoeOrder2, true>(L + RING_OFF, DFF, S, E);
        }
    }
    SEAM(9);
    if (IN(10)) {
        const int gw = vcu * NWAVES + wave, NGW = G * NWAVES;
        for (int m = gw; m < T_; m += NGW) {
            const GAS v2u* hr = (const GAS v2u*)(H1B + (size_t)m * D_) + lane;
            const GAS v2u* y0 = (const GAS v2u*)(YS + (size_t)m * D_) + lane; const GAS v2u* y1 = (const GAS v2u*)(YS + (size_t)(T_ + m) * D_) + lane;
            GAS v2u* hb = (GAS v2u*)(H2B + (size_t)m * D_) + lane;
            float s = 0.f;
#pragma unroll
            for (int j = 0; j < 4; ++j) {
                const v2u hq = hr[64 * j]; const v2u a = y0[64 * j], b = y1[64 * j];
                f32x4 v; v.x = __uint_as_float(hq.x << 16); v.y = __uint_as_float(hq.x & 0xffff0000u); v.z = __uint_as_float(hq.y << 16); v.w = __uint_as_float(hq.y & 0xffff0000u);
                v.x += __uint_as_float(a.x << 16) + __uint_as_float(b.x << 16); v.y += __uint_as_float(a.x & 0xffff0000u) + __uint_as_float(b.x & 0xffff0000u);
                v.z += __uint_as_float(a.y << 16) + __uint_as_float(b.y << 16); v.w += __uint_as_float(a.y & 0xffff0000u) + __uint_as_float(b.y & 0xffff0000u);
                v2u w; w.x = pk2(v.x, v.y); w.y = pk2(v.z, v.w); hb[64 * j] = w;
                s += (v.x * v.x + v.y * v.y) + (v.z * v.z + v.w * v.w);
            }
            s = wave_sum_x(s);
            if (lane == 0) RSTD2[m] = rsqrtf(s * (1.f / D_) + EPS);
        }
    }
    SEAM(10);
    if (IN(11)) {
        pg8::StaticOrder S; S.init(H2B, WPG, T_, D_, D_, G, bx);
        EpiPleGate E{OUT, PW, RSTD2, H2B};
        pg8::gemm_phase<EpiPleGate, pg8::StaticOrder, true>(L + RING_OFF, D_, S, E);
    }
#ifdef PROBE_PHASE
    if (multi) { xcd_barrier(bar); STAMP(12);
        if (bx == 0 && tid == 0) { const float us = (float)(TS[PROBE_PHASE + 1] - TS[PROBE_PHASE]) * 0.01f; OUT[0] += us; } }
#endif
#undef IN
#undef SEAM
}

extern "C" void kernel_launch(void* const* d_in, const int* in_sizes, int n_in, void* d_out, int out_size, void* d_ws, size_t ws_size, hipStream_t stream) {
    using namespace orc;
    const float* x = (const float*)d_in[0];
    const float* p = (const float*)d_in[1];
    const float* g_mix = (const float*)d_in[2];
    const float* w_in = (const float*)d_in[3];
    const float* g_v_a = (const float*)d_in[4];
    const float* w_s = (const float*)d_in[5];
    const float* b_s = (const float*)d_in[6];
    const float* g_q = (const float*)d_in[7];
    const float* g_k = (const float*)d_in[8];
    const float* g_out_a = (const float*)d_in[9];
    const float* g_out_b = (const float*)d_in[10];
    const float* w_out = (const float*)d_in[11];
    const float* g_ffn = (const float*)d_in[12];
    const float* w_group = (const float*)d_in[13];
    const float* w_expert = (const float*)d_in[14];
    const float* w_gate_e = (const float*)d_in[15];
    const float* w_up_e = (const float*)d_in[16];
    const float* w_down_e = (const float*)d_in[17];
    const float* g_ple = (const float*)d_in[18];
    const float* w_ple = (const float*)d_in[19];
    const float* w_ple_gate = (const float*)d_in[20];
    float* out = (float*)d_out;
    char* ws = (char*)d_ws;
    (void)g_mix; (void)w_in; (void)p; (void)w_ple; (void)w_out; (void)g_ffn; (void)w_group; (void)w_expert; (void)w_gate_e; (void)w_up_e; (void)w_down_e; (void)g_ple; (void)w_ple_gate; (void)x;

    static int grid = 0;
    if (grid == 0) {
        int dev = 0, cus = 0, per_cu = 0;
        if (hipGetDevice(&dev) != hipSuccess || hipDeviceGetAttribute(&cus, hipDeviceAttributeMultiprocessorCount, dev) != hipSuccess) { fprintf(stderr, "kernel_launch: device query failed\n"); grid = -1; return; }
        if (hipFuncSetAttribute((const void*)mk_fwd, hipFuncAttributeMaxDynamicSharedMemorySize, LDS_BYTES) != hipSuccess) { fprintf(stderr, "kernel_launch: hipFuncSetAttribute(%d) failed\n", LDS_BYTES); grid = -1; return; }
        if (hipOccupancyMaxActiveBlocksPerMultiprocessor(&per_cu, (const void*)mk_fwd, NWAVES * 64, LDS_BYTES) != hipSuccess || per_cu < 1) { fprintf(stderr, "kernel_launch: occupancy query says %d\n", per_cu); per_cu = 1; }
        (void)hipGetLastError();
        grid = cus * 1;
        if (ws_size < 256 * MiB) { fprintf(stderr, "kernel_launch: workspace too small\n"); grid = -1; return; }
    }
    if (grid < 0) return;
    hipMemsetAsync(ws + WS_CTL, 0, ZERO_BYTES, stream);
    Args a{};
    for (int i = 0; i < 21; ++i) a.in[i] = (const float*)d_in[i];
    a.out = out; a.ws = (unsigned char*)d_ws; a.li = 0; a.pad = 0;

    float* rstd_va = (float*)(ws + WS_ORC);
    int* sel = (int*)(ws + WS_ORC + 512 * 1024);
    Route* route = (Route*)(ws + WS_ORC + 2 * MiB);
    float* rstd_h = (float*)(ws + WS_ORC + 2 * MiB + 512 * 1024);
    float* rstd_h2 = (float*)(ws + WS_ORC + 3 * MiB);
    float* kmean = (float*)(ws + WS_KMEAN);
    const bf16_t* ua = (const bf16_t*)(ws + WS_ARR); const bf16_t* va = ua + ARR; const bf16_t* qn = ua + 2 * ARR; const bf16_t* kn = ua + 3 * ARR; const bf16_t* vb = ua + 4 * ARR;
    const bf16_t* pwb = (const bf16_t*)(ws + WS_PW);

#ifndef ONE_LAUNCH
#define ONE_LAUNCH 1
#endif
#ifndef LEVEL
#define LEVEL 4
#endif
#ifndef ATT_ORACLE
#define ATT_ORACLE 0
#endif
#define LAUNCH_PH(lo_, hi_) do { a.ph_lo = (lo_); a.ph_hi = (hi_); hipLaunchKernelGGL(mk_fwd, dim3(grid), dim3(NWAVES * 64), LDS_BYTES, stream, a); } while (0)
#if ONE_LAUNCH
    LAUNCH_PH(0, 12);
    (void)ua; (void)va; (void)qn; (void)kn; (void)vb; (void)sel; (void)kmean; (void)rstd_va; (void)route; (void)rstd_h; (void)rstd_h2; (void)pwb; (void)g_v_a; (void)w_s; (void)b_s; (void)g_q; (void)g_k; (void)g_out_a; (void)g_out_b;
#else
    LAUNCH_PH(0, 1); LAUNCH_PH(1, 2);
    LAUNCH_PH(2, 3);
#if ATT_ORACLE
    bf16_t* op = (bf16_t*)out; float* lp = (float*)(ws + WS_LP);
    hipMemsetAsync(op, 0, (size_t)3 * T_ * 512 * 2, stream);
    hipMemsetAsync(lp, 0, (size_t)3 * T_ * 8 * 4, stream);
    k_fill<<<T_ * 8 / 256, 256, 0, stream>>>(lp + (size_t)3 * T_ * 8, 1.0f, T_ * 8, 0);
    k_gate<bf16_t><<<T_ * NH / 256, 256, 0, stream>>>(qn, kmean, sel);
    k_attn<bf16_t, bf16_t><<<T_ * NH, 256, 0, stream>>>(qn, kn, vb, sel, op + (size_t)3 * T_ * 512, 512, 0);
#else
    LAUNCH_PH(3, 4);
    (void)qn; (void)kn; (void)vb; (void)sel; (void)kmean;
#endif
    LAUNCH_PH(4, 5);
    (void)ua; (void)va; (void)rstd_va; (void)g_v_a; (void)w_s; (void)b_s; (void)g_out_a; (void)g_out_b;
#if LEVEL >= 2
    LAUNCH_PH(5, 6);
#else
    k_sgemm<<<dim3(D_ / 64, T_ / 64), 256, 0, stream>>>((long)D_, ALPlain<bf16_t>{ycat, D_, 0}, BLPlain{w_out, D_, 0}, EPResid{x, out, D_, 0});
#endif
#if LEVEL >= 3
    LAUNCH_PH(6, 7); LAUNCH_PH(7, 8); LAUNCH_PH(8, 9); LAUNCH_PH(9, 10); LAUNCH_PH(10, 11);
#if LEVEL >= 4
    LAUNCH_PH(11, 12);
#else
    float* h2 = (float*)(ws);
    hipMemcpyAsync(h2, out, (size_t)T_ * D_ * 4, hipMemcpyDeviceToDevice, stream);
    k_row_rstd<float><<<T_ / 4, 256, 0, stream>>>(h2, rstd_h2, T_, D_, D_, 0);
    k_sgemm<<<dim3(D_ / 64, T_ / 64), 256, 0, stream>>>((long)D_, ALScaled<float>{h2, rstd_h2, g_ple, D_, 0}, BLPlain{w_ple_gate, D_, 0}, EPPle<bf16_t>{h2, pwb, out, D_, 0});
#endif
#else
    float* h2 = (float*)(ws + 90 * MiB);
    k_row_rstd<float><<<T_ / 4, 256, 0, stream>>>(out, rstd_h, T_, D_, D_, 0);
    k_route<<<T_ / 4, 256, 0, stream>>>(out, rstd_h, g_ffn, w_group, w_expert, route);
    k_moe<<<T_, 256, 0, stream>>>(out, rstd_h, g_ffn, route, w_gate_e, w_up_e, w_down_e, h2);
    k_row_rstd<float><<<T_ / 4, 256, 0, stream>>>(h2, rstd_h2, T_, D_, D_, 0);
    k_sgemm<<<dim3(D_ / 64, T_ / 64), 256, 0, stream>>>((long)D_, ALScaled<float>{h2, rstd_h2, g_ple, D_, 0}, BLPlain{w_ple_gate, D_, 0}, EPPle<bf16_t>{h2, pwb, out, D_, 0});
#endif
#endif
}
```

```cpp
#include <hip/hip_runtime.h>
#include <math.h>
#include <stdint.h>
#include <cstdio>

#ifndef MODE
#define MODE 1
#endif

typedef unsigned short bf16_t;
constexpr int NB_ = 4, S_ = 4096, D_ = 1024, T_ = NB_ * S_;
constexpr int DIN = 2560, NH = 8, DH = 64, BLK = 256, NBLK = 16;
constexpr int NE = 32, DFF = 256, DPLE = 256;
constexpr float EPS = 1e-6f;
constexpr size_t MiB = 1u << 20;
constexpr size_t ARR = (size_t)T_ * 512;

__host__ __device__ __forceinline__ unsigned f2bf(float f) { unsigned u = __builtin_bit_cast(unsigned, f); return (u + 0x7fffu + ((u >> 16) & 1u)) >> 16; }
__device__ __forceinline__ float bf2f(unsigned h) { return __uint_as_float(h << 16); }
__device__ __forceinline__ float ldv(const float* p, size_t i) { return p[i]; }
__device__ __forceinline__ float ldv(const bf16_t* p, size_t i) { return bf2f((unsigned)p[i]); }
__device__ __forceinline__ void stv(float* p, size_t i, float v) { p[i] = v; }
__device__ __forceinline__ void stv(bf16_t* p, size_t i, float v) { p[i] = (bf16_t)f2bf(v); }

namespace orc {
__device__ __forceinline__ float gelu_tanh(float x) {
    const float c = 0.7978845608028654f;
    return 0.5f * x * (1.f + tanhf(c * (x + 0.044715f * x * x * x)));
}
__device__ __forceinline__ float sigmoidf_(float x) { return 1.f / (1.f + expf(-x)); }
__device__ __forceinline__ float wave_sum(float v) {
#pragma unroll
    for (int o = 32; o > 0; o >>= 1) v += __shfl_xor(v, o);
    return v;
}
template <class TI>
__global__ void __launch_bounds__(256) k_row_rstd(const TI* __restrict__ x, float* __restrict__ rstd, int nrows, int ncols, int ld, int pad_) {
    const int row = blockIdx.x * 4 + (threadIdx.x >> 6), lane = threadIdx.x & 63;
    if (row >= nrows) return;
    float s = 0.f;
    for (int c = lane; c < ncols; c += 64) { const float v = ldv(x, (size_t)row * ld + c); s += v * v; }
    s = wave_sum(s);
    if (lane == 0) rstd[row] = rsqrtf(s / (float)ncols + EPS);
}
template <class TO>
__global__ void __launch_bounds__(256) k_rownorm_inplace(TO* __restrict__ y, const float* __restrict__ g, int nrows, int ncols, int ld, int c0) {
    const int row = blockIdx.x * 4 + (threadIdx.x >> 6), lane = threadIdx.x & 63;
    if (row >= nrows) return;
    float s = 0.f;
    for (int c = lane; c < ncols; c += 64) { const float v = ldv(y, (size_t)row * ld + c0 + c); s += v * v; }
    s = wave_sum(s);
    const float r = rsqrtf(s / (float)ncols + EPS);
    for (int c = lane; c < ncols; c += 64) { const size_t i = (size_t)row * ld + c0 + c; stv(y, i, ldv(y, i) * r * g[c]); }
}
template <class AL, class BL, class EP>
__global__ void __launch_bounds__(256) k_sgemm(long K, AL al, BL bl, EP ep) {
    __shared__ float As[16][65];
    __shared__ float Bs[16][65];
    const int tx = threadIdx.x & 15, ty = threadIdx.x >> 4;
    const int m0 = blockIdx.y * 64, n0 = blockIdx.x * 64;
    float acc[4][4];
#pragma unroll
    for (int i = 0; i < 4; ++i)
#pragma unroll
        for (int j = 0; j < 4; ++j) acc[i][j] = 0.f;
    for (int k0 = 0; k0 < K; k0 += 16) {
#pragma unroll
        for (int r = 0; r < 4; ++r) { const int i = threadIdx.x + r * 256; const int m = i >> 4, k = i & 15; As[k][m] = al(m0 + m, k0 + k); }
#pragma unroll
        for (int r = 0; r < 4; ++r) { const int i = threadIdx.x + r * 256; const int k = i >> 6, n = i & 63; Bs[k][n] = bl(k0 + k, n0 + n); }
        __syncthreads();
#pragma unroll
        for (int k = 0; k < 16; ++k) {
            float a[4], b[4];
#pragma unroll
            for (int i = 0; i < 4; ++i) a[i] = As[k][ty * 4 + i];
#pragma unroll
            for (int j = 0; j < 4; ++j) b[j] = Bs[k][tx * 4 + j];
#pragma unroll
            for (int i = 0; i < 4; ++i)
#pragma unroll
                for (int j = 0; j < 4; ++j) acc[i][j] += a[i] * b[j];
        }
        __syncthreads();
    }
#pragma unroll
    for (int i = 0; i < 4; ++i)
#pragma unroll
        for (int j = 0; j < 4; ++j) ep(m0 + ty * 4 + i, n0 + tx * 4 + j, acc[i][j]);
}
template <class TI> struct ALScaled { const TI* x; const float* rstd; const float* g; int ld; int pad;
    __device__ float operator()(int m, int k) const { return ldv(x, (size_t)m * ld + k) * rstd[m] * g[k]; } };
template <class TI> struct ALPlain { const TI* x; int ld; int pad;
    __device__ float operator()(int m, int k) const { return ldv(x, (size_t)m * ld + k); } };
struct BLPlain { const float* w; int ld; int pad;
    __device__ float operator()(int k, int n) const { return w[(size_t)k * ld + n]; } };
struct EPStore { float* c; int ld; int pad;
    __device__ void operator()(int m, int n, float v) const { c[(size_t)m * ld + n] = v; } };
struct EPSplit5 { float* a0;
    __device__ void operator()(int m, int n, float v) const { a0[(size_t)(n >> 9) * ARR + (size_t)m * 512 + (n & 511)] = v; } };
struct EPResid { const float* r; float* c; int ld; int pad;
    __device__ void operator()(int m, int n, float v) const { c[(size_t)m * ld + n] = r[(size_t)m * ld + n] + v; } };
template <class TP> struct EPPle { const float* h; const TP* pw; float* c; int ld; int pad;
    __device__ void operator()(int m, int n, float v) const { const size_t i = (size_t)m * ld + n; c[i] = h[i] + ldv(pw, i) * sigmoidf_(v); } };

__global__ void __launch_bounds__(256) k_post_gelu(float* __restrict__ a0) {
    const size_t i = (size_t)blockIdx.x * 256 + threadIdx.x;
    a0[i] = gelu_tanh(a0[i]);
}
__global__ void __launch_bounds__(256) k_qknorm(float* __restrict__ a0, const float* __restrict__ g_q, const float* __restrict__ g_k) {
    const int idx = blockIdx.x * 256 + threadIdx.x;
    if (idx >= T_ * 16) return;
    const int t = idx >> 4, which = (idx >> 3) & 1, h = idx & 7;
    float* p = a0 + (size_t)(2 + which) * ARR + (size_t)t * 512 + h * 64;
    const float* g = which ? g_k : g_q;
    float s = 0.f;
    for (int d = 0; d < 64; ++d) s += p[d] * p[d];
    const float r = rsqrtf(s / 64.f + EPS);
    for (int d = 0; d < 64; ++d) p[d] = p[d] * r * g[d];
}
template <class TI>
__global__ void __launch_bounds__(256) k_va_rstd(const TI* __restrict__ va, float* __restrict__ rstd_va) {
    const int idx = blockIdx.x * 4 + (threadIdx.x >> 6), lane = threadIdx.x & 63;
    const int t = idx >> 2, g = idx & 3;
    float s = 0.f;
    for (int d = lane; d < 128; d += 64) { const float v = ldv(va, (size_t)t * 512 + g * 128 + d); s += v * v; }
    s = wave_sum(s);
    if (lane == 0) rstd_va[idx] = rsqrtf(s / 128.f + EPS);
}
template <class TI, class TO>
__global__ void __launch_bounds__(256) k_mixa(const TI* __restrict__ ua, const TI* __restrict__ va, const float* __restrict__ rstd_va, const float* __restrict__ g_v,
                                              const float* __restrict__ w_s, const float* __restrict__ b_s, TO* __restrict__ ycat) {
    const int bc = blockIdx.x, g = blockIdx.y;
    const int t0 = bc * 128;
    for (int o = threadIdx.x; o < 128 * 128; o += 256) {
        const int tl = o >> 7, d = o & 127;
        float acc = 0.f;
        for (int s = 0; s <= tl; ++s) {
            const float v = ldv(va, (size_t)(t0 + s) * 512 + g * 128 + d) * rstd_va[(t0 + s) * 4 + g] * g_v[g * 128 + d];
            acc += w_s[((size_t)g * 128 + tl) * 128 + s] * v;
        }
        acc += b_s[g * 128 + tl];
        const float u = ldv(ua, (size_t)(t0 + tl) * 512 + g * 128 + d);
        stv(ycat, (size_t)(t0 + tl) * D_ + g * 128 + d, u * acc);
    }
}
template <class TI>
__global__ void __launch_bounds__(256) k_kmean(const TI* __restrict__ kn, float* __restrict__ kmean) {
    const int idx = blockIdx.x * 256 + threadIdx.x;
    if (idx >= NB_ * NH * NBLK * DH) return;
    const int d = idx & 63, n = (idx >> 6) & 15, h = (idx >> 10) & 7, b = idx >> 13;
    float s = 0.f;
    for (int r = 0; r < BLK; ++r) s += ldv(kn, (size_t)(b * S_ + n * BLK + r) * 512 + h * 64 + d);
    kmean[idx] = s / (float)BLK;
}
template <class TI>
__global__ void __launch_bounds__(256) k_gate(const TI* __restrict__ qn, const float* __restrict__ kmean, int* __restrict__ sel) {
    const int idx = blockIdx.x * 256 + threadIdx.x;
    if (idx >= T_ * NH) return;
    const int t = idx >> 3, h = idx & 7, b = t / S_, s = t % S_, qb = s / BLK;
    float v0 = -INFINITY, v1 = -INFINITY, v2 = -INFINITY; int i0 = -1, i1 = -1, i2 = -1;
    for (int n = 0; n < qb; ++n) {
        const float* km = kmean + ((size_t)(b * NH + h) * NBLK + n) * DH;
        float sc = 0.f;
        for (int d = 0; d < 64; ++d) sc += ldv(qn, (size_t)t * 512 + h * 64 + d) * km[d];
        if (sc > v0) { v2 = v1; i2 = i1; v1 = v0; i1 = i0; v0 = sc; i0 = n; }
        else if (sc > v1) { v2 = v1; i2 = i1; v1 = sc; i1 = n; }
        else if (sc > v2) { v2 = sc; i2 = n; }
    }
    sel[idx * 3 + 0] = i0; sel[idx * 3 + 1] = i1; sel[idx * 3 + 2] = i2;
}
template <class TI, class TO>
__global__ void __launch_bounds__(256) k_attn(const TI* __restrict__ qn, const TI* __restrict__ kn, const TI* __restrict__ vb, const int* __restrict__ sel, TO* __restrict__ ycat, int ldo, int coff) {
    __shared__ float qs[64];
    __shared__ float ps[4][256];
    __shared__ float red[4];
    __shared__ float part[4][64];
    const int idx = blockIdx.x;
    const int t = idx >> 3, h = idx & 7, b = t / S_, s = t % S_, qb = s / BLK;
    const int tid = threadIdx.x, lane = tid & 63, wid = tid >> 6;
    if (tid < 64) qs[tid] = ldv(qn, (size_t)t * 512 + h * 64 + tid);
    __syncthreads();
    const int b0 = sel[idx * 3 + 0], b1 = sel[idx * 3 + 1], b2 = sel[idx * 3 + 2], b3 = qb;
    float sc[4];
    float mx = -INFINITY;
#pragma unroll
    for (int j = 0; j < 4; ++j) {
        const int bj = (j == 0) ? b0 : (j == 1) ? b1 : (j == 2) ? b2 : b3;
        sc[j] = -INFINITY;
        if (bj >= 0) {
            const int kpos = bj * BLK + tid;
            if (j < 3 || kpos <= s) {
                float a = 0.f;
                for (int d = 0; d < 64; ++d) a += qs[d] * ldv(kn, (size_t)(b * S_ + kpos) * 512 + h * 64 + d);
                sc[j] = a * 0.125f;
            }
        }
        mx = fmaxf(mx, sc[j]);
    }
#pragma unroll
    for (int o = 32; o > 0; o >>= 1) mx = fmaxf(mx, __shfl_xor(mx, o));
    if (lane == 0) red[wid] = mx;
    __syncthreads();
    mx = fmaxf(fmaxf(red[0], red[1]), fmaxf(red[2], red[3]));
    __syncthreads();
    float sum = 0.f;
#pragma unroll
    for (int j = 0; j < 4; ++j) { const float p = (sc[j] == -INFINITY) ? 0.f : expf(sc[j] - mx); ps[j][tid] = p; sum += p; }
    sum = wave_sum(sum);
    if (lane == 0) red[wid] = sum;
    __syncthreads();
    sum = red[0] + red[1] + red[2] + red[3];
    float o = 0.f;
    {
        const int j = wid;
        const int bj = (j == 0) ? b0 : (j == 1) ? b1 : (j == 2) ? b2 : b3;
        if (bj >= 0) {
            for (int k = 0; k < 256; ++k) {
                const float p = ps[j][k];
                if (p != 0.f) o += p * ldv(vb, (size_t)(b * S_ + bj * BLK + k) * 512 + h * 64 + lane);
            }
        }
    }
    part[wid][lane] = o;
    __syncthreads();
    if (tid < 64) stv(ycat, (size_t)t * ldo + coff + h * 64 + tid, (part[0][tid] + part[1][tid] + part[2][tid] + part[3][tid]) / sum);
}
__global__ void __launch_bounds__(256) k_fill(float* __restrict__ p, float v, int n, int pad_) { const int i = blockIdx.x * 256 + threadIdx.x; if (i < n) p[i] = v; }
struct Route { int e1, e2; float c1, c2; };
__global__ void __launch_bounds__(256) k_route(const float* __restrict__ h, const float* __restrict__ rstd, const float* __restrict__ g,
                                               const float* __restrict__ w_group, const float* __restrict__ w_expert, Route* __restrict__ route) {
    const int t = blockIdx.x * 4 + (threadIdx.x >> 6), lane = threadIdx.x & 63;
    float acc[36];
#pragma unroll
    for (int j = 0; j < 36; ++j) acc[j] = 0.f;
    const float r = rstd[t];
    for (int k = lane; k < D_; k += 64) {
        const float xv = h[(size_t)t * D_ + k] * r * g[k];
#pragma unroll
        for (int j = 0; j < 4; ++j) acc[j] += xv * w_group[k * 4 + j];
#pragma unroll
        for (int j = 0; j < 32; ++j) acc[4 + j] += xv * w_expert[k * 32 + j];
    }
#pragma unroll
    for (int j = 0; j < 36; ++j) acc[j] = wave_sum(acc[j]);
    if (lane == 0) {
        int gs = 0; float gm = acc[0];
#pragma unroll
        for (int j = 1; j < 4; ++j) if (acc[j] > gm) { gm = acc[j]; gs = j; }
        float den = 0.f;
#pragma unroll
        for (int j = 0; j < 4; ++j) den += expf(acc[j] - gm);
        const float pg = 1.f / den;
        float el[8];
#pragma unroll
        for (int j = 0; j < 8; ++j) {
            float v = acc[4 + j];
#pragma unroll
            for (int gg = 1; gg < 4; ++gg) v = (gs == gg) ? acc[4 + gg * 8 + j] : v;
            el[j] = v;
        }
        int a1 = 0; float m1 = el[0];
#pragma unroll
        for (int j = 1; j < 8; ++j) if (el[j] > m1) { m1 = el[j]; a1 = j; }
        int a2 = -1; float m2 = -INFINITY;
#pragma unroll
        for (int j = 0; j < 8; ++j) if (j != a1 && el[j] > m2) { m2 = el[j]; a2 = j; }
        const float e2 = expf(m2 - m1);
        Route rt; rt.e1 = gs * 8 + a1; rt.e2 = gs * 8 + a2; rt.c1 = pg / (1.f + e2); rt.c2 = pg * e2 / (1.f + e2);
        route[t] = rt;
    }
}
__global__ void __launch_bounds__(256) k_moe(const float* __restrict__ h, const float* __restrict__ rstd, const float* __restrict__ g, const Route* __restrict__ route,
                                             const float* __restrict__ wg, const float* __restrict__ wu, const float* __restrict__ wd, float* __restrict__ h2) {
    __shared__ float xs[D_];
    __shared__ float as[DFF];
    const int t = blockIdx.x, tid = threadIdx.x;
    const float r = rstd[t];
    for (int k = tid; k < D_; k += 256) xs[k] = h[(size_t)t * D_ + k] * r * g[k];
    __syncthreads();
    const Route rt = route[t];
    float out[4] = {0.f, 0.f, 0.f, 0.f};
    for (int slot = 0; slot < 2; ++slot) {
        const int e = slot ? rt.e2 : rt.e1; const float cw = slot ? rt.c2 : rt.c1;
        const float* pg_ = wg + (size_t)e * D_ * DFF; const float* pu_ = wu + (size_t)e * D_ * DFF; const float* pd_ = wd + (size_t)e * DFF * D_;
        float hh = 0.f, uu = 0.f;
        for (int k = 0; k < D_; ++k) { const float xv = xs[k]; hh += xv * pg_[(size_t)k * DFF + tid]; uu += xv * pu_[(size_t)k * DFF + tid]; }
        __syncthreads();
        as[tid] = hh * sigmoidf_(hh) * uu * cw;
        __syncthreads();
        for (int f = 0; f < DFF; ++f) {
            const float a = as[f];
#pragma unroll
            for (int i = 0; i < 4; ++i) out[i] += a * pd_[(size_t)f * D_ + tid + 256 * i];
        }
    }
#pragma unroll
    for (int i = 0; i < 4; ++i) h2[(size_t)t * D_ + tid + 256 * i] = h[(size_t)t * D_ + tid + 256 * i] + out[i];
}
}

namespace pg8 {
#define PG8_LAS __attribute__((address_space(3)))
typedef short bf16x8 __attribute__((ext_vector_type(8)));
typedef float f32x4 __attribute__((ext_vector_type(4)));
typedef float f32x2 __attribute__((ext_vector_type(2)));
typedef unsigned u32x4 __attribute__((ext_vector_type(4)));
typedef unsigned u32x2 __attribute__((ext_vector_type(2)));
constexpr int BM = 256, BK = 64, HALF = 128, HTB = HALF * BK * 2, STAGE_BYTES = 8 * HTB, NXCD = 8, WGM = 8;

__host__ __device__ __forceinline__ int lds_byte(int r, int c) { const int st = (r >> 4) * 2 + (c >> 5), rr = r & 15, cc = c & 31, ob = rr * 64 + cc * 2; return st * 1024 + (ob ^ (((ob >> 9) & 1) << 5)); }
__host__ __device__ __forceinline__ void stage_rc(int b, int& R, int& C) { const int st = b / 1024, sb = b % 1024, swz = sb ^ (((sb >> 9) & 1) << 5); R = (st >> 1) * 16 + swz / 64; C = (st & 1) * 32 + (swz % 64) / 2; }
__host__ __device__ __forceinline__ int perm32(int rho) { const int n = rho >> 4, i = rho & 15; return 8 * (i >> 2) + 4 * n + (i & 3); }

struct Unit { int pm, pn, e, aux; };

__device__ __forceinline__ unsigned cvt_pk_bf16(float lo, float hi) { unsigned r; asm volatile("v_cvt_pk_bf16_f32 %0, %1, %2" : "=v"(r) : "v"(lo), "v"(hi)); return r; }

struct StaticOrder {
    static constexpr bool GATHER = false;
    const char* A; const char* Bt; int K; int nM, nN, nwg, G, c;
    __device__ void init(const void* A_, const void* Bt_, int M, int N, int K_, int G_, int c_) { A = (const char*)A_; Bt = (const char*)Bt_; K = K_; nM = M / BM; nN = N / BM; nwg = nM * nN; G = G_; c = c_; }
    __device__ bool next(int i, Unit& u) const {
        const long L = (long)i * G + c; if (L >= nwg) return false;
        int wgid = (int)L; { const int q = nwg / NXCD, r = nwg % NXCD, xcd = wgid % NXCD, off = wgid / NXCD; wgid = (xcd < r ? xcd * (q + 1) : r * (q + 1) + (xcd - r) * q) + off; }
        const int nig = WGM * nN, gid = wgid / nig, fm = gid * WGM, gsz = (nM - fm) < WGM ? (nM - fm) : WGM;
        u.pm = fm + ((wgid % nig) % gsz); u.pn = (wgid % nig) / gsz; u.e = 0; u.aux = 0; return true;
    }
    __device__ __forceinline__ const char* a_base(const Unit& u) const { return A + (size_t)u.pm * BM * K * 2; }
    __device__ __forceinline__ const char* b_base(const Unit& u) const { return Bt + (size_t)u.pn * BM * K * 2; }
    __device__ __forceinline__ int row(const Unit&, int r) const { return r; }
    __device__ __forceinline__ void a_ready(const Unit&) const {}
    __device__ __forceinline__ void done(const Unit&) const {}
};

template <class Epi, class Sched, bool ALIGN_EPI>
__device__ __forceinline__ void gemm_phase(PG8_LAS unsigned char* lds, const int K, const Sched& S, const Epi& E) {
    int tid_o = threadIdx.x; asm volatile("" : "+v"(tid_o));
    const int tid = tid_o, wid = __builtin_amdgcn_readfirstlane(tid >> 6), lane = tid & 63, wr = wid >> 2, wc = wid & 3, fr = lane & 15, fq = lane >> 4;
    const int nt = K / BK;
    unsigned voffB[2]; unsigned cv0[2], cv1[2], nv0[2], nv1[2];
    const size_t kstep = (size_t)(BK * 2);
    const size_t hstep = (size_t)HALF * K * 2;
    const unsigned ldsw = (unsigned)wid * 1024u;
    const int aoff = lds_byte(wr * 64 + fr, fq * 8), boff = lds_byte(wc * 32 + fr, fq * 8);
#define PG8_SA(b, h) (((b) * 2 + (h)) * HTB)
#define PG8_SB(b, h) ((4 + (b) * 2 + (h)) * HTB)
#define PG8_STAGE(bufoff, gbase, voff) do { _Pragma("unroll") for (int _i = 0; _i < 2; ++_i) \
        __builtin_amdgcn_global_load_lds((const unsigned*)((const char*)(gbase) + (voff)[_i]), (PG8_LAS unsigned*)(lds + (bufoff) + ldsw + _i * 8192), 16, 0, 0); } while (0)
#define PG8_STAGE_A1(bufoff, gbase, v0_, v1_) do { if constexpr (Sched::GATHER) { PG8_STAGE(bufoff, gbase, v1_); } else { PG8_STAGE(bufoff, (gbase) + hstep, v0_); } } while (0)
#define PG8_LDA(dst, b, h) do { _Pragma("unroll") for (int m = 0; m < 4; ++m) _Pragma("unroll") for (int k = 0; k < 2; ++k) dst[m][k] = *(const PG8_LAS bf16x8*)(lds + PG8_SA(b, h) + aoff + m * 2048 + k * 1024); } while (0)
#define PG8_LDB(dst, b, h) do { _Pragma("unroll") for (int n = 0; n < 2; ++n) _Pragma("unroll") for (int k = 0; k < 2; ++k) dst[n][k] = *(const PG8_LAS bf16x8*)(lds + PG8_SB(b, h) + boff + n * 2048 + k * 1024); } while (0)
#define PG8_MMA(ai, bj, At, Bt) do { __builtin_amdgcn_s_setprio(1); _Pragma("unroll") for (int m = 0; m < 4; ++m) _Pragma("unroll") for (int n = 0; n < 2; ++n) _Pragma("unroll") for (int k = 0; k < 2; ++k) \
        acc[ai][bj][m][n] = __builtin_amdgcn_mfma_f32_16x16x32_bf16(Bt[n][k], At[m][k], acc[ai][bj][m][n], 0, 0, 0); __builtin_amdgcn_s_setprio(0); } while (0)
#define PG8_WAIT_V(n) asm volatile("s_waitcnt vmcnt(" #n ")" ::: "memory")
#define PG8_WAIT_L(n) asm volatile("s_waitcnt lgkmcnt(" #n ")" ::: "memory")
#define PG8_BAR __builtin_amdgcn_s_barrier()
#define PG8_SCHED __builtin_amdgcn_sched_barrier(0)
#define PG8_AOFFS(v0, v1, U) do { _Pragma("unroll") for (int _i = 0; _i < 2; ++_i) { int R_, C_; stage_rc(tid * 16 + _i * 8192, R_, C_); \
        v0[_i] = (unsigned)(S.row(U, R_) * K + C_) * 2u; v1[_i] = (unsigned)(S.row(U, HALF + R_) * K + C_) * 2u; } } while (0)
    Unit cur, nxt; int ui = 0;
    if (!S.next(0, cur)) return;
#pragma unroll
    for (int i = 0; i < 2; ++i) { int R, C; stage_rc(tid * 16 + i * 8192, R, C); const int Rb = Epi::PERM ? ((R & ~31) + perm32(R & 31)) : R; voffB[i] = (unsigned)(Rb * K + C) * 2u; }
    PG8_AOFFS(cv0, cv1, cur);
    f32x4 acc[2][2][4][2];
#pragma unroll
    for (int a = 0; a < 2; ++a)
#pragma unroll
        for (int b = 0; b < 2; ++b)
#pragma unroll
            for (int m = 0; m < 4; ++m)
#pragma unroll
                for (int n = 0; n < 2; ++n) acc[a][b][m][n] = (f32x4){0.f, 0.f, 0.f, 0.f};
    bf16x8 At[4][2], B0[2][2], B1[2][2];
    const char* cA = S.a_base(cur); const char* cB = S.b_base(cur);
    S.a_ready(cur);
    PG8_STAGE(PG8_SB(0, 0), cB, voffB); PG8_STAGE(PG8_SB(0, 1), cB + hstep, voffB); PG8_STAGE(PG8_SA(0, 0), cA, cv0); PG8_STAGE_A1(PG8_SA(0, 1), cA, cv0, cv1);
    if (wr == 1) PG8_BAR;
    PG8_WAIT_V(2); PG8_BAR;
    PG8_STAGE(PG8_SB(1, 0), cB + kstep, voffB); PG8_STAGE(PG8_SA(1, 0), cA + kstep, cv0); PG8_STAGE(PG8_SB(1, 1), cB + hstep + kstep, voffB);
    PG8_WAIT_V(6); PG8_BAR;
    for (;;) {
        const bool has_next = S.next(ui + 1, nxt);
        const char* nA = has_next ? S.a_base(nxt) : cA; const char* nB = has_next ? S.b_base(nxt) : cB;
        if constexpr (Sched::GATHER) { if (has_next) { PG8_AOFFS(nv0, nv1, nxt); } else { nv0[0] = cv0[0]; nv0[1] = cv0[1]; nv1[0] = cv1[0]; nv1[1] = cv1[1]; } }
        for (int t = 0; t < nt; t += 2) {
            const bool last = (t == nt - 2);
            const char* a1 = cA + (size_t)(t + 1) * kstep;
            const char* a2 = last ? nA : cA + (size_t)(t + 2) * kstep; const char* b2 = last ? nB : cB + (size_t)(t + 2) * kstep;
            const char* a3 = a2 + kstep; const char* b3 = b2 + kstep;
            unsigned s0[2], s1[2];
            if constexpr (Sched::GATHER) { s0[0] = last ? nv0[0] : cv0[0]; s0[1] = last ? nv0[1] : cv0[1]; s1[0] = last ? nv1[0] : cv1[0]; s1[1] = last ? nv1[1] : cv1[1]; }
            else { s0[0] = cv0[0]; s0[1] = cv0[1]; s1[0] = 0u; s1[1] = 0u; }
            if (last && has_next) S.a_ready(nxt);
            PG8_LDB(B0, 0, 0); PG8_LDB(B1, 0, 1); PG8_SCHED; PG8_LDA(At, 0, 0); PG8_STAGE_A1(PG8_SA(1, 1), a1, cv0, cv1);
            PG8_WAIT_V(8); PG8_WAIT_L(0); PG8_BAR; PG8_MMA(0, 0, At, B0); PG8_MMA(0, 1, At, B1); PG8_BAR; PG8_SCHED;
            PG8_LDA(At, 0, 1); PG8_STAGE(PG8_SB(0, 0), b2, voffB); PG8_STAGE(PG8_SB(0, 1), b2 + hstep, voffB); PG8_STAGE(PG8_SA(0, 0), a2, s0);
            PG8_WAIT_V(8); PG8_WAIT_L(0); PG8_BAR; PG8_MMA(1, 0, At, B0); PG8_MMA(1, 1, At, B1); PG8_BAR; PG8_SCHED;
            PG8_LDB(B0, 1, 0); PG8_LDB(B1, 1, 1); PG8_SCHED; PG8_LDA(At, 1, 0); PG8_STAGE_A1(PG8_SA(0, 1), a2, s0, s1);
            PG8_WAIT_V(8); PG8_WAIT_L(0); PG8_BAR; PG8_MMA(0, 0, At, B0); PG8_MMA(0, 1, At, B1); PG8_BAR; PG8_SCHED;
            PG8_LDA(At, 1, 1); PG8_STAGE(PG8_SB(1, 0), b3, voffB); PG8_STAGE(PG8_SB(1, 1), b3 + hstep, voffB); PG8_STAGE(PG8_SA(1, 0), a3, s0);
            PG8_WAIT_V(8); PG8_WAIT_L(0); PG8_BAR; PG8_MMA(1, 0, At, B0); PG8_MMA(1, 1, At, B1); PG8_BAR; PG8_SCHED;
        }
        if constexpr (ALIGN_EPI) { if (wr == 0) PG8_BAR; }
        { int l2 = (int)__builtin_amdgcn_mbcnt_hi(~0u, __builtin_amdgcn_mbcnt_lo(~0u, 0u)); asm volatile("" : "+v"(l2)); E(acc, cur, wr, wc, l2 & 15, l2 >> 4); } S.done(cur);
        if (!has_next) break;
#pragma unroll
        for (int a = 0; a < 2; ++a)
#pragma unroll
            for (int b = 0; b < 2; ++b)
#pragma unroll
                for (int m = 0; m < 4; ++m)
#pragma unroll
                    for (int n = 0; n < 2; ++n) acc[a][b][m][n] = (f32x4){0.f, 0.f, 0.f, 0.f};
        cur = nxt; cA = nA; cB = nB; ++ui;
        if constexpr (Sched::GATHER) { cv0[0] = nv0[0]; cv0[1] = nv0[1]; cv1[0] = nv1[0]; cv1[1] = nv1[1]; }
        if constexpr (ALIGN_EPI) { if (wr == 1) PG8_BAR; }
    }
    PG8_WAIT_V(0);
    if constexpr (!ALIGN_EPI) { if (wr == 0) PG8_BAR; }
    PG8_BAR;
#undef PG8_SA
#undef PG8_SB
#undef PG8_STAGE
#undef PG8_STAGE_A1
#undef PG8_LDA
#undef PG8_LDB
#undef PG8_MMA
#undef PG8_WAIT_V
#undef PG8_WAIT_L
#undef PG8_BAR
#undef PG8_SCHED
#undef PG8_AOFFS
}
}

#define GAS __attribute__((address_space(1)))
#define LAS __attribute__((address_space(3)))
typedef unsigned v4u __attribute__((ext_vector_type(4)));
typedef unsigned v2u __attribute__((ext_vector_type(2)));
typedef float f32x4 __attribute__((ext_vector_type(4)));
typedef float f32x2 __attribute__((ext_vector_type(2)));
typedef short bf16x8 __attribute__((ext_vector_type(8)));
typedef GAS unsigned gu32;
#define RLX_AGENT __ATOMIC_RELAXED, __HIP_MEMORY_SCOPE_AGENT
#define LDS_WAIT() asm volatile("s_waitcnt lgkmcnt(0)" ::: "memory")
#define VM_WAIT() asm volatile("s_waitcnt vmcnt(0)" ::: "memory")
constexpr int NWAVES = 8;
constexpr int PH_COMB = 4;

constexpr size_t WS_WIN = 0;
constexpr size_t WS_WOUT = 5 * MiB;
constexpr size_t WS_WGU = 7 * MiB;
constexpr size_t WS_WD = 39 * MiB;
constexpr size_t WS_WPLE = 55 * MiB;
constexpr size_t WS_WPG = 56 * MiB;
constexpr size_t WS_XN = 58 * MiB;
constexpr size_t WS_PB = 58 * MiB;
constexpr size_t WS_ARR = 98 * MiB;
constexpr size_t WS_PW = 211 * MiB;
constexpr size_t WS_CTL = 243 * MiB;
constexpr size_t WS_ACC = 244 * MiB;
constexpr size_t ZERO_BYTES = 2 * MiB;
constexpr size_t WS_KMEAN = WS_ACC, WS_SSQ1 = WS_ACC + 128 * 1024, WS_SSQ2 = WS_ACC + 192 * 1024;
constexpr size_t WS_YCAT = 58 * MiB;
constexpr size_t WS_H1B = 90 * MiB;
constexpr size_t WS_A2 = 122 * MiB;
constexpr size_t WS_YS = 142 * MiB;
constexpr size_t WS_H2B = 58 * MiB;
constexpr size_t WS_YA = 178 * MiB;
constexpr size_t WS_LP = 194 * MiB;
constexpr size_t WS_QL = 196 * MiB;
constexpr int CW_QCNT = 8192;
constexpr size_t WS_LTOK = 245 * MiB;
constexpr size_t WS_LSC = 247 * MiB;
constexpr size_t WS_RSTD2 = 251 * MiB;
constexpr size_t WS_WR = 251 * MiB + 512 * 1024;
constexpr size_t WS_ORC = 252 * MiB;
constexpr int CW_CNT = 1024;
constexpr int LCAP = 16384;
constexpr int CW_BAR = 4096;

constexpr int RING_OFF = 0, RING_BYTES = 131072;
constexpr int XTRA_OFF = 131072;
constexpr int LDS_BYTES = 163840;
constexpr int LDSCTL_OFF = LDS_BYTES - 512, MISC_OFF = LDSCTL_OFF + 320;

#define XB_TMO      128
#define XB_XCNT(j)  (256  + 64 * (j))
#define XB_XSUB(j)  (1280 + 64 * (j))
#define XB_XGEN(j)  (2304 + 64 * (j))
#define XB_TOP      3328
#define XB_TOPGEN   3392
#define XCD_BAR_WORDS 3456
#define XB_SPIN_CAP (1u << 18)
__device__ __forceinline__ unsigned xb_ld(unsigned* p)              { return __hip_atomic_load(p, __ATOMIC_RELAXED, __HIP_MEMORY_SCOPE_AGENT); }
__device__ __forceinline__ unsigned xb_add(unsigned* p, unsigned v) { return __hip_atomic_fetch_add(p, v, __ATOMIC_RELAXED, __HIP_MEMORY_SCOPE_AGENT); }
__device__ __forceinline__ unsigned xb_xcc_id() { return (unsigned)__builtin_amdgcn_s_getreg((3 << 11) | 20) & 0xFu; }
#define XB_SPIN(cond, bar) do { unsigned _sp = 0; while (cond) { __builtin_amdgcn_s_sleep(1); \
    if ((++_sp & 255u) == 0u) { if (xb_ld(&(bar)[XB_TMO])) break; if (_sp > XB_SPIN_CAP) { atomicAdd(&(bar)[XB_TMO], 1u); break; } } } } while (0)
struct XcdBarrier { unsigned* bar; unsigned x; volatile LAS unsigned* st; };
__device__ __forceinline__ XcdBarrier xcd_barrier_post(unsigned* bar, volatile LAS unsigned* st) {
    XcdBarrier b; b.bar = bar; b.x = xb_xcc_id(); b.st = st;
    if (threadIdx.x == 0) (void)xb_add(&bar[XB_XCNT(b.x)], 1u);
    return b;
}
__device__ __forceinline__ void xcd_barrier_complete(unsigned* bar, unsigned x, unsigned& nloc, unsigned& nx) {
    const unsigned G = gridDim.x * gridDim.y * gridDim.z;
    unsigned sum, cnt, mine, sp = 0u;
    for (;;) {
        sum = 0u; cnt = 0u; mine = 0u;
#pragma unroll
        for (unsigned j = 0; j < 16; ++j) { const unsigned c = xb_ld(&bar[XB_XCNT(j)]); sum += c; cnt += (c > 0u) ? 1u : 0u; mine = (j == x) ? c : mine; }
        if (sum == G) break;
        __builtin_amdgcn_s_sleep(1);
        if ((++sp & 255u) == 0u) { if (xb_ld(&bar[XB_TMO])) break; if (sp > XB_SPIN_CAP) { atomicAdd(&bar[XB_TMO], 1u); break; } }
    }
    nloc = mine > 0u ? mine : 1u; nx = cnt > 0u ? cnt : 1u;
}
__device__ __forceinline__ void xcd_barrier(const XcdBarrier& b) {
    asm volatile("s_waitcnt vmcnt(0)" ::: "memory");
    __syncthreads();
    if (threadIdx.x == 0) {
        unsigned* bar = b.bar;
        __builtin_amdgcn_s_waitcnt(0);
        unsigned nloc = b.st[0], nx = b.st[1];
        if (nloc == 0u) { xcd_barrier_complete(bar, b.x, nloc, nx); b.st[0] = nloc; b.st[1] = nx; }
        const unsigned old = xb_add(&bar[XB_XSUB(b.x)], 1u);
        const unsigned gen = old / nloc;
        if (old + 1u == (gen + 1u) * nloc) {
            __builtin_amdgcn_fence(__ATOMIC_RELEASE, "agent");
            asm volatile("s_waitcnt vmcnt(0)" ::: "memory");
            const unsigned og = xb_add(&bar[XB_TOP], 1u);
            const unsigned tg = og / nx;
            if (og + 1u == (tg + 1u) * nx) xb_add(&bar[XB_TOPGEN], 1u);
            else XB_SPIN(xb_ld(&bar[XB_TOPGEN]) == tg, bar);
            __builtin_amdgcn_fence(__ATOMIC_ACQUIRE, "agent");
            xb_add(&bar[XB_XGEN(b.x)], 1u);
            asm volatile("s_waitcnt vmcnt(0)" ::: "memory");
        } else {
            XB_SPIN(xb_ld(&bar[XB_XGEN(b.x)]) == gen, bar);
            __builtin_amdgcn_fence(__ATOMIC_ACQUIRE, "agent");
            asm volatile("s_waitcnt vmcnt(0)" ::: "memory");
        }
    }
    __syncthreads();
}

struct Args { const float* in[21]; float* out; unsigned char* ws; int ph_lo, ph_hi, li, pad; };

__device__ __forceinline__ float gelu_fast(float x) {
    const float z = x * (0.7978845608f + 0.0356774081f * x * x);
    const float e = __builtin_amdgcn_exp2f(-2.885390082f * z);
    return x * __builtin_amdgcn_rcpf(1.f + e);
}
struct EpiInProj {
    static constexpr bool PERM = true;
    bf16_t* arr0; float* kmean; const float* gq; const float* gk; int pn0; int pad_;
    __device__ __forceinline__ void operator()(const pg8::f32x4 (&acc)[2][2][4][2], const pg8::Unit& u_, int wr, int wc, int fr, int fq) const {
        using namespace pg8;
        Unit u = u_; u.pn += pn0;
        const int kind = u.pn >> 1;
        bf16_t* base = arr0 + (size_t)kind * ARR + (size_t)(u.pm * 256 + wr * 64 + fr) * 512 + (u.pn & 1) * 256;
        if (kind == 2 || kind == 3) {
            const float* g = (kind == 2) ? gq : gk;
            f32x4 gv[2][2], ks[2][2];
#pragma unroll
            for (int bj = 0; bj < 2; ++bj)
#pragma unroll
                for (int n = 0; n < 2; ++n) { gv[bj][n] = *(const f32x4*)(g + 32 * bj + 8 * fq + 4 * n); ks[bj][n] = (f32x4){0.f, 0.f, 0.f, 0.f}; }
#pragma unroll
            for (int ai = 0; ai < 2; ++ai)
#pragma unroll
                for (int m = 0; m < 4; ++m) {
                    float ss = 0.f;
#pragma unroll
                    for (int bj = 0; bj < 2; ++bj)
#pragma unroll
                        for (int n = 0; n < 2; ++n) { const f32x4 x = acc[ai][bj][m][n]; ss += (x[0] * x[0] + x[1] * x[1]) + (x[2] * x[2] + x[3] * x[3]); }
                    ss += __shfl_xor(ss, 16); ss += __shfl_xor(ss, 32);
                    const float rs = rsqrtf(ss * (1.f / 64.f) + EPS);
                    bf16_t* rowp = arr0 + (size_t)kind * ARR + ((size_t)((u.pm >> 4) * NH + (u.pn & 1) * 4 + wc) * S_ + (u.pm & 15) * 256 + ai * HALF + wr * 64 + m * 16 + fr) * DH + 8 * fq;
#pragma unroll
                    for (int bj = 0; bj < 2; ++bj) {
                        const f32x4 v0 = acc[ai][bj][m][0] * rs * gv[bj][0], v1 = acc[ai][bj][m][1] * rs * gv[bj][1];
                        ks[bj][0] += v0; ks[bj][1] += v1;
                        u32x4 w; w.x = cvt_pk_bf16(v0[0], v0[1]); w.y = cvt_pk_bf16(v0[2], v0[3]); w.z = cvt_pk_bf16(v1[0], v1[1]); w.w = cvt_pk_bf16(v1[2], v1[3]);
                        *(u32x4*)(rowp + 32 * bj) = w;
                    }
                }
            if (kind == 3) {
                float* km = kmean + ((size_t)((u.pm >> 4) * NH + (u.pn & 1) * 4 + wc) * NBLK + (u.pm & 15)) * DH + 8 * fq;
#pragma unroll
                for (int bj = 0; bj < 2; ++bj)
#pragma unroll
                    for (int n = 0; n < 2; ++n)
#pragma unroll
                        for (int r = 0; r < 4; ++r) {
                            float v = ks[bj][n][r];
                            v += __shfl_xor(v, 1); v += __shfl_xor(v, 2); v += __shfl_xor(v, 4); v += __shfl_xor(v, 8);
                            if (fr == 0) atomicAdd(km + 32 * bj + 4 * n + r, v * (1.f / 256.f));
                        }
            }
        } else {
#pragma unroll
            for (int ai = 0; ai < 2; ++ai)
#pragma unroll
                for (int m = 0; m < 4; ++m) {
                    bf16_t* rowp = base + (size_t)(ai * HALF + m * 16) * 512 + wc * 32 + 8 * fq;
                    const size_t vrow = (size_t)(u.pm & 15) * 256 + ai * HALF + wr * 64 + m * 16 + fr;
#pragma unroll
                    for (int bj = 0; bj < 2; ++bj) {
                        f32x4 v0 = acc[ai][bj][m][0], v1 = acc[ai][bj][m][1];
                        if (kind <= 1) {
#pragma unroll
                            for (int r = 0; r < 4; ++r) { v0[r] = gelu_fast(v0[r]); v1[r] = gelu_fast(v1[r]); }
                        }
                        u32x4 w; w.x = cvt_pk_bf16(v0[0], v0[1]); w.y = cvt_pk_bf16(v0[2], v0[3]); w.z = cvt_pk_bf16(v1[0], v1[1]); w.w = cvt_pk_bf16(v1[2], v1[3]);
                        if (kind == 4) *(u32x4*)(arr0 + (size_t)4 * ARR + ((size_t)((u.pm >> 4) * NH + (u.pn & 1) * 4 + 2 * bj + (wc >> 1)) * S_ + vrow) * DH + (wc & 1) * 32 + 8 * fq) = w;
                        else *(u32x4*)(rowp + bj * HALF) = w;
                    }
                }
        }
    }
};
struct EpiBf16Plain {
    static constexpr bool PERM = true;
    bf16_t* O; int ldc;
    __device__ __forceinline__ void operator()(const pg8::f32x4 (&acc)[2][2][4][2], const pg8::Unit& u, int wr, int wc, int fr, int fq) const {
        using namespace pg8;
        bf16_t* base = O + (size_t)(u.pm * 256 + wr * 64 + fr) * ldc + u.pn * 256 + wc * 32 + 8 * fq;
#pragma unroll
        for (int ai = 0; ai < 2; ++ai)
#pragma unroll
            for (int m = 0; m < 4; ++m) {
                bf16_t* rowp = base + (size_t)(ai * HALF + m * 16) * ldc;
#pragma unroll
                for (int bj = 0; bj < 2; ++bj) {
                    const f32x4 v0 = acc[ai][bj][m][0], v1 = acc[ai][bj][m][1];
                    u32x4 w; w.x = cvt_pk_bf16(v0[0], v0[1]); w.y = cvt_pk_bf16(v0[2], v0[3]); w.z = cvt_pk_bf16(v1[0], v1[1]); w.w = cvt_pk_bf16(v1[2], v1[3]);
                    *(u32x4*)(rowp + bj * HALF) = w;
                }
            }
    }
};

struct EpiOutProj {
    static constexpr bool PERM = true;
    const float* x; bf16_t* h1b; float* ssq;
    __device__ __forceinline__ void operator()(const pg8::f32x4 (&acc)[2][2][4][2], const pg8::Unit& u, int wr, int wc, int fr, int fq) const {
        using namespace pg8;
        const int row0 = u.pm * 256 + wr * 64 + fr, col0 = u.pn * 256 + wc * 32 + 8 * fq;
#pragma unroll
        for (int ai = 0; ai < 2; ++ai)
#pragma unroll
            for (int m = 0; m < 4; ++m) {
                const int row = row0 + ai * HALF + m * 16; const size_t off = (size_t)row * D_ + col0;
                float ss = 0.f;
#pragma unroll
                for (int bj = 0; bj < 2; ++bj) {
                    const f32x4 x0 = *(const f32x4*)(x + off + bj * HALF), x1 = *(const f32x4*)(x + off + bj * HALF + 4);
                    const f32x4 v0 = acc[ai][bj][m][0] + x0, v1 = acc[ai][bj][m][1] + x1;
                    u32x4 w; w.x = cvt_pk_bf16(v0[0], v0[1]); w.y = cvt_pk_bf16(v0[2], v0[3]); w.z = cvt_pk_bf16(v1[0], v1[1]); w.w = cvt_pk_bf16(v1[2], v1[3]);
                    *(u32x4*)(h1b + off + bj * HALF) = w;
                    ss += (v0[0] * v0[0] + v0[1] * v0[1]) + (v0[2] * v0[2] + v0[3] * v0[3]) + (v1[0] * v1[0] + v1[1] * v1[1]) + (v1[2] * v1[2] + v1[3] * v1[3]);
                }
                ss += __shfl_xor(ss, 16); ss += __shfl_xor(ss, 32);
                if (fq == 0) atomicAdd(ssq + row, ss);
                if (m & 1) asm volatile("" ::: "memory");
            }
    }
};
struct EpiPleGate {
    static constexpr bool PERM = true;
    float* out; const bf16_t* pw; const float* rstd2; const bf16_t* h2b;
    __device__ __forceinline__ void operator()(const pg8::f32x4 (&acc)[2][2][4][2], const pg8::Unit& u, int wr, int wc, int fr, int fq) const {
        using namespace pg8;
        const int row0 = u.pm * 256 + wr * 64 + fr, col0 = u.pn * 256 + wc * 32 + 8 * fq;
#pragma unroll
        for (int ai = 0; ai < 2; ++ai)
#pragma unroll
            for (int m = 0; m < 4; ++m) {
                const int row = row0 + ai * HALF + m * 16; const size_t off = (size_t)row * D_ + col0;
                const float rs = rstd2[row] * -1.4426950408889634f;
#pragma unroll
                for (int bj = 0; bj < 2; ++bj) {
                    const u32x4 hv = *(const u32x4*)(h2b + off + bj * HALF);
                    const u32x4 pv = *(const u32x4*)(pw + off + bj * HALF);
                    f32x4 v0, v1;
#pragma unroll
                    for (int r = 0; r < 4; ++r) {
                        const unsigned pw0 = (r & 1) ? (pv[r >> 1] & 0xffff0000u) : (pv[r >> 1] << 16);
                        const unsigned pw1 = (r & 1) ? (pv[2 + (r >> 1)] & 0xffff0000u) : (pv[2 + (r >> 1)] << 16);
                        const float s0 = __builtin_amdgcn_rcpf(1.f + __builtin_amdgcn_exp2f(acc[ai][bj][m][0][r] * rs));
                        const float s1 = __builtin_amdgcn_rcpf(1.f + __builtin_amdgcn_exp2f(acc[ai][bj][m][1][r] * rs));
                        const unsigned hw0 = (r & 1) ? (hv[r >> 1] & 0xffff0000u) : (hv[r >> 1] << 16);
                        const unsigned hw1 = (r & 1) ? (hv[2 + (r >> 1)] & 0xffff0000u) : (hv[2 + (r >> 1)] << 16);
                        v0[r] = __uint_as_float(hw0) + __uint_as_float(pw0) * s0; v1[r] = __uint_as_float(hw1) + __uint_as_float(pw1) * s1;
                    }
                    *(f32x4*)(out + off + bj * HALF) = v0; *(f32x4*)(out + off + bj * HALF + 4) = v1;
                }
                if (m & 1) asm volatile("" ::: "memory");
            }
    }
};
struct MoeOrder1 {
    static constexpr bool GATHER = true;
    const char* A; const char* Bt; const unsigned* ltok; const LAS int* pref; int G, c, Lbeg, Lend;
    __device__ bool next(int i, pg8::Unit& u) const {
        const int L = Lbeg + i * G + c;
        if (c < 0 || L >= Lend) return false;
        const int tile = L >> 1; int e = 0;
#pragma unroll 1
        for (int j = 16; j > 0; j >>= 1) if (pref[e + j] <= tile) e += j;
        const int rt = tile - pref[e]; const int valid = min(256, pref[33 + e] - rt * 256);
        u.pm = tile; u.pn = L & 1; u.e = e; u.aux = valid | (rt << 16); return true;
    }
    __device__ __forceinline__ const char* a_base(const pg8::Unit&) const { return A; }
    __device__ __forceinline__ const char* b_base(const pg8::Unit& u) const { return Bt + ((size_t)u.e * 512 + u.pn * 256) * 1024 * 2; }
    __device__ __forceinline__ int row(const pg8::Unit& u, int r) const { const int valid = u.aux & 0xffff ? (u.aux & 0xffff) : 256; const int rr = r < valid ? r : valid - 1;
        return (int)(ltok[(size_t)u.e * LCAP + (u.aux >> 16) * 256 + rr] & 0x3fffu); }
    __device__ __forceinline__ void a_ready(const pg8::Unit&) const {}
    __device__ __forceinline__ void done(const pg8::Unit&) const {}
};
struct MoeOrder2 {
    static constexpr bool GATHER = false;
    const char* A; const char* Bt; const LAS int* pref; int G, c, Lbeg, Lend;
    __device__ bool next(int i, pg8::Unit& u) const {
        const int L = Lbeg + i * G + c;
        if (c < 0 || L >= Lend) return false;
        const int tile = L >> 2; int e = 0;
#pragma unroll 1
        for (int j = 16; j > 0; j >>= 1) if (pref[e + j] <= tile) e += j;
        const int rt = tile - pref[e]; const int valid = min(256, pref[33 + e] - rt * 256);
        u.pm = tile; u.pn = L & 3; u.e = e; u.aux = valid | (rt << 16); return true;
    }
    __device__ __forceinline__ const char* a_base(const pg8::Unit& u) const { return A + (size_t)u.pm * 256 * 256 * 2; }
    __device__ __forceinline__ const char* b_base(const pg8::Unit& u) const { return Bt + ((size_t)u.e * 1024 + u.pn * 256) * 256 * 2; }
    __device__ __forceinline__ int row(const pg8::Unit&, int r) const { return r; }
    __device__ __forceinline__ void a_ready(const pg8::Unit&) const {}
    __device__ __forceinline__ void done(const pg8::Unit&) const {}
};
struct EpiMoe1 {
    static constexpr bool PERM = true;
    bf16_t* a2; const f32x2* lsc;
    __device__ __forceinline__ void operator()(const pg8::f32x4 (&acc)[2][2][4][2], const pg8::Unit& u, int wr, int wc, int fr, int fq) const {
        using namespace pg8;
        const int rt = u.aux >> 16;
#pragma unroll
        for (int ai = 0; ai < 2; ++ai)
#pragma unroll
            for (int m = 0; m < 4; ++m) {
                const int rl = ai * HALF + wr * 64 + m * 16 + fr;
                const f32x2 sc = lsc[(size_t)u.e * LCAP + rt * 256 + rl];
                const float rs = sc.x, cw = sc.y * sc.x;
                f32x4 o0, o1;
#pragma unroll
                for (int r = 0; r < 4; ++r) {
                    const float g0 = acc[ai][0][m][0][r] * rs, g1 = acc[ai][0][m][1][r] * rs;
                    o0[r] = g0 * __builtin_amdgcn_rcpf(1.f + __builtin_amdgcn_exp2f(-1.4426950408889634f * g0)) * acc[ai][1][m][0][r] * cw;
                    o1[r] = g1 * __builtin_amdgcn_rcpf(1.f + __builtin_amdgcn_exp2f(-1.4426950408889634f * g1)) * acc[ai][1][m][1][r] * cw;
                }
                u32x4 w; w.x = cvt_pk_bf16(o0[0], o0[1]); w.y = cvt_pk_bf16(o0[2], o0[3]); w.z = cvt_pk_bf16(o1[0], o1[1]); w.w = cvt_pk_bf16(o1[2], o1[3]);
                *(u32x4*)(a2 + ((size_t)u.pm * 256 + rl) * 256 + u.pn * 128 + wc * 32 + 8 * fq) = w;
            }
    }
};
struct EpiMoe2 {
    static constexpr bool PERM = true;
    bf16_t* ys; const unsigned* ltok;
    __device__ __forceinline__ void operator()(const pg8::f32x4 (&acc)[2][2][4][2], const pg8::Unit& u, int wr, int wc, int fr, int fq) const {
        using namespace pg8;
        const int rt = u.aux >> 16, valid = u.aux & 0xffff;
#pragma unroll
        for (int ai = 0; ai < 2; ++ai)
#pragma unroll
            for (int m = 0; m < 4; ++m) {
                const int rl = ai * HALF + wr * 64 + m * 16 + fr;
                if (rl < valid) {
                    const unsigned ts = ltok[(size_t)u.e * LCAP + rt * 256 + rl];
                    bf16_t* rowp = ys + ((size_t)(ts >> 16) * T_ + (ts & 0x3fffu)) * D_ + u.pn * 256 + wc * 32 + 8 * fq;
#pragma unroll
                    for (int bj = 0; bj < 2; ++bj) {
                        const f32x4 v0 = acc[ai][bj][m][0], v1 = acc[ai][bj][m][1];
                        u32x4 w; w.x = cvt_pk_bf16(v0[0], v0[1]); w.y = cvt_pk_bf16(v0[2], v0[3]); w.z = cvt_pk_bf16(v1[0], v1[1]); w.w = cvt_pk_bf16(v1[2], v1[3]);
                        *(u32x4*)(rowp + bj * HALF) = w;
                    }
                }
            }
    }
};

__device__ __forceinline__ float wave_sum_x(float v) {
#pragma unroll
    for (int o = 1; o < 64; o <<= 1) v += __shfl_xor(v, o);
    return v;
}
__device__ __forceinline__ unsigned pk2(float lo, float hi) { return f2bf(lo) | (f2bf(hi) << 16); }
__device__ __forceinline__ void p0_transpose_item(const float* W, int K, int N, bf16_t* WT, const float* gain, int mapmode, LAS float* scr, int item, int lane) {
    const int nblk = N / 32, kb = item / nblk, nb = item % nblk, k0 = 64 * kb, n0 = 32 * nb;
#pragma unroll 8
    for (int i = 0; i < 32; ++i) { const int kk = 2 * i + (lane >> 5); float v = W[(size_t)(k0 + kk) * N + n0 + (lane & 31)]; if (gain) v *= gain[k0 + kk]; scr[kk * 33 + (lane & 31)] = v; }
    LDS_WAIT(); asm volatile("" ::: "memory");
    int r0 = n0;
    if (mapmode == 1) { if (n0 >= 1024 && n0 < 2048) { const int cc = n0 & 255; r0 = (n0 & ~255) + 128 * ((cc >> 5) & 1) + 32 * (cc >> 6); } }
    else if (mapmode == 2) r0 = (n0 >> 7) * 256 + (n0 & 127);
    else if (mapmode == 3) r0 = (n0 >> 7) * 256 + 128 + (n0 & 127);
    const int c = lane & 7;
#pragma unroll
    for (int j = 0; j < 4; ++j) { const int n = (lane >> 3) + 8 * j; const LAS float* s = scr + (8 * c) * 33 + n;
        v4u o; o.x = pk2(s[0 * 33], s[1 * 33]); o.y = pk2(s[2 * 33], s[3 * 33]); o.z = pk2(s[4 * 33], s[5 * 33]); o.w = pk2(s[6 * 33], s[7 * 33]);
        *(GAS v4u*)(WT + (size_t)(r0 + n) * K + k0 + 8 * c) = o; }
    LDS_WAIT(); asm volatile("" ::: "memory");
}

typedef short s16x4 __attribute__((ext_vector_type(4)));
__device__ __forceinline__ s16x4 lds_tr16(LAS const void* p) { return __builtin_bit_cast(s16x4, __builtin_amdgcn_ds_read_tr16_b64_v4i16((LAS s16x4*)p)); }
typedef float f32x2_t __attribute__((ext_vector_type(2))); typedef __bf16 bf16x2_t __attribute__((ext_vector_type(2)));
__device__ __forceinline__ unsigned cvt_pk(float lo, float hi) { f32x2_t v = {lo, hi}; bf16x2_t b = __builtin_convertvector(v, bf16x2_t); return __builtin_bit_cast(unsigned, b); }

constexpr int MA_WS_STRIDE = 136, MA_VS_STRIDE = 144, MA_VS_OFF = 128 * MA_WS_STRIDE * 2;
__device__ __forceinline__ void mixa_load_w(LAS unsigned char* lds, const float* wsg, int tid) {
    for (int i = tid; i < 128 * 16; i += NWAVES * 64) {
        const int t = i >> 4, c = i & 15;
        const f32x4 a = *(const f32x4*)(wsg + t * 128 + 8 * c), b = *(const f32x4*)(wsg + t * 128 + 8 * c + 4);
        float v[8] = {a.x, a.y, a.z, a.w, b.x, b.y, b.z, b.w};
#pragma unroll
        for (int j = 0; j < 8; ++j) if (8 * c + j > t) v[j] = 0.f;
        v4u o; o.x = pk2(v[0], v[1]); o.y = pk2(v[2], v[3]); o.z = pk2(v[4], v[5]); o.w = pk2(v[6], v[7]);
        *(LAS v4u*)(lds + (t * MA_WS_STRIDE + 8 * c) * 2) = o;
    }
}
__device__ __forceinline__ void mixa_unit(LAS unsigned char* lds, int u, const bf16_t* UA, const bf16_t* VA, const float* g_v, const float* b_s, bf16_t* YA, int tid, int lane, int wave) {
    const int g = u & 3, bn = u >> 2, t0 = bn * 128, c0 = g * 128;
    const int fr = lane & 15, fq = lane >> 4;
    v4u vraw[4];
#pragma unroll
    for (int i = 0; i < 4; ++i) vraw[i] = *(const GAS v4u*)(VA + (size_t)(t0 + (tid >> 4) + 32 * i) * 512 + c0 + 8 * (tid & 15));
    v2u ur[8]; float bias[8];
#pragma unroll
    for (int j = 0; j < 8; ++j) { const int t = 16 * j + fr; ur[j] = *(const GAS v2u*)(UA + (size_t)(t0 + t) * 512 + c0 + 16 * wave + 4 * fq); bias[j] = b_s[g * 128 + t]; }
    const f32x4 gv = *(const f32x4*)(g_v + c0 + 16 * wave + 4 * fq);
#pragma unroll
    for (int i = 0; i < 4; ++i) {
        const int s_ = (tid >> 4) + 32 * i, c = tid & 15;
        const v4u raw = vraw[i];
        float v[8];
#pragma unroll
        for (int j = 0; j < 4; ++j) { v[2 * j] = __uint_as_float(raw[j] << 16); v[2 * j + 1] = __uint_as_float(raw[j] & 0xffff0000u); }
        float ss = 0.f;
#pragma unroll
        for (int j = 0; j < 8; ++j) ss += v[j] * v[j];
        ss += __shfl_xor(ss, 1); ss += __shfl_xor(ss, 2); ss += __shfl_xor(ss, 4); ss += __shfl_xor(ss, 8);
        const float rs = rsqrtf(ss * (1.f / 128.f) + EPS);
        v4u o; o.x = pk2(v[0] * rs, v[1] * rs); o.y = pk2(v[2] * rs, v[3] * rs); o.z = pk2(v[4] * rs, v[5] * rs); o.w = pk2(v[6] * rs, v[7] * rs);
        *(LAS v4u*)(lds + MA_VS_OFF + (s_ * MA_VS_STRIDE + 8 * c) * 2) = o;
    }
    LDS_WAIT(); __syncthreads();
    bf16x8 vf[4];
#pragma unroll
    for (int ks = 0; ks < 4; ++ks) {
        LAS const unsigned char* p = lds + MA_VS_OFF + ((32 * ks + 8 * fq + (fr >> 2)) * MA_VS_STRIDE + 16 * wave + 4 * (lane & 3)) * 2;
        const s16x4 lo = lds_tr16(p), hi = lds_tr16(p + 4 * MA_VS_STRIDE * 2);
        vf[ks] = (bf16x8){lo[0], lo[1], lo[2], lo[3], hi[0], hi[1], hi[2], hi[3]};
    }
#pragma unroll
    for (int j = 0; j < 8; ++j) {
        f32x4 acc = {0.f, 0.f, 0.f, 0.f};
#pragma unroll
        for (int ks = 0; ks < 4; ++ks) if (ks <= (j >> 1)) {
            const bf16x8 wf = *(const LAS bf16x8*)(lds + ((16 * j + fr) * MA_WS_STRIDE + 32 * ks + 8 * fq) * 2);
            acc = __builtin_amdgcn_mfma_f32_16x16x32_bf16(vf[ks], wf, acc, 0, 0, 0);
        }
        const int t = 16 * j + fr;
        const size_t off = (size_t)(t0 + t) * 512 + c0 + 16 * wave + 4 * fq;
        v2u o;
        o.x = pk2(__uint_as_float(ur[j].x << 16) * (acc[0] * gv[0] + bias[j]), __uint_as_float(ur[j].x & 0xffff0000u) * (acc[1] * gv[1] + bias[j]));
        o.y = pk2(__uint_as_float(ur[j].y << 16) * (acc[2] * gv[2] + bias[j]), __uint_as_float(ur[j].y & 0xffff0000u) * (acc[3] * gv[3] + bias[j]));
        *(GAS v2u*)(YA + off) = o;
    }
    LDS_WAIT(); __syncthreads();
}

__device__ __forceinline__ void combine_row(int m, const bf16_t* YA, const bf16_t* OP, const float* LP, const float* g_out_a, const float* g_out_b, bf16_t* YCAT, int lane) {
    const int nsel = min((m & (S_ - 1)) >> 8, 3);
    const int h = lane >> 3;
    float o[8], l = 0.f;
#pragma unroll
    for (int j = 0; j < 8; ++j) o[j] = 0.f;
#pragma unroll
    for (int sl = 0; sl < 4; ++sl) {
        if (sl == 3 || sl < nsel) {
            const v4u raw = *(const GAS v4u*)(OP + ((size_t)sl * T_ + m) * 512 + 8 * lane);
#pragma unroll
            for (int j = 0; j < 4; ++j) { o[2 * j] += __uint_as_float(raw[j] << 16); o[2 * j + 1] += __uint_as_float(raw[j] & 0xffff0000u); }
            l += LP[((size_t)sl * T_ + m) * 8 + h];
        }
    }
    const float il = 1.f / l;
    float sb = 0.f;
#pragma unroll
    for (int j = 0; j < 8; ++j) { o[j] *= il; sb += o[j] * o[j]; }
    const v4u ar = *(const GAS v4u*)(YA + (size_t)m * 512 + 8 * lane);
    float a[8], sa = 0.f;
#pragma unroll
    for (int j = 0; j < 4; ++j) { a[2 * j] = __uint_as_float(ar[j] << 16); a[2 * j + 1] = __uint_as_float(ar[j] & 0xffff0000u); }
#pragma unroll
    for (int j = 0; j < 8; ++j) sa += a[j] * a[j];
    sa = wave_sum_x(sa); sb = wave_sum_x(sb);
    const float ra = rsqrtf(sa * (1.f / 512.f) + EPS), rb = rsqrtf(sb * (1.f / 512.f) + EPS);
    const f32x4 ga0 = *(const f32x4*)(g_out_a + 8 * lane), ga1 = *(const f32x4*)(g_out_a + 8 * lane + 4);
    const f32x4 gb0 = *(const f32x4*)(g_out_b + 8 * lane), gb1 = *(const f32x4*)(g_out_b + 8 * lane + 4);
    v4u wa, wb;
    wa.x = pk2(a[0] * ra * ga0[0], a[1] * ra * ga0[1]); wa.y = pk2(a[2] * ra * ga0[2], a[3] * ra * ga0[3]); wa.z = pk2(a[4] * ra * ga1[0], a[5] * ra * ga1[1]); wa.w = pk2(a[6] * ra * ga1[2], a[7] * ra * ga1[3]);
    wb.x = pk2(o[0] * rb * gb0[0], o[1] * rb * gb0[1]); wb.y = pk2(o[2] * rb * gb0[2], o[3] * rb * gb0[3]); wb.z = pk2(o[4] * rb * gb1[0], o[5] * rb * gb1[1]); wb.w = pk2(o[6] * rb * gb1[2], o[7] * rb * gb1[3]);
    *(GAS v4u*)(YCAT + (size_t)m * D_ + 8 * lane) = wa;
    *(GAS v4u*)(YCAT + (size_t)m * D_ + 512 + 8 * lane) = wb;
}

__device__ __forceinline__ void gate_task(int task, const bf16_t* QN, const float* KMEAN, unsigned* qcnt, unsigned short* QL, int lane, LAS float* kml  ) {
    const int qq = task & 3; int r = task >> 2; const int i = (r % 15) + 1; r /= 15; const int h = r & 7, b = r >> 3;
    const int s_ = i * 256 + qq * 64 + lane;
    const bf16_t* qp = QN + ((size_t)(b * NH + h) * S_ + s_) * DH;
    float q[64];
#pragma unroll
    for (int c = 0; c < 8; ++c) { const v4u raw = *(const GAS v4u*)(qp + 8 * c);
#pragma unroll
        for (int j = 0; j < 4; ++j) { q[8 * c + 2 * j] = __uint_as_float(raw[j] << 16); q[8 * c + 2 * j + 1] = __uint_as_float(raw[j] & 0xffff0000u); } }
    float v0 = -INFINITY, v1 = -INFINITY, v2 = -INFINITY; int i0 = -1, i1 = -1, i2 = -1;
    const float* kmb = KMEAN + (size_t)((b * NH + h) * NBLK) * DH;
    {
        f32x4 t4[4];
#pragma unroll
        for (int c = 0; c < 4; ++c) t4[c] = *(const GAS f32x4*)(kmb + c * 256 + lane * 4);
#pragma unroll
        for (int c = 0; c < 4; ++c) *(LAS f32x4*)(kml + c * 256 + lane * 4) = t4[c];
        LDS_WAIT(); asm volatile("" ::: "memory");
    }
#pragma unroll 1
    for (int n = 0; n < i; ++n) {
        const LAS float* km = kml + n * DH;
        float sc = 0.f;
#pragma unroll
        for (int d4 = 0; d4 < 16; ++d4) { const f32x4 kv = *(const LAS f32x4*)(km + 4 * d4); sc += q[4 * d4] * kv.x; sc += q[4 * d4 + 1] * kv.y; sc += q[4 * d4 + 2] * kv.z; sc += q[4 * d4 + 3] * kv.w; }
        if (sc > v0) { v2 = v1; i2 = i1; v1 = v0; i1 = i0; v0 = sc; i0 = n; }
        else if (sc > v1) { v2 = v1; i2 = i1; v1 = sc; i1 = n; }
        else if (sc > v2) { v2 = sc; i2 = n; }
    }
    const int lbase = (b * NH + h) * NBLK;
    int mycount = 0, rk0 = 0, rk1 = 0, rk2 = 0;
    const unsigned long long lt = (1ull << lane) - 1ull;
#pragma unroll 1
    for (int n = 0; n < i; ++n) {
        const unsigned long long mask = __ballot((i0 == n) | (i1 == n) | (i2 == n));
        const int below = __popcll(mask & lt);
        if (lane == n) mycount = __popcll(mask);
        if (i0 == n) rk0 = below;
        if (i1 == n) rk1 = below;
        if (i2 == n) rk2 = below;
    }
    unsigned mybase = 0;
    if (lane < i && mycount > 0) mybase = __hip_atomic_fetch_add(qcnt + lbase + lane, (unsigned)mycount, RLX_AGENT);
#pragma unroll
    for (int k = 0; k < 3; ++k) {
        const int sel = (k == 0) ? i0 : (k == 1) ? i1 : i2;
        const int rank = (k == 0) ? rk0 : (k == 1) ? rk1 : rk2;
        const unsigned base = (unsigned)__shfl((int)mybase, sel < 0 ? 0 : sel);
        if (sel >= 0) QL[(size_t)(lbase + sel) * 4096 + base + rank] = (unsigned short)(s_ | (k << 12));
    }
}

constexpr int AT_IPREF = XTRA_OFF + 2048, AT_ICNT = XTRA_OFF + 4352, AT_MYIT = XTRA_OFF + 6400;
__device__ __forceinline__ void attn_stage_tile(LAS unsigned char* dst, const bf16_t* src  , int wave, int lane) {
#pragma unroll
    for (int i = 0; i < 4; ++i) {
        const int key = 8 * (wave * 4 + i) + (lane >> 3), ch = (lane & 7) ^ (key & 7);
        __builtin_amdgcn_global_load_lds((const unsigned*)(src + (size_t)key * DH + ch * 8), (LAS unsigned*)(dst + (wave * 4 + i) * 1024), 16, 0, 0);
    }
}
__device__ __forceinline__ bf16x8 scale_bf16x8(const v4u raw, float c) {
    v4u o;
#pragma unroll
    for (int j = 0; j < 4; ++j) o[j] = cvt_pk(__uint_as_float(raw[j] << 16) * c, __uint_as_float(raw[j] & 0xffff0000u) * c);
    return __builtin_bit_cast(bf16x8, o);
}

template <bool OWN>
__device__ __forceinline__ void attn_item(LAS const unsigned char* Kb, LAS const unsigned char* Vb, const bf16x8 (&qf)[2][2], const float MREF, f32x4 (&O)[4][2], float& lsum0, float& lsum1,
                                          const int fr, const int fq, const int lane, const int ql0, const int ql1) {
    bf16x8 KA[2][2], KB[2][2], VA[4], VB[4], P[2];
    f32x4 SA[2][2], SB[2][2];
    const int kb0 = fr * 128 + ((fq ^ (fr & 7)) << 4), kb1 = fr * 128 + (((4 + fq) ^ (fr & 7)) << 4);
    int vb[4];
    { const int kq = 4 * fq + (fr >> 2);
#pragma unroll
      for (int dt = 0; dt < 4; ++dt) vb[dt] = kq * 128 + (((2 * dt + ((lane & 3) >> 1)) ^ (kq & 7)) << 4) + (lane & 1) * 8; }
    const bf16x8 ones = (bf16x8){0x3f80, 0x3f80, 0x3f80, 0x3f80, 0x3f80, 0x3f80, 0x3f80, 0x3f80};
    f32x4 L0 = {0.f, 0.f, 0.f, 0.f}, L1 = {0.f, 0.f, 0.f, 0.f};
    const int emax0 = OWN ? __builtin_amdgcn_readfirstlane(ql0 >> 5) : 7, emax1 = OWN ? __builtin_amdgcn_readfirstlane(ql1 >> 5) : 7;
#define SBAR() __builtin_amdgcn_sched_barrier(0)
#define LDK(e, KF) do { _Pragma("unroll") for (int kt = 0; kt < 2; ++kt) { \
        KF[kt][0] = *(const LAS bf16x8*)(Kb + kb0 + (32 * (e) + 16 * kt) * 128); KF[kt][1] = *(const LAS bf16x8*)(Kb + kb1 + (32 * (e) + 16 * kt) * 128); } } while (0)
#define MMS(e, KF, S) do { _Pragma("unroll") for (int kt = 0; kt < 2; ++kt) { \
        if (!OWN || (e) <= emax0) { f32x4 a = {-MREF, -MREF, -MREF, -MREF}; a = __builtin_amdgcn_mfma_f32_16x16x32_bf16(KF[kt][0], qf[0][0], a, 0, 0, 0); S[kt][0] = __builtin_amdgcn_mfma_f32_16x16x32_bf16(KF[kt][1], qf[0][1], a, 0, 0, 0); } \
        if (!OWN || (e) <= emax1) { f32x4 a = {-MREF, -MREF, -MREF, -MREF}; a = __builtin_amdgcn_mfma_f32_16x16x32_bf16(KF[kt][0], qf[1][0], a, 0, 0, 0); S[kt][1] = __builtin_amdgcn_mfma_f32_16x16x32_bf16(KF[kt][1], qf[1][1], a, 0, 0, 0); } } } while (0)
#define EXPP1(e, S, qi, QL, EMAX) do { if (!OWN || (e) <= EMAX) { \
        _Pragma("unroll") for (int kt = 0; kt < 2; ++kt) _Pragma("unroll") for (int r = 0; r < 4; ++r) { float x = S[kt][qi][r]; \
            if (OWN) { if (32 * (e) + 16 * kt + 4 * fq + r > QL) x = -INFINITY; } S[kt][qi][r] = __builtin_amdgcn_exp2f(x); } \
        v4u w; w.x = cvt_pk(S[0][qi][0], S[0][qi][1]); w.y = cvt_pk(S[0][qi][2], S[0][qi][3]); w.z = cvt_pk(S[1][qi][0], S[1][qi][1]); w.w = cvt_pk(S[1][qi][2], S[1][qi][3]); P[qi] = __builtin_bit_cast(bf16x8, w); } } while (0)
#define EXPP(e, S) do { EXPP1(e, S, 0, ql0, emax0); EXPP1(e, S, 1, ql1, emax1); } while (0)
#define LDV(e, VF) do { _Pragma("unroll") for (int dt = 0; dt < 4; ++dt) { \
            const s16x4 lo = lds_tr16(Vb + vb[dt] + (32 * (e)) * 128); const s16x4 hi = lds_tr16(Vb + vb[dt] + (32 * (e) + 16) * 128); \
            VF[dt] = (bf16x8){lo[0], lo[1], lo[2], lo[3], hi[0], hi[1], hi[2], hi[3]}; } } while (0)
#define MMV(e, VF) do { if (!OWN || (e) <= emax0) L0 = __builtin_amdgcn_mfma_f32_16x16x32_bf16(ones, P[0], L0, 0, 0, 0); \
        if (!OWN || (e) <= emax1) L1 = __builtin_amdgcn_mfma_f32_16x16x32_bf16(ones, P[1], L1, 0, 0, 0); \
        _Pragma("unroll") for (int dt = 0; dt < 4; ++dt) { \
        if (!OWN || (e) <= emax0) O[dt][0] = __builtin_amdgcn_mfma_f32_16x16x32_bf16(VF[dt], P[0], O[dt][0], 0, 0, 0); \
        if (!OWN || (e) <= emax1) O[dt][1] = __builtin_amdgcn_mfma_f32_16x16x32_bf16(VF[dt], P[1], O[dt][1], 0, 0, 0); } } while (0)
    LDK(0, KA); SBAR();
    LDK(1, KB); SBAR(); MMS(0, KA, SA); SBAR();
    LDK(2, KA); LDV(0, VA); SBAR(); MMS(1, KB, SB); EXPP(0, SA); SBAR();
    LDK(3, KB); LDV(1, VB); SBAR(); MMV(0, VA); MMS(2, KA, SA); EXPP(1, SB); SBAR();
    LDK(4, KA); LDV(2, VA); SBAR(); MMV(1, VB); MMS(3, KB, SB); EXPP(2, SA); SBAR();
    LDK(5, KB); LDV(3, VB); SBAR(); MMV(2, VA); MMS(4, KA, SA); EXPP(3, SB); SBAR();
    LDK(6, KA); LDV(4, VA); SBAR(); MMV(3, VB); MMS(5, KB, SB); EXPP(4, SA); SBAR();
    LDK(7, KB); LDV(5, VB); SBAR(); MMV(4, VA); MMS(6, KA, SA); EXPP(5, SB); SBAR();
    LDV(6, VA); SBAR(); MMV(5, VB); MMS(7, KB, SB); EXPP(6, SA); SBAR();
    LDV(7, VB); SBAR(); MMV(6, VA); EXPP(7, SB); SBAR();
    MMV(7, VB);
#undef SBAR
    lsum0 = L0[0]; lsum1 = L1[0];
#undef LDK
#undef MMS
#undef EXPP1
#undef EXPP
#undef LDV
#undef MMV
}
__device__ __forceinline__ void attn_phase(LAS unsigned char* L, const bf16_t* QN, const bf16_t* KN, const bf16_t* VB, const float* g_q, const float* g_k,
                                           const unsigned* qcnt, const unsigned short* QL, bf16_t* OP, float* LP, bf16_t* DUMMY, int vcu, int G, int tid, int lane, int wave) {
    LAS int* ipref = (LAS int*)(L + AT_IPREF); LAS int* icnt = (LAS int*)(L + AT_ICNT); LAS int* myit = (LAS int*)(L + AT_MYIT);
    {
        const int c = (int)__hip_atomic_load(qcnt + tid, RLX_AGENT);
        const int nit = 1 + ((c + 255) >> 8);
        int incl = nit;
#pragma unroll
        for (int o = 1; o < 64; o <<= 1) { const int v = __shfl_up(incl, o); if (lane >= o) incl += v; }
        icnt[tid] = c;
        if (lane == 63) myit[64 + wave] = incl;
        __syncthreads();
        int woff = 0;
        for (int w = 0; w < wave; ++w) woff += myit[64 + w];
        ipref[tid] = woff + incl - nit;
        if (tid == 511) ipref[512] = woff + incl;
        __syncthreads();
    }
    const int nitems = ipref[512];
    const int nmine = (nitems - vcu + G - 1) / G;
    if (tid < nmine && tid < 64) {
        const int Lx = tid * G + vcu; int t = 0;
#pragma unroll 1
        for (int j = 256; j > 0; j >>= 1) if (ipref[t + j] <= Lx) t += j;
        myit[tid] = (t << 8) | (Lx - ipref[t]);
    }
    __syncthreads();
    float gqm = fabsf(g_q[lane]), gkm = fabsf(g_k[lane]);
#pragma unroll
    for (int o = 1; o < 64; o <<= 1) { gqm = fmaxf(gqm, __shfl_xor(gqm, o)); gkm = fmaxf(gkm, __shfl_xor(gkm, o)); }
    const float MREF = 11.6f * gqm * gkm + 0.125f;
    const float CS = 0.125f * 1.4426950408889634f;
    const int fr = lane & 15, fq = lane >> 4;
    const int nloop = nmine < 64 ? nmine : 64;
    if (nloop <= 0) return;
#define AT_DECODE(itw, E0, E1, V0, V1) do { const int t_ = (itw) >> 8, k_ = (itw) & 255; \
        if (k_ == 0) { int l2_ = lane; asm volatile("" : "+v"(l2_)); const int f2_ = l2_ & 15; E0 = ((t_ & 15) * 256 + 16 * wave + f2_) | (3 << 12); E1 = ((t_ & 15) * 256 + 16 * (15 - wave) + f2_) | (3 << 12); V0 = 1; V1 = 1; } \
        else { const int base_ = (k_ - 1) * 256, nq_ = min(256, icnt[t_] - base_); const int q0 = 32 * wave + fr, q1 = q0 + 16; \
               const unsigned short* ql_ = QL + (size_t)t_ * 4096 + base_; V0 = q0 < nq_; V1 = q1 < nq_; \
               const unsigned short* p0_ = ql_ + (V0 ? q0 : 0); const unsigned short* p1_ = ql_ + (V1 ? q1 : 0); \
               asm volatile("global_load_ushort %0, %1, off" : "=v"(E0) : "v"(p0_) : "memory"); asm volatile("global_load_ushort %0, %1, off" : "=v"(E1) : "v"(p1_) : "memory"); } } while (0)
#define AT_QLOAD(itw, E0, E1, QR) do { const int t_ = (itw) >> 8; const int b_ = t_ >> 7, h_ = (t_ >> 4) & 7; \
        const bf16_t* q0_ = QN + ((size_t)(b_ * NH + h_) * S_ + ((E0) & 0xfff)) * DH + 8 * fq; const bf16_t* q1_ = QN + ((size_t)(b_ * NH + h_) * S_ + ((E1) & 0xfff)) * DH + 8 * fq; \
        const bf16_t* q0b_ = q0_ + 32; const bf16_t* q1b_ = q1_ + 32; \
        asm volatile("global_load_dwordx4 %0, %1, off" : "=v"(QR[0]) : "v"(q0_) : "memory"); asm volatile("global_load_dwordx4 %0, %1, off" : "=v"(QR[1]) : "v"(q0b_) : "memory"); \
        asm volatile("global_load_dwordx4 %0, %1, off" : "=v"(QR[2]) : "v"(q1_) : "memory"); asm volatile("global_load_dwordx4 %0, %1, off" : "=v"(QR[3]) : "v"(q1b_) : "memory"); } while (0)
#define AT_STAGE(itw, bufi) do { const int t_ = (itw) >> 8; const int b_ = t_ >> 7, h_ = (t_ >> 4) & 7, j_ = t_ & 15; const size_t r0_ = ((size_t)(b_ * NH + h_) * S_ + j_ * 256) * DH; \
        attn_stage_tile(L + (bufi) * 65536, KN + r0_, wave, lane); attn_stage_tile(L + (bufi) * 65536 + 32768, VB + r0_, wave, lane); } while (0)
    int it0 = myit[0];
    int ec0, ec1, xl0 = 0, xl1 = 0, vc0, vc1, vn0 = 0, vn1 = 0;
    v4u qn[4];
    AT_STAGE(it0, 0);
    AT_DECODE(it0, ec0, ec1, vc0, vc1);
    asm volatile("s_waitcnt vmcnt(0)" : "+v"(ec0), "+v"(ec1) :: "memory");
    AT_QLOAD(it0, ec0, ec1, qn);
    if (nloop > 1) { const int it1 = myit[1]; AT_DECODE(it1, xl0, xl1, vn0, vn1); }
    f32x4 O[4][2]; float lsum0 = 0.f, lsum1 = 0.f; int pe0 = 0, pe1 = 0, ph_ = 0, pb_ = 0;
    LAS unsigned char* ost = L + XTRA_OFF + 8192 + wave * 2304;
#define AT_STORE_PREV() do { _Pragma("unroll") for (int qi = 0; qi < 2; ++qi) { const int e = qi ? pe1 : pe0; \
            _Pragma("unroll") for (int dt = 0; dt < 4; ++dt) { v2u w; w.x = cvt_pk(O[dt][qi][0], O[dt][qi][1]); w.y = cvt_pk(O[dt][qi][2], O[dt][qi][3]); *(LAS v2u*)(ost + fr * 144 + 32 * dt + 8 * fq) = w; } \
            { const size_t row = (size_t)((e >> 12) & 3) * T_ + (size_t)(pb_ * S_ + (e & 0xfff)); float* lpd = ((e & 0x8000) && fq == 0) ? LP + row * 8 + ph_ : (float*)DUMMY + 1024 + lane; *(GAS float*)lpd = qi ? lsum1 : lsum0; } \
            LDS_WAIT(); asm volatile("" ::: "memory"); \
            _Pragma("unroll") for (int hh = 0; hh < 2; ++hh) { const int rq = (lane >> 3) + 8 * hh; const int er = __shfl(e, rq); \
                const v4u val = *(const LAS v4u*)(ost + rq * 144 + (lane & 7) * 16); \
                const size_t row = (size_t)((er >> 12) & 3) * T_ + (size_t)(pb_ * S_ + (er & 0xfff)); bf16_t* od = (er & 0x8000) ? OP + row * 512 + ph_ * 64 + (lane & 7) * 8 : DUMMY + lane * 8; *(GAS v4u*)od = val; } \
            LDS_WAIT(); asm volatile("" ::: "memory"); } } while (0)
    for (int it = 0; it < nloop; ++it) {
        const int itw = myit[it];
        const int t_ = itw >> 8, own = ((itw & 255) == 0);
        const int h_ = (t_ >> 4) & 7;
        if (it == 0) asm volatile("s_waitcnt vmcnt(0) lgkmcnt(0)" : "+v"(qn[0]), "+v"(qn[1]), "+v"(qn[2]), "+v"(qn[3]), "+v"(xl0), "+v"(xl1) :: "memory");
        else asm volatile("s_waitcnt vmcnt(6) lgkmcnt(0)" : "+v"(qn[0]), "+v"(qn[1]), "+v"(qn[2]), "+v"(qn[3]), "+v"(xl0), "+v"(xl1) :: "memory");
        __builtin_amdgcn_s_barrier(); asm volatile("" ::: "memory");
        const int en0 = xl0, en1 = xl1;
        bf16x8 qf[2][2];
        qf[0][0] = scale_bf16x8(qn[0], CS); qf[0][1] = scale_bf16x8(qn[1], CS); qf[1][0] = scale_bf16x8(qn[2], CS); qf[1][1] = scale_bf16x8(qn[3], CS);
        int vx0 = 0, vx1 = 0;
        if (it + 1 < nloop) {
            const int itn = myit[it + 1];
            AT_STAGE(itn, (it + 1) & 1);
            AT_QLOAD(itn, en0, en1, qn);
            if (it + 2 < nloop) { const int itn2 = myit[it + 2]; AT_DECODE(itn2, xl0, xl1, vx0, vx1); }
        }
        asm volatile("" ::: "memory");
        LAS const unsigned char* Kb = L + (it & 1) * 65536; LAS const unsigned char* Vb = Kb + 32768;
        lsum0 = 0.f; lsum1 = 0.f;
#pragma unroll
        for (int dt = 0; dt < 4; ++dt) { O[dt][0] = (f32x4){0.f, 0.f, 0.f, 0.f}; O[dt][1] = (f32x4){0.f, 0.f, 0.f, 0.f}; }
        const int ql0 = (ec0 & 0xff), ql1 = (ec1 & 0xff);
        if (own) attn_item<true>(Kb, Vb, qf, MREF, O, lsum0, lsum1, fr, fq, lane, ql0, ql1);
        else attn_item<false>(Kb, Vb, qf, MREF, O, lsum0, lsum1, fr, fq, lane, ql0, ql1);
        pe0 = ec0 | (vc0 << 15); pe1 = ec1 | (vc1 << 15); ph_ = h_; pb_ = t_ >> 7;
        AT_STORE_PREV();
        ec0 = en0; ec1 = en1; vc0 = vn0; vc1 = vn1; vn0 = vx0; vn1 = vx1;
    }
    asm volatile("s_waitcnt vmcnt(0) lgkmcnt(0)" ::: "memory"); __builtin_amdgcn_s_barrier();
#undef AT_STORE_PREV
#undef AT_DECODE
#undef AT_QLOAD
#undef AT_STAGE
}

__global__ void __launch_bounds__(NWAVES * 64, 2) mk_fwd(Args args) {
    extern __shared__ __attribute__((aligned(16))) unsigned char lds[];
    LAS unsigned char* L = (LAS unsigned char*)lds;
    volatile LAS unsigned* MISC = (volatile LAS unsigned*)(L + MISC_OFF);
    const int tid = threadIdx.x, lane = tid & 63, wave = __builtin_amdgcn_readfirstlane(tid >> 6);
    const int G = gridDim.x; const int bx = blockIdx.x;
    const int vcu = (G % 8 == 0) ? (bx % 8) * (G / 8) + bx / 8 : bx;
    unsigned char* ws = args.ws;
    gu32* ctl = (gu32*)(ws + WS_CTL);
    const float* x = args.in[0]; const float* p_in = args.in[1]; const float* g_mix = args.in[2]; const float* w_in = args.in[3];
    const float* g_q = args.in[7]; const float* g_k = args.in[8];
    const float* w_out = args.in[11]; const float* g_ffn = args.in[12];
    const float* w_gate_e = args.in[15]; const float* w_up_e = args.in[16]; const float* w_down_e = args.in[17];
    const float* g_ple = args.in[18]; const float* w_ple = args.in[19]; const float* w_ple_gate = args.in[20];
    bf16_t* WIN = (bf16_t*)(ws + WS_WIN); bf16_t* WOUT = (bf16_t*)(ws + WS_WOUT); bf16_t* WGU = (bf16_t*)(ws + WS_WGU); bf16_t* WD = (bf16_t*)(ws + WS_WD);
    bf16_t* WPLE = (bf16_t*)(ws + WS_WPLE); bf16_t* WPG = (bf16_t*)(ws + WS_WPG);
    bf16_t* XN = (bf16_t*)(ws + WS_XN); bf16_t* PB = (bf16_t*)(ws + WS_PB); bf16_t* ARR0 = (bf16_t*)(ws + WS_ARR); bf16_t* PW = (bf16_t*)(ws + WS_PW);
    float* KMEAN = (float*)(ws + WS_KMEAN); float* SSQ1 = (float*)(ws + WS_SSQ1);
    const float* w_group = args.in[13]; const float* w_expert = args.in[14];
    bf16_t* YCAT = (bf16_t*)(ws + WS_YCAT); bf16_t* H1B = (bf16_t*)(ws + WS_H1B); bf16_t* A2 = (bf16_t*)(ws + WS_A2); bf16_t* YS = (bf16_t*)(ws + WS_YS); bf16_t* H2B = (bf16_t*)(ws + WS_H2B);
    unsigned* LTOK = (unsigned*)(ws + WS_LTOK); f32x2* LSC = (f32x2*)(ws + WS_LSC); float* RSTD2 = (float*)(ws + WS_RSTD2); bf16_t* WR = (bf16_t*)(ws + WS_WR);
    float* OUT = args.out;
    const float* g_v_a = args.in[4]; const float* w_s = args.in[5]; const float* b_s = args.in[6]; const float* g_out_a = args.in[9]; const float* g_out_b = args.in[10];
    unsigned short* QLp = (unsigned short*)(ws + WS_QL);
    bf16_t* YA = (bf16_t*)(ws + WS_YA); bf16_t* OP = (bf16_t*)args.out; float* LP = (float*)(ws + WS_LP);

    for (int u = tid; u < (LDS_BYTES - LDSCTL_OFF) / 4; u += NWAVES * 64) ((LAS unsigned*)(L + LDSCTL_OFF))[u] = 0u;
    __syncthreads();
    const int lo = args.ph_lo, hi = args.ph_hi;
    const bool multi = (hi - lo) > 1;
    XcdBarrier bar; bar.bar = (unsigned*)(ctl + CW_BAR); bar.x = 0; bar.st = nullptr;
    if (multi) bar = xcd_barrier_post((unsigned*)(ctl + CW_BAR), MISC + 8);
#ifdef PROBE_PHASE
    unsigned long long* TS = (unsigned long long*)(ws + WS_ORC);
#define STAMP(k) do { if (bx == 0 && tid == 0) TS[k] = __builtin_amdgcn_s_memrealtime(); } while (0)
#else
#define STAMP(k) do {} while (0)
#endif
#define IN(k) (lo <= (k) && (k) < hi)
#define SEAM(k) do { if (IN(k) && IN((k) + 1)) xcd_barrier(bar); STAMP((k) + 1); } while (0)

    STAMP(0);
    if (IN(0)) {
        const int gw = vcu * NWAVES + wave, NGW = G * NWAVES;
        {
            constexpr int T_IN = 16 * 10, T_OUT = 16 * 4, T_G = 32 * 16, T_U = T_G, T_D = 32 * 16, T_PLE = 4 * 4, T_PG = 16 * 4;
            constexpr int NTILES = T_IN + T_OUT + T_G + T_U + T_D + T_PLE + T_PG;
            constexpr int NTP = 257, TBUF = 64 * NTP * 4;
#define P0_DECODE(itv, SRC, DST, GAIN, KK, NN, K0, N0, MM) do { int r_ = (itv); int tl_ = 0; MM = 0; \
                if (r_ < T_IN) { SRC = w_in; DST = WIN; GAIN = g_mix; KK = 1024; NN = 2560; MM = 1; tl_ = r_; } \
                else if ((r_ -= T_IN) < T_OUT) { SRC = w_out; DST = WOUT; GAIN = nullptr; KK = 1024; NN = 1024; tl_ = r_; } \
                else if ((r_ -= T_OUT) < T_G) { const int e_ = r_ >> 4; SRC = w_gate_e + (size_t)e_ * 1024 * 256; DST = WGU + (size_t)e_ * 512 * 1024; GAIN = g_ffn; KK = 1024; NN = 256; MM = 2; tl_ = r_ & 15; } \
                else if ((r_ -= T_G) < T_U) { const int e_ = r_ >> 4; SRC = w_up_e + (size_t)e_ * 1024 * 256; DST = WGU + (size_t)e_ * 512 * 1024; GAIN = g_ffn; KK = 1024; NN = 256; MM = 3; tl_ = r_ & 15; } \
                else if ((r_ -= T_U) < T_D) { const int e_ = r_ >> 4; SRC = w_down_e + (size_t)e_ * 256 * 1024; DST = WD + (size_t)e_ * 1024 * 256; GAIN = nullptr; KK = 256; NN = 1024; tl_ = r_ & 15; } \
                else if ((r_ -= T_D) < T_PLE) { SRC = w_ple; DST = WPLE; GAIN = nullptr; KK = 256; NN = 1024; tl_ = r_; } \
                else { r_ -= T_PLE; SRC = w_ple_gate; DST = WPG; GAIN = g_ple; KK = 1024; NN = 1024; tl_ = r_; } \
                const int nblk_ = NN / 256; K0 = 64 * (tl_ / nblk_); N0 = 256 * (tl_ % nblk_); } while (0)
#define P0_LOAD(SRC, GAIN, NN, K0, N0) do { _Pragma("unroll") for (int i_ = 0; i_ < 8; ++i_) { const int kk_ = 8 * wave + i_; \
                pv[i_] = *(const GAS f32x4*)(SRC + (size_t)(K0 + kk_) * NN + N0 + 4 * lane); pg[i_] = GAIN ? GAIN[K0 + kk_] : 1.f; } } while (0)
            const float* csrc = nullptr; bf16_t* cdst = nullptr; const float* cgain = nullptr; int cK = 0, cN = 0, ck0 = 0, cn0 = 0, cmm = 0;
            f32x4 pv[8]; float pg[8];
            int tl = vcu, pbuf = 0;
            if (tl < NTILES) { P0_DECODE(tl, csrc, cdst, cgain, cK, cN, ck0, cn0, cmm); P0_LOAD(csrc, cgain, cN, ck0, cn0); }
            while (tl < NTILES) {
                LAS float* tb = (LAS float*)(L + pbuf * TBUF);
#pragma unroll
                for (int i = 0; i < 8; ++i) { LAS float* d_ = tb + (8 * wave + i) * NTP + 4 * lane; const f32x4 v = pv[i] * pg[i]; d_[0] = v.x; d_[1] = v.y; d_[2] = v.z; d_[3] = v.w; }
                bf16_t* odst = cdst; const int oK = cK, ok0 = ck0, on0 = cn0, omm = cmm;
                const int tln = tl + G;
                LDS_WAIT(); __syncthreads();
                if (tln < NTILES) { P0_DECODE(tln, csrc, cdst, cgain, cK, cN, ck0, cn0, cmm); P0_LOAD(csrc, cgain, cN, ck0, cn0); }
                asm volatile("" ::: "memory");
                const int kc = lane & 7;
#pragma unroll
                for (int j = 0; j < 4; ++j) {
                    const int c = (tid >> 3) + 64 * j;
                    const LAS float* s_ = tb + (8 * kc) * NTP + c;
                    v4u o; o.x = pk2(s_[0 * NTP], s_[1 * NTP]); o.y = pk2(s_[2 * NTP], s_[3 * NTP]); o.z = pk2(s_[4 * NTP], s_[5 * NTP]); o.w = pk2(s_[6 * NTP], s_[7 * NTP]);
                    int drow = on0 + c;
                    if (omm == 1) { if (on0 >= 1024 && on0 < 2048) drow = on0 + 128 * ((c >> 5) & 1) + 32 * (c >> 6) + (c & 31); }
                    else if (omm == 2) drow = (c >> 7) * 256 + (c & 127);
                    else if (omm == 3) drow = (c >> 7) * 256 + 128 + (c & 127);
                    *(GAS v4u*)(odst + (size_t)drow * oK + ok0 + 8 * kc) = o;
                }
                tl = tln; pbuf ^= 1;
            }
            LDS_WAIT(); __syncthreads();
#undef P0_DECODE
#undef P0_LOAD
        }
        for (int m = gw; m < T_; m += 2 * NGW) {
            const GAS f32x4* xr0 = (const GAS f32x4*)(x + (size_t)m * D_) + lane; const GAS f32x4* xr1 = (const GAS f32x4*)(x + (size_t)(m + NGW) * D_) + lane;
            f32x4 v0[4], v1[4]; float s0 = 0.f, s1 = 0.f;
#pragma unroll
            for (int j = 0; j < 4; ++j) { v0[j] = xr0[64 * j]; v1[j] = xr1[64 * j]; }
#pragma unroll
            for (int j = 0; j < 4; ++j) { s0 += (v0[j].x * v0[j].x + v0[j].y * v0[j].y) + (v0[j].z * v0[j].z + v0[j].w * v0[j].w); s1 += (v1[j].x * v1[j].x + v1[j].y * v1[j].y) + (v1[j].z * v1[j].z + v1[j].w * v1[j].w); }
            const float r0 = rsqrtf(wave_sum_x(s0) * (1.f / D_) + EPS), r1 = rsqrtf(wave_sum_x(s1) * (1.f / D_) + EPS);
            GAS v2u* o0 = (GAS v2u*)(XN + (size_t)m * D_) + lane; GAS v2u* o1 = (GAS v2u*)(XN + (size_t)(m + NGW) * D_) + lane;
#pragma unroll
            for (int j = 0; j < 4; ++j) { v2u w; w.x = pk2(v0[j].x * r0, v0[j].y * r0); w.y = pk2(v0[j].z * r0, v0[j].w * r0); o0[64 * j] = w;
                                          v2u w2; w2.x = pk2(v1[j].x * r1, v1[j].y * r1); w2.y = pk2(v1[j].z * r1, v1[j].w * r1); o1[64 * j] = w2; }
        }
        for (int i = gw * 64 + lane; i < 48 * 1024; i += NGW * 64) {
            const int jj = i >> 10, k = i & 1023; float v = 0.f;
            if (jj < 4) v = w_group[k * 4 + jj] * g_ffn[k];
            else if (jj >= 16) { const int hi = (jj >= 32), g = ((jj - 16) & 15) >> 2, r = jj & 3; v = w_expert[k * 32 + g * 8 + hi * 4 + r] * g_ffn[k]; }
            WR[i] = (bf16_t)f2bf(v);
        }
    }
    SEAM(0);
    if (IN(1)) {
        pg8::StaticOrder S; S.init(XN, WIN, T_, 2048, D_, G, bx);
        EpiInProj E{ARR0, KMEAN, g_q, g_k, 0, 0};
        pg8::gemm_phase<EpiInProj, pg8::StaticOrder, true>(L + RING_OFF, D_, S, E);
    }
    SEAM(1);
    if (IN(2)) {
        const int GH = G >> 1;
        if (bx < GH) {
            pg8::StaticOrder S; S.init(XN, WIN + (size_t)2048 * 1024, T_, 512, D_, GH, bx);
            EpiInProj E{ARR0, KMEAN, g_q, g_k, 8, 0};
            pg8::gemm_phase<EpiInProj, pg8::StaticOrder, true>(L + RING_OFF, D_, S, E);
        } else {
            const int c2 = bx - GH, G2 = G - GH;
            { const int gw = c2 * NWAVES + wave, NGW = G2 * NWAVES;
              for (int tk = gw; tk < NB_ * NH * 15 * 4; tk += NGW) { const int task = (tk < NGW) ? tk : (NB_ * NH * 15 * 4 - 1) - (tk - NGW); if (task < NGW && tk >= NGW) continue; gate_task(task, ARR0 + 2 * ARR, KMEAN, (unsigned*)ctl + CW_QCNT, QLp, lane, (LAS float*)(L + RING_OFF + 81920 + wave * 4096)); }
              LDS_WAIT(); }
            int curg = -1;
            for (int u = c2; u < 512; u += G2) {
                const int g = u & 3;
                if (g != curg) { mixa_load_w(L + RING_OFF, w_s + (size_t)g * 128 * 128, tid); curg = g; }
                mixa_unit(L + RING_OFF, u, ARR0, ARR0 + ARR, g_v_a, b_s, YA, tid, lane, wave);
            }
        }
    }
    SEAM(2);
    if (IN(3)) attn_phase(L, ARR0 + 2 * ARR, ARR0 + 3 * ARR, ARR0 + 4 * ARR, g_q, g_k, (const unsigned*)ctl + CW_QCNT, QLp, OP, LP, (bf16_t*)(ws + 200 * MiB), vcu, G, tid, lane, wave);
    SEAM(3);
    if (IN(PH_COMB)) {
        const int gw = vcu * NWAVES + wave, NGW = G * NWAVES;
        for (int m = gw; m < T_; m += NGW) combine_row(m, YA, OP, LP, g_out_a, g_out_b, YCAT, lane);
    }
    SEAM(PH_COMB);
    if (IN(5)) {
        pg8::StaticOrder S; S.init(YCAT, WOUT, T_, D_, D_, G, bx);
        EpiOutProj E{x, H1B, SSQ1};
        pg8::gemm_phase<EpiOutProj, pg8::StaticOrder, true>(L + RING_OFF, D_, S, E);
    }
    SEAM(5);
    if (IN(6)) {
        { const int gw = vcu * NWAVES + wave, NGW = G * NWAVES;
          for (int m = gw; m < T_; m += NGW) {
              const f32x4 v = ((const GAS f32x4*)(p_in + (size_t)m * DPLE))[lane];
              v2u w; w.x = pk2(v.x, v.y); w.y = pk2(v.z, v.w);
              ((GAS v2u*)(PB + (size_t)m * DPLE))[lane] = w;
          } }
        LAS int* hist = (LAS int*)(L + XTRA_OFF); LAS int* hbase = hist + 32;
        for (int chunk = vcu; chunk < T_ / 64; chunk += G) {
            if (tid < 32) hist[tid] = 0;
            __syncthreads();
            int e1 = -1, e2 = -1, rk1 = 0, rk2 = 0, tok = 0; float c1 = 0.f, c2 = 0.f, rs1 = 0.f;
            LAS float* part = (LAS float*)(L + RING_OFF + 100352);
            {
                const int fr = lane & 15, fq = lane >> 4;
                const int t0 = chunk * 64 + (wave & 3) * 16, kh = wave >> 2;
                f32x4 d0 = {0.f, 0.f, 0.f, 0.f}, d1 = d0, d2 = d0;
                const bf16_t* ap = H1B + (size_t)(t0 + fr) * D_ + 8 * fq + kh * 512;
                bf16x8 hf[16];
#pragma unroll
                for (int ks = 0; ks < 16; ++ks) hf[ks] = *(const bf16x8*)(ap + ks * 32);
                const float ssq_tok = SSQ1[t0 + fr];
#pragma unroll
                for (int i = 0; i < 12; ++i) { const int pc = tid + 512 * i, rr = pc >> 7, cc = pc & 127; *(LAS v4u*)(L + RING_OFF + rr * 2064 + cc * 16) = *(const GAS v4u*)(WR + (size_t)rr * D_ + cc * 8); }
                LDS_WAIT(); __syncthreads();
                LAS const unsigned char* bpl = L + RING_OFF + fr * 2064 + (8 * fq + kh * 512) * 2;
#pragma unroll
                for (int ks = 0; ks < 16; ++ks) {
                    const bf16x8 w0 = *(const LAS bf16x8*)(bpl + ks * 64), w1 = *(const LAS bf16x8*)(bpl + 16 * 2064 + ks * 64), w2 = *(const LAS bf16x8*)(bpl + 32 * 2064 + ks * 64);
                    d0 = __builtin_amdgcn_mfma_f32_16x16x32_bf16(w0, hf[ks], d0, 0, 0, 0);
                    d1 = __builtin_amdgcn_mfma_f32_16x16x32_bf16(w1, hf[ks], d1, 0, 0, 0);
                    d2 = __builtin_amdgcn_mfma_f32_16x16x32_bf16(w2, hf[ks], d2, 0, 0, 0);
                }
                if (kh == 1) {
#pragma unroll
                    for (int r = 0; r < 4; ++r) { part[((wave & 3) * 12 + r) * 64 + lane] = d0[r]; part[((wave & 3) * 12 + 4 + r) * 64 + lane] = d1[r]; part[((wave & 3) * 12 + 8 + r) * 64 + lane] = d2[r]; }
                }
                LDS_WAIT(); __syncthreads();
              if (kh == 0) {
#pragma unroll
                for (int r = 0; r < 4; ++r) { d0[r] += part[(wave * 12 + r) * 64 + lane]; d1[r] += part[(wave * 12 + 4 + r) * 64 + lane]; d2[r] += part[(wave * 12 + 8 + r) * 64 + lane]; }
                tok = t0 + fr;
                rs1 = rsqrtf(ssq_tok * (1.f / D_) + EPS);
                float gl[4];
#pragma unroll
                for (int r = 0; r < 4; ++r) gl[r] = __shfl(d0[r], fr) * rs1;
                int gs = 0; float gm = gl[0];
#pragma unroll
                for (int r = 1; r < 4; ++r) if (gl[r] > gm) { gm = gl[r]; gs = r; }
                float den = 0.f;
#pragma unroll
                for (int r = 0; r < 4; ++r) den += __expf(gl[r] - gm);
                const float pg = 1.f / den;
                float el[8];
#pragma unroll
                for (int r = 0; r < 4; ++r) { el[r] = d1[r] * rs1; el[4 + r] = d2[r] * rs1; }
                int a1 = 0; float m1 = el[0];
#pragma unroll
                for (int j = 1; j < 8; ++j) if (el[j] > m1) { m1 = el[j]; a1 = j; }
                int a2 = -1; float m2 = -INFINITY;
#pragma unroll
                for (int j = 0; j < 8; ++j) if (j != a1 && el[j] > m2) { m2 = el[j]; a2 = j; }
                const float ex2 = __expf(m2 - m1);
                if (fq == gs) {
                    e1 = gs * 8 + a1; e2 = gs * 8 + a2; c1 = pg / (1.f + ex2); c2 = pg * ex2 / (1.f + ex2);
                    rk1 = __hip_atomic_fetch_add(hist + e1, 1, __ATOMIC_RELAXED, __HIP_MEMORY_SCOPE_WORKGROUP);
                    rk2 = __hip_atomic_fetch_add(hist + e2, 1, __ATOMIC_RELAXED, __HIP_MEMORY_SCOPE_WORKGROUP);
                }
              }
            }
            __syncthreads();
            if (tid < 32) { const int hc = hist[tid]; hbase[tid] = hc > 0 ? (int)__hip_atomic_fetch_add((unsigned*)ctl + CW_CNT + 64 * tid, (unsigned)hc, RLX_AGENT) : 0; }
            __syncthreads();
            if (e1 >= 0) {
                const int p1 = hbase[e1] + rk1, p2 = hbase[e2] + rk2;
                LTOK[(size_t)e1 * LCAP + p1] = (unsigned)tok; LSC[(size_t)e1 * LCAP + p1] = (f32x2){rs1, c1};
                LTOK[(size_t)e2 * LCAP + p2] = (unsigned)tok | 0x10000u; LSC[(size_t)e2 * LCAP + p2] = (f32x2){rs1, c2};
            }
            __syncthreads();
        }
    }
    SEAM(6);
    if (IN(7) || IN(8) || IN(9)) {
        LAS int* pref = (LAS int*)(L + XTRA_OFF + 1024);
        __syncthreads();
        if (tid < 32) pref[33 + tid] = (int)__hip_atomic_load((unsigned*)ctl + CW_CNT + 64 * tid, RLX_AGENT);
        __syncthreads();
        if (tid == 0) { int acc_ = 0; for (int e = 0; e < 32; ++e) { pref[e] = acc_; acc_ += (pref[33 + e] + 255) >> 8; } pref[32] = acc_; }
        __syncthreads();
    }
    if (IN(7) || IN(8) || IN(9)) {
        const LAS int* pref = (const LAS int*)(L + XTRA_OFF + 1024);
        const int tot = pref[32], U1 = 2 * tot, first = U1 < G ? U1 : G, rem = U1 - first, T1 = first >> 1;
        if (IN(7)) {
            MoeOrder1 S{(const char*)H1B, (const char*)WGU, LTOK, pref, G, bx, 0, first};
            EpiMoe1 E{A2, LSC};
            pg8::gemm_phase<EpiMoe1, MoeOrder1, true>(L + RING_OFF, D_, S, E);
        }
        SEAM(7);
        if (IN(8)) {
            if (bx < rem) {
                MoeOrder1 S{(const char*)H1B, (const char*)WGU, LTOK, pref, rem, bx, first, U1};
                EpiMoe1 E{A2, LSC};
                pg8::gemm_phase<EpiMoe1, MoeOrder1, true>(L + RING_OFF, D_, S, E);
            } else {
                MoeOrder2 S{(const char*)A2, (const char*)WD, pref, G - rem, bx - rem, 0, 4 * T1};
                EpiMoe2 E{YS, LTOK};
                pg8::gemm_phase<EpiMoe2, MoeOrder2, true>(L + RING_OFF, DFF, S, E);
            }
        }
        SEAM(8);
        if (IN(9)) {
            { MoeOrder2 S{(const char*)A2, (const char*)WD, pref, G, bx, 4 * T1, 4 * tot};
              EpiMoe2 E{YS, LTOK};
              pg8::gemm_phase<EpiMoe2, MoeOrder2, true>(L + RING_OFF, DFF, S, E); }
            { pg8::StaticOrder S; S.init(PB, WPLE, T_, D_, DPLE, G, (bx + G / 2) % G);
              EpiBf16Plain E{PW, D_};
              pg8::gemm_phase<EpiBf16Plain, pg8::StaticOrder, true>(L + RING_OFF, DPLE, S, E); }
        }
    }
    SEAM(9);
    if (IN(10)) {
        const int gw = vcu * NWAVES + wave, NGW = G * NWAVES;
        for (int m = gw; m < T_; m += NGW) {
            const GAS v2u* hr = (const GAS v2u*)(H1B + (size_t)m * D_) + lane;
            const GAS v2u* y0 = (const GAS v2u*)(YS + (size_t)m * D_) + lane; const GAS v2u* y1 = (const GAS v2u*)(YS + (size_t)(T_ + m) * D_) + lane;
            GAS v2u* hb = (GAS v2u*)(H2B + (size_t)m * D_) + lane;
            float s = 0.f;
#pragma unroll
            for (int j = 0; j < 4; ++j) {
                const v2u hq = hr[64 * j]; const v2u a = y0[64 * j], b = y1[64 * j];
                f32x4 v; v.x = __uint_as_float(hq.x << 16); v.y = __uint_as_float(hq.x & 0xffff0000u); v.z = __uint_as_float(hq.y << 16); v.w = __uint_as_float(hq.y & 0xffff0000u);
                v.x += __uint_as_float(a.x << 16) + __uint_as_float(b.x << 16); v.y += __uint_as_float(a.x & 0xffff0000u) + __uint_as_float(b.x & 0xffff0000u);
                v.z += __uint_as_float(a.y << 16) + __uint_as_float(b.y << 16); v.w += __uint_as_float(a.y & 0xffff0000u) + __uint_as_float(b.y & 0xffff0000u);
                v2u w; w.x = pk2(v.x, v.y); w.y = pk2(v.z, v.w); hb[64 * j] = w;
                s += (v.x * v.x + v.y * v.y) + (v.z * v.z + v.w * v.w);
            }
            s = wave_sum_x(s);
            if (lane == 0) RSTD2[m] = rsqrtf(s * (1.f / D_) + EPS);
        }
    }
    SEAM(10);
    if (IN(11)) {
        pg8::StaticOrder S; S.init(H2B, WPG, T_, D_, D_, G, bx);
        EpiPleGate E{OUT, PW, RSTD2, H2B};
        pg8::gemm_phase<EpiPleGate, pg8::StaticOrder, true>(L + RING_OFF, D_, S, E);
    }
#ifdef PROBE_PHASE
    if (multi) { xcd_barrier(bar); STAMP(12);
        if (bx == 0 && tid == 0) { const float us = (float)(TS[PROBE_PHASE + 1] - TS[PROBE_PHASE]) * 0.01f; OUT[0] += us; } }
#endif
#undef IN
#undef SEAM
}

extern "C" void kernel_launch(void* const* d_in, const int* in_sizes, int n_in, void* d_out, int out_size, void* d_ws, size_t ws_size, hipStream_t stream) {
    using namespace orc;
    const float* x = (const float*)d_in[0];
    const float* p = (const float*)d_in[1];
    const float* g_mix = (const float*)d_in[2];
    const float* w_in = (const float*)d_in[3];
    const float* g_v_a = (const float*)d_in[4];
    const float* w_s = (const float*)d_in[5];
    const float* b_s = (const float*)d_in[6];
    const float* g_q = (const float*)d_in[7];
    const float* g_k = (const float*)d_in[8];
    const float* g_out_a = (const float*)d_in[9];
    const float* g_out_b = (const float*)d_in[10];
    const float* w_out = (const float*)d_in[11];
    const float* g_ffn = (const float*)d_in[12];
    const float* w_group = (const float*)d_in[13];
    const float* w_expert = (const float*)d_in[14];
    const float* w_gate_e = (const float*)d_in[15];
    const float* w_up_e = (const float*)d_in[16];
    const float* w_down_e = (const float*)d_in[17];
    const float* g_ple = (const float*)d_in[18];
    const float* w_ple = (const float*)d_in[19];
    const float* w_ple_gate = (const float*)d_in[20];
    float* out = (float*)d_out;
    char* ws = (char*)d_ws;
    (void)g_mix; (void)w_in; (void)p; (void)w_ple; (void)w_out; (void)g_ffn; (void)w_group; (void)w_expert; (void)w_gate_e; (void)w_up_e; (void)w_down_e; (void)g_ple; (void)w_ple_gate; (void)x;

    static int grid = 0;
    if (grid == 0) {
        int dev = 0, cus = 0, per_cu = 0;
        if (hipGetDevice(&dev) != hipSuccess || hipDeviceGetAttribute(&cus, hipDeviceAttributeMultiprocessorCount, dev) != hipSuccess) { fprintf(stderr, "kernel_launch: device query failed\n"); grid = -1; return; }
        if (hipFuncSetAttribute((const void*)mk_fwd, hipFuncAttributeMaxDynamicSharedMemorySize, LDS_BYTES) != hipSuccess) { fprintf(stderr, "kernel_launch: hipFuncSetAttribute(%d) failed\n", LDS_BYTES); grid = -1; return; }
        if (hipOccupancyMaxActiveBlocksPerMultiprocessor(&per_cu, (const void*)mk_fwd, NWAVES * 64, LDS_BYTES) != hipSuccess || per_cu < 1) { fprintf(stderr, "kernel_launch: occupancy query says %d\n", per_cu); per_cu = 1; }
        (void)hipGetLastError();
        grid = cus * 1;
        if (ws_size < 256 * MiB) { fprintf(stderr, "kernel_launch: workspace too small\n"); grid = -1; return; }
    }
    if (grid < 0) return;
    hipMemsetAsync(ws + WS_CTL, 0, ZERO_BYTES, stream);
    Args a{};
    for (int i = 0; i < 21; ++i) a.in[i] = (const float*)d_in[i];
    a.out = out; a.ws = (unsigned char*)d_ws; a.li = 0; a.pad = 0;

    float* rstd_va = (float*)(ws + WS_ORC);
    int* sel = (int*)(ws + WS_ORC + 512 * 1024);
    Route* route = (Route*)(ws + WS_ORC + 2 * MiB);
    float* rstd_h = (float*)(ws + WS_ORC + 2 * MiB + 512 * 1024);
    float* rstd_h2 = (float*)(ws + WS_ORC + 3 * MiB);
    float* kmean = (float*)(ws + WS_KMEAN);
    const bf16_t* ua = (const bf16_t*)(ws + WS_ARR); const bf16_t* va = ua + ARR; const bf16_t* qn = ua + 2 * ARR; const bf16_t* kn = ua + 3 * ARR; const bf16_t* vb = ua + 4 * ARR;
    const bf16_t* pwb = (const bf16_t*)(ws + WS_PW);

#ifndef ONE_LAUNCH
#define ONE_LAUNCH 1
#endif
#ifndef LEVEL
#define LEVEL 4
#endif
#ifndef ATT_ORACLE
#define ATT_ORACLE 0
#endif
#define LAUNCH_PH(lo_, hi_) do { a.ph_lo = (lo_); a.ph_hi = (hi_); hipLaunchKernelGGL(mk_fwd, dim3(grid), dim3(NWAVES * 64), LDS_BYTES, stream, a); } while (0)
#if ONE_LAUNCH
    LAUNCH_PH(0, 12);
    (void)ua; (void)va; (void)qn; (void)kn; (void)vb; (void)sel; (void)kmean; (void)rstd_va; (void)route; (void)rstd_h; (void)rstd_h2; (void)pwb; (void)g_v_a; (void)w_s; (void)b_s; (void)g_q; (void)g_k; (void)g_out_a; (void)g_out_b;
#else
    LAUNCH_PH(0, 1); LAUNCH_PH(1, 2);
    LAUNCH_PH(2, 3);
#if ATT_ORACLE
    bf16_t* op = (bf16_t*)out; float* lp = (float*)(ws + WS_LP);
    hipMemsetAsync(op, 0, (size_t)3 * T_ * 512 * 2, stream);
    hipMemsetAsync(lp, 0, (size_t)3 * T_ * 8 * 4, stream);
    k_fill<<<T_ * 8 / 256, 256, 0, stream>>>(lp + (size_t)3 * T_ * 8, 1.0f, T_ * 8, 0);
    k_gate<bf16_t><<<T_ * NH / 256, 256, 0, stream>>>(qn, kmean, sel);
    k_attn<bf16_t, bf16_t><<<T_ * NH, 256, 0, stream>>>(qn, kn, vb, sel, op + (size_t)3 * T_ * 512, 512, 0);
#else
    LAUNCH_PH(3, 4);
    (void)qn; (void)kn; (void)vb; (void)sel; (void)kmean;
#endif
    LAUNCH_PH(4, 5);
    (void)ua; (void)va; (void)rstd_va; (void)g_v_a; (void)w_s; (void)b_s; (void)g_out_a; (void)g_out_b;
#if LEVEL >= 2
    LAUNCH_PH(5, 6);
#else
    k_sgemm<<<dim3(D_ / 64, T_ / 64), 256, 0, stream>>>((long)D_, ALPlain<bf16_t>{ycat, D_, 0}, BLPlain{w_out, D_, 0}, EPResid{x, out, D_, 0});
#endif
#if LEVEL >= 3
    LAUNCH_PH(6, 7); LAUNCH_PH(7, 8); LAUNCH_PH(8, 9); LAUNCH_PH(9, 10); LAUNCH_PH(10, 11);
#if LEVEL >= 4
    LAUNCH_PH(11, 12);
#else
    float* h2 = (float*)(ws);
    hipMemcpyAsync(h2, out, (size_t)T_ * D_ * 4, hipMemcpyDeviceToDevice, stream);
    k_row_rstd<float><<<T_ / 4, 256, 0, stream>>>(h2, rstd_h2, T_, D_, D_, 0);
    k_sgemm<<<dim3(D_ / 64, T_ / 64), 256, 0, stream>>>((long)D_, ALScaled<float>{h2, rstd_h2, g_ple, D_, 0}, BLPlain{w_ple_gate, D_, 0}, EPPle<bf16_t>{h2, pwb, out, D_, 0});
#endif
#else
    float* h2 = (float*)(ws + 90 * MiB);
    k_row_rstd<float><<<T_ / 4, 256, 0, stream>>>(out, rstd_h, T_, D_, D_, 0);
    k_route<<<T_ / 4, 256, 0, stream>>>(out, rstd_h, g_ffn, w_group, w_expert, route);
    k_moe<<<T_, 256, 0, stream>>>(out, rstd_h, g_ffn, route, w_gate_e, w_up_e, w_down_e, h2);
    k_row_rstd<float><<<T_ / 4, 256, 0, stream>>>(h2, rstd_h2, T_, D_, D_, 0);
    k_sgemm<<<dim3(D_ / 64, T_ / 64), 256, 0, stream>>>((long)D_, ALScaled<float>{h2, rstd_h2, g_ple, D_, 0}, BLPlain{w_ple_gate, D_, 0}, EPPle<bf16_t>{h2, pwb, out, D_, 0});
#endif
#endif
}
```

```cpp
#include <hip/hip_runtime.h>
#include <math.h>
#include <stdint.h>
#include <cstdio>

#ifndef MODE
#define MODE 1
#endif

typedef unsigned short bf16_t;
constexpr int NB_ = 4, S_ = 4096, D_ = 1024, T_ = NB_ * S_;
constexpr int DIN = 2560, NH = 8, DH = 64, BLK = 256, NBLK = 16;
constexpr int NE = 32, DFF = 256, DPLE = 256;
constexpr float EPS = 1e-6f;
constexpr size_t MiB = 1u << 20;
constexpr size_t ARR = (size_t)T_ * 512;

__host__ __device__ __forceinline__ unsigned f2bf(float f) { unsigned u = __builtin_bit_cast(unsigned, f); return (u + 0x7fffu + ((u >> 16) & 1u)) >> 16; }
__device__ __forceinline__ float bf2f(unsigned h) { return __uint_as_float(h << 16); }
__device__ __forceinline__ float ldv(const float* p, size_t i) { return p[i]; }
__device__ __forceinline__ float ldv(const bf16_t* p, size_t i) { return bf2f((unsigned)p[i]); }
__device__ __forceinline__ void stv(float* p, size_t i, float v) { p[i] = v; }
__device__ __forceinline__ void stv(bf16_t* p, size_t i, float v) { p[i] = (bf16_t)f2bf(v); }

namespace orc {
__device__ __forceinline__ float gelu_tanh(float x) {
    const float c = 0.7978845608028654f;
    return 0.5f * x * (1.f + tanhf(c * (x + 0.044715f * x * x * x)));
}
__device__ __forceinline__ float sigmoidf_(float x) { return 1.f / (1.f + expf(-x)); }
__device__ __forceinline__ float wave_sum(float v) {
#pragma unroll
    for (int o = 32; o > 0; o >>= 1) v += __shfl_xor(v, o);
    return v;
}
template <class TI>
__global__ void __launch_bounds__(256) k_row_rstd(const TI* __restrict__ x, float* __restrict__ rstd, int nrows, int ncols, int ld, int pad_) {
    const int row = blockIdx.x * 4 + (threadIdx.x >> 6), lane = threadIdx.x & 63;
    if (row >= nrows) return;
    float s = 0.f;
    for (int c = lane; c < ncols; c += 64) { const float v = ldv(x, (size_t)row * ld + c); s += v * v; }
    s = wave_sum(s);
    if (lane == 0) rstd[row] = rsqrtf(s / (float)ncols + EPS);
}
template <class TO>
__global__ void __launch_bounds__(256) k_rownorm_inplace(TO* __restrict__ y, const float* __restrict__ g, int nrows, int ncols, int ld, int c0) {
    const int row = blockIdx.x * 4 + (threadIdx.x >> 6), lane = threadIdx.x & 63;
    if (row >= nrows) return;
    float s = 0.f;
    for (int c = lane; c < ncols; c += 64) { const float v = ldv(y, (size_t)row * ld + c0 + c); s += v * v; }
    s = wave_sum(s);
    const float r = rsqrtf(s / (float)ncols + EPS);
    for (int c = lane; c < ncols; c += 64) { const size_t i = (size_t)row * ld + c0 + c; stv(y, i, ldv(y, i) * r * g[c]); }
}
template <class AL, class BL, class EP>
__global__ void __launch_bounds__(256) k_sgemm(long K, AL al, BL bl, EP ep) {
    __shared__ float As[16][65];
    __shared__ float Bs[16][65];
    const int tx = threadIdx.x & 15, ty = threadIdx.x >> 4;
    const int m0 = blockIdx.y * 64, n0 = blockIdx.x * 64;
    float acc[4][4];
#pragma unroll
    for (int i = 0; i < 4; ++i)
#pragma unroll
        for (int j = 0; j < 4; ++j) acc[i][j] = 0.f;
    for (int k0 = 0; k0 < K; k0 += 16) {
#pragma unroll
        for (int r = 0; r < 4; ++r) { const int i = threadIdx.x + r * 256; const int m = i >> 4, k = i & 15; As[k][m] = al(m0 + m, k0 + k); }
#pragma unroll
        for (int r = 0; r < 4; ++r) { const int i = threadIdx.x + r * 256; const int k = i >> 6, n = i & 63; Bs[k][n] = bl(k0 + k, n0 + n); }
        __syncthreads();
#pragma unroll
        for (int k = 0; k < 16; ++k) {
            float a[4], b[4];
#pragma unroll
            for (int i = 0; i < 4; ++i) a[i] = As[k][ty * 4 + i];
#pragma unroll
            for (int j = 0; j < 4; ++j) b[j] = Bs[k][tx * 4 + j];
#pragma unroll
            for (int i = 0; i < 4; ++i)
#pragma unroll
                for (int j = 0; j < 4; ++j) acc[i][j] += a[i] * b[j];
        }
        __syncthreads();
    }
#pragma unroll
    for (int i = 0; i < 4; ++i)
#pragma unroll
        for (int j = 0; j < 4; ++j) ep(m0 + ty * 4 + i, n0 + tx * 4 + j, acc[i][j]);
}
template <class TI> struct ALScaled { const TI* x; const float* rstd; const float* g; int ld; int pad;
    __device__ float operator()(int m, int k) const { return ldv(x, (size_t)m * ld + k) * rstd[m] * g[k]; } };
template <class TI> struct ALPlain { const TI* x; int ld; int pad;
    __device__ float operator()(int m, int k) const { return ldv(x, (size_t)m * ld + k); } };
struct BLPlain { const float* w; int ld; int pad;
    __device__ float operator()(int k, int n) const { return w[(size_t)k * ld + n]; } };
struct EPStore { float* c; int ld; int pad;
    __device__ void operator()(int m, int n, float v) const { c[(size_t)m * ld + n] = v; } };
struct EPSplit5 { float* a0;
    __device__ void operator()(int m, int n, float v) const { a0[(size_t)(n >> 9) * ARR + (size_t)m * 512 + (n & 511)] = v; } };
struct EPResid { const float* r; float* c; int ld; int pad;
    __device__ void operator()(int m, int n, float v) const { c[(size_t)m * ld + n] = r[(size_t)m * ld + n] + v; } };
template <class TP> struct EPPle { const float* h; const TP* pw; float* c; int ld; int pad;
    __device__ void operator()(int m, int n, float v) const { const size_t i = (size_t)m * ld + n; c[i] = h[i] + ldv(pw, i) * sigmoidf_(v); } };

__global__ void __launch_bounds__(256) k_post_gelu(float* __restrict__ a0) {
    const size_t i = (size_t)blockIdx.x * 256 + threadIdx.x;
    a0[i] = gelu_tanh(a0[i]);
}
__global__ void __launch_bounds__(256) k_qknorm(float* __restrict__ a0, const float* __restrict__ g_q, const float* __restrict__ g_k) {
    const int idx = blockIdx.x * 256 + threadIdx.x;
    if (idx >= T_ * 16) return;
    const int t = idx >> 4, which = (idx >> 3) & 1, h = idx & 7;
    float* p = a0 + (size_t)(2 + which) * ARR + (size_t)t * 512 + h * 64;
    const float* g = which ? g_k : g_q;
    float s = 0.f;
    for (int d = 0; d < 64; ++d) s += p[d] * p[d];
    const float r = rsqrtf(s / 64.f + EPS);
    for (int d = 0; d < 64; ++d) p[d] = p[d] * r * g[d];
}
template <class TI>
__global__ void __launch_bounds__(256) k_va_rstd(const TI* __restrict__ va, float* __restrict__ rstd_va) {
    const int idx = blockIdx.x * 4 + (threadIdx.x >> 6), lane = threadIdx.x & 63;
    const int t = idx >> 2, g = idx & 3;
    float s = 0.f;
    for (int d = lane; d < 128; d += 64) { const float v = ldv(va, (size_t)t * 512 + g * 128 + d); s += v * v; }
    s = wave_sum(s);
    if (lane == 0) rstd_va[idx] = rsqrtf(s / 128.f + EPS);
}
template <class TI, class TO>
__global__ void __launch_bounds__(256) k_mixa(const TI* __restrict__ ua, const TI* __restrict__ va, const float* __restrict__ rstd_va, const float* __restrict__ g_v,
                                              const float* __restrict__ w_s, const float* __restrict__ b_s, TO* __restrict__ ycat) {
    const int bc = blockIdx.x, g = blockIdx.y;
    const int t0 = bc * 128;
    for (int o = threadIdx.x; o < 128 * 128; o += 256) {
        const int tl = o >> 7, d = o & 127;
        float acc = 0.f;
        for (int s = 0; s <= tl; ++s) {
            const float v = ldv(va, (size_t)(t0 + s) * 512 + g * 128 + d) * rstd_va[(t0 + s) * 4 + g] * g_v[g * 128 + d];
            acc += w_s[((size_t)g * 128 + tl) * 128 + s] * v;
        }
        acc += b_s[g * 128 + tl];
        const float u = ldv(ua, (size_t)(t0 + tl) * 512 + g * 128 + d);
        stv(ycat, (size_t)(t0 + tl) * D_ + g * 128 + d, u * acc);
    }
}
template <class TI>
__global__ void __launch_bounds__(256) k_kmean(const TI* __restrict__ kn, float* __restrict__ kmean) {
    const int idx = blockIdx.x * 256 + threadIdx.x;
    if (idx >= NB_ * NH * NBLK * DH) return;
    const int d = idx & 63, n = (idx >> 6) & 15, h = (idx >> 10) & 7, b = idx >> 13;
    float s = 0.f;
    for (int r = 0; r < BLK; ++r) s += ldv(kn, (size_t)(b * S_ + n * BLK + r) * 512 + h * 64 + d);
    kmean[idx] = s / (float)BLK;
}
template <class TI>
__global__ void __launch_bounds__(256) k_gate(const TI* __restrict__ qn, const float* __restrict__ kmean, int* __restrict__ sel) {
    const int idx = blockIdx.x * 256 + threadIdx.x;
    if (idx >= T_ * NH) return;
    const int t = idx >> 3, h = idx & 7, b = t / S_, s = t % S_, qb = s / BLK;
    float v0 = -INFINITY, v1 = -INFINITY, v2 = -INFINITY; int i0 = -1, i1 = -1, i2 = -1;
    for (int n = 0; n < qb; ++n) {
        const float* km = kmean + ((size_t)(b * NH + h) * NBLK + n) * DH;
        float sc = 0.f;
        for (int d = 0; d < 64; ++d) sc += ldv(qn, (size_t)t * 512 + h * 64 + d) * km[d];
        if (sc > v0) { v2 = v1; i2 = i1; v1 = v0; i1 = i0; v0 = sc; i0 = n; }
        else if (sc > v1) { v2 = v1; i2 = i1; v1 = sc; i1 = n; }
        else if (sc > v2) { v2 = sc; i2 = n; }
    }
    sel[idx * 3 + 0] = i0; sel[idx * 3 + 1] = i1; sel[idx * 3 + 2] = i2;
}
template <class TI, class TO>
__global__ void __launch_bounds__(256) k_attn(const TI* __restrict__ qn, const TI* __restrict__ kn, const TI* __restrict__ vb, const int* __restrict__ sel, TO* __restrict__ ycat, int ldo, int coff) {
    __shared__ float qs[64];
    __shared__ float ps[4][256];
    __shared__ float red[4];
    __shared__ float part[4][64];
    const int idx = blockIdx.x;
    const int t = idx >> 3, h = idx & 7, b = t / S_, s = t % S_, qb = s / BLK;
    const int tid = threadIdx.x, lane = tid & 63, wid = tid >> 6;
    if (tid < 64) qs[tid] = ldv(qn, (size_t)t * 512 + h * 64 + tid);
    __syncthreads();
    const int b0 = sel[idx * 3 + 0], b1 = sel[idx * 3 + 1], b2 = sel[idx * 3 + 2], b3 = qb;
    float sc[4];
    float mx = -INFINITY;
#pragma unroll
    for (int j = 0; j < 4; ++j) {
        const int bj = (j == 0) ? b0 : (j == 1) ? b1 : (j == 2) ? b2 : b3;
        sc[j] = -INFINITY;
        if (bj >= 0) {
            const int kpos = bj * BLK + tid;
            if (j < 3 || kpos <= s) {
                float a = 0.f;
                for (int d = 0; d < 64; ++d) a += qs[d] * ldv(kn, (size_t)(b * S_ + kpos) * 512 + h * 64 + d);
                sc[j] = a * 0.125f;
            }
        }
        mx = fmaxf(mx, sc[j]);
    }
#pragma unroll
    for (int o = 32; o > 0; o >>= 1) mx = fmaxf(mx, __shfl_xor(mx, o));
    if (lane == 0) red[wid] = mx;
    __syncthreads();
    mx = fmaxf(fmaxf(red[0], red[1]), fmaxf(red[2], red[3]));
    __syncthreads();
    float sum = 0.f;
#pragma unroll
    for (int j = 0; j < 4; ++j) { const float p = (sc[j] == -INFINITY) ? 0.f : expf(sc[j] - mx); ps[j][tid] = p; sum += p; }
    sum = wave_sum(sum);
    if (lane == 0) red[wid] = sum;
    __syncthreads();
    sum = red[0] + red[1] + red[2] + red[3];
    float o = 0.f;
    {
        const int j = wid;
        const int bj = (j == 0) ? b0 : (j == 1) ? b1 : (j == 2) ? b2 : b3;
        if (bj >= 0) {
            for (int k = 0; k < 256; ++k) {
                const float p = ps[j][k];
                if (p != 0.f) o += p * ldv(vb, (size_t)(b * S_ + bj * BLK + k) * 512 + h * 64 + lane);
            }
        }
    }
    part[wid][lane] = o;
    __syncthreads();
    if (tid < 64) stv(ycat, (size_t)t * ldo + coff + h * 64 + tid, (part[0][tid] + part[1][tid] + part[2][tid] + part[3][tid]) / sum);
}
__global__ void __launch_bounds__(256) k_fill(float* __restrict__ p, float v, int n, int pad_) { const int i = blockIdx.x * 256 + threadIdx.x; if (i < n) p[i] = v; }
struct Route { int e1, e2; float c1, c2; };
__global__ void __launch_bounds__(256) k_route(const float* __restrict__ h, const float* __restrict__ rstd, const float* __restrict__ g,
                                               const float* __restrict__ w_group, const float* __restrict__ w_expert, Route* __restrict__ route) {
    const int t = blockIdx.x * 4 + (threadIdx.x >> 6), lane = threadIdx.x & 63;
    float acc[36];
#pragma unroll
    for (int j = 0; j < 36; ++j) acc[j] = 0.f;
    const float r = rstd[t];
    for (int k = lane; k < D_; k += 64) {
        const float xv = h[(size_t)t * D_ + k] * r * g[k];
#pragma unroll
        for (int j = 0; j < 4; ++j) acc[j] += xv * w_group[k * 4 + j];
#pragma unroll
        for (int j = 0; j < 32; ++j) acc[4 + j] += xv * w_expert[k * 32 + j];
    }
#pragma unroll
    for (int j = 0; j < 36; ++j) acc[j] = wave_sum(acc[j]);
    if (lane == 0) {
        int gs = 0; float gm = acc[0];
#pragma unroll
        for (int j = 1; j < 4; ++j) if (acc[j] > gm) { gm = acc[j]; gs = j; }
        float den = 0.f;
#pragma unroll
        for (int j = 0; j < 4; ++j) den += expf(acc[j] - gm);
        const float pg = 1.f / den;
        float el[8];
#pragma unroll
        for (int j = 0; j < 8; ++j) {
            float v = acc[4 + j];
#pragma unroll
            for (int gg = 1; gg < 4; ++gg) v = (gs == gg) ? acc[4 + gg * 8 + j] : v;
            el[j] = v;
        }
        int a1 = 0; float m1 = el[0];
#pragma unroll
        for (int j = 1; j < 8; ++j) if (el[j] > m1) { m1 = el[j]; a1 = j; }
        int a2 = -1; float m2 = -INFINITY;
#pragma unroll
        for (int j = 0; j < 8; ++j) if (j != a1 && el[j] > m2) { m2 = el[j]; a2 = j; }
        const float e2 = expf(m2 - m1);
        Route rt; rt.e1 = gs * 8 + a1; rt.e2 = gs * 8 + a2; rt.c1 = pg / (1.f + e2); rt.c2 = pg * e2 / (1.f + e2);
        route[t] = rt;
    }
}
__global__ void __launch_bounds__(256) k_moe(const float* __restrict__ h, const float* __restrict__ rstd, const float* __restrict__ g, const Route* __restrict__ route,
                                             const float* __restrict__ wg, const float* __restrict__ wu, const float* __restrict__ wd, float* __restrict__ h2) {
    __shared__ float xs[D_];
    __shared__ float as[DFF];
    const int t = blockIdx.x, tid = threadIdx.x;
    const float r = rstd[t];
    for (int k = tid; k < D_; k += 256) xs[k] = h[(size_t)t * D_ + k] * r * g[k];
    __syncthreads();
    const Route rt = route[t];
    float out[4] = {0.f, 0.f, 0.f, 0.f};
    for (int slot = 0; slot < 2; ++slot) {
        const int e = slot ? rt.e2 : rt.e1; const float cw = slot ? rt.c2 : rt.c1;
        const float* pg_ = wg + (size_t)e * D_ * DFF; const float* pu_ = wu + (size_t)e * D_ * DFF; const float* pd_ = wd + (size_t)e * DFF * D_;
        float hh = 0.f, uu = 0.f;
        for (int k = 0; k < D_; ++k) { const float xv = xs[k]; hh += xv * pg_[(size_t)k * DFF + tid]; uu += xv * pu_[(size_t)k * DFF + tid]; }
        __syncthreads();
        as[tid] = hh * sigmoidf_(hh) * uu * cw;
        __syncthreads();
        for (int f = 0; f < DFF; ++f) {
            const float a = as[f];
#pragma unroll
            for (int i = 0; i < 4; ++i) out[i] += a * pd_[(size_t)f * D_ + tid + 256 * i];
        }
    }
#pragma unroll
    for (int i = 0; i < 4; ++i) h2[(size_t)t * D_ + tid + 256 * i] = h[(size_t)t * D_ + tid + 256 * i] + out[i];
}
}

namespace pg8 {
#define PG8_LAS __attribute__((address_space(3)))
typedef short bf16x8 __attribute__((ext_vector_type(8)));
typedef float f32x4 __attribute__((ext_vector_type(4)));
typedef float f32x2 __attribute__((ext_vector_type(2)));
typedef unsigned u32x4 __attribute__((ext_vector_type(4)));
typedef unsigned u32x2 __attribute__((ext_vector_type(2)));
constexpr int BM = 256, BK = 64, HALF = 128, HTB = HALF * BK * 2, STAGE_BYTES = 8 * HTB, NXCD = 8, WGM = 8;

__host__ __device__ __forceinline__ int lds_byte(int r, int c) { const int st = (r >> 4) * 2 + (c >> 5), rr = r & 15, cc = c & 31, ob = rr * 64 + cc * 2; return st * 1024 + (ob ^ (((ob >> 9) & 1) << 5)); }
__host__ __device__ __forceinline__ void stage_rc(int b, int& R, int& C) { const int st = b / 1024, sb = b % 1024, swz = sb ^ (((sb >> 9) & 1) << 5); R = (st >> 1) * 16 + swz / 64; C = (st & 1) * 32 + (swz % 64) / 2; }
__host__ __device__ __forceinline__ int perm32(int rho) { const int n = rho >> 4, i = rho & 15; return 8 * (i >> 2) + 4 * n + (i & 3); }

struct Unit { int pm, pn, e, aux; };

__device__ __forceinline__ unsigned cvt_pk_bf16(float lo, float hi) { unsigned r; asm volatile("v_cvt_pk_bf16_f32 %0, %1, %2" : "=v"(r) : "v"(lo), "v"(hi)); return r; }

template <bool F8_> struct StaticOrderT {
    static constexpr bool GATHER = false, F8 = F8_;
    const char* A; const char* Bt; int K; int nM, nN, nwg, G, c;
    __device__ void init(const void* A_, const void* Bt_, int M, int N, int K_, int G_, int c_) { A = (const char*)A_; Bt = (const char*)Bt_; K = K_; nM = M / BM; nN = N / BM; nwg = nM * nN; G = G_; c = c_; }
    __device__ bool next(int i, Unit& u) const {
        const long L = (long)i * G + c; if (L >= nwg) return false;
        int wgid = (int)L; { const int q = nwg / NXCD, r = nwg % NXCD, xcd = wgid % NXCD, off = wgid / NXCD; wgid = (xcd < r ? xcd * (q + 1) : r * (q + 1) + (xcd - r) * q) + off; }
        const int nig = WGM * nN, gid = wgid / nig, fm = gid * WGM, gsz = (nM - fm) < WGM ? (nM - fm) : WGM;
        u.pm = fm + ((wgid % nig) % gsz); u.pn = (wgid % nig) / gsz; u.e = 0; u.aux = 0; return true;
    }
    __device__ __forceinline__ const char* a_base(const Unit& u) const { return A + (size_t)u.pm * BM * K * (F8_ ? 1 : 2); }
    __device__ __forceinline__ const char* b_base(const Unit& u) const { return Bt + (size_t)u.pn * BM * K * (F8_ ? 1 : 2); }
    __device__ __forceinline__ const char* a_root() const { return A; }
    __device__ __forceinline__ const char* b_root() const { return Bt; }
    __device__ __forceinline__ int row(const Unit&, int r) const { return r; }
    __device__ __forceinline__ void a_ready(const Unit&) const {}
    __device__ __forceinline__ void done(const Unit&) const {}
};

typedef StaticOrderT<false> StaticOrder;
typedef int v8i __attribute__((ext_vector_type(8)));
template <class Epi, class Sched, bool ALIGN_EPI>
__device__ __forceinline__ void gemm_phase(PG8_LAS unsigned char* lds, const int K, const Sched& S, const Epi& E) {
    int tid_o = threadIdx.x; asm volatile("" : "+v"(tid_o));
    const int tid = tid_o, wid = __builtin_amdgcn_readfirstlane(tid >> 6), lane = tid & 63, wr = wid >> 2, wc = wid & 3, fr = lane & 15, fq = lane >> 4;
    constexpr bool F8 = Sched::F8;
    const int RB = F8 ? K : 2 * K;
    int nt = RB / 128;
    if constexpr (F8) asm volatile("" : "+s"(nt));
    unsigned voffB[2]; unsigned cv0[2], cv1[2], nv0[2], nv1[2];
    const unsigned kstep = (unsigned)(BK * 2);
    const unsigned hstep = (unsigned)(HALF * RB);
    const char* rootA = S.a_root(); const char* rootB = S.b_root();
    const __amdgpu_buffer_rsrc_t rsA = __builtin_amdgcn_make_buffer_rsrc((void*)rootA, 0, 0x7fffffff, 0x00020000), rsB = __builtin_amdgcn_make_buffer_rsrc((void*)rootB, 0, 0x7fffffff, 0x00020000);
    const unsigned ldsw = (unsigned)wid * 1024u;
    const int fc = F8 ? ((fq >> 1) * 32 + (fq & 1) * 16) : fq * 8;
    constexpr int KSTR = F8 ? 16 : 1024;
    const int aoff = lds_byte(wr * 64 + fr, fc), boff = lds_byte(wc * 32 + fr, fc);
#define PG8_SA(b, h) (((b) * 2 + (h)) * HTB)
#define PG8_SB(b, h) ((4 + (b) * 2 + (h)) * HTB)
#define PG8_STAGE_RS(bufoff, RS, soff, voff) do { _Pragma("unroll") for (int _i = 0; _i < 2; ++_i) \
        __builtin_amdgcn_raw_ptr_buffer_load_lds(RS, (PG8_LAS void*)(lds + (bufoff) + ldsw + _i * 8192), 16, (int)(voff)[_i], (int)(soff), 0, 0); } while (0)
#define PG8_STAGE_B(bufoff, soff) PG8_STAGE_RS(bufoff, rsB, soff, voffB)
#define PG8_STAGE(bufoff, soff, voff) PG8_STAGE_RS(bufoff, rsA, soff, voff)
#define PG8_STAGE_A1(bufoff, soff, v0_, v1_) do { if constexpr (Sched::GATHER) { PG8_STAGE(bufoff, soff, v1_); } else { PG8_STAGE(bufoff, (soff) + hstep, v0_); } } while (0)
#define PG8_LDA(dst, b, h) do { _Pragma("unroll") for (int m = 0; m < 4; ++m) _Pragma("unroll") for (int k = 0; k < 2; ++k) dst[m][k] = *(const PG8_LAS bf16x8*)(lds + PG8_SA(b, h) + aoff + m * 2048 + k * KSTR); } while (0)
#define PG8_LDB(dst, b, h) do { _Pragma("unroll") for (int n = 0; n < 2; ++n) _Pragma("unroll") for (int k = 0; k < 2; ++k) dst[n][k] = *(const PG8_LAS bf16x8*)(lds + PG8_SB(b, h) + boff + n * 2048 + k * KSTR); } while (0)
#define PG8_MMA(ai, bj, At, Bt) do { __builtin_amdgcn_s_setprio(1); _Pragma("unroll") for (int m = 0; m < 4; ++m) _Pragma("unroll") for (int n = 0; n < 2; ++n) { \
        if constexpr (F8) { const v8i wa_ = __builtin_bit_cast(v8i, __builtin_shufflevector(Bt[n][0], Bt[n][1], 0, 1, 2, 3, 4, 5, 6, 7, 8, 9, 10, 11, 12, 13, 14, 15)); \
                            const v8i xa_ = __builtin_bit_cast(v8i, __builtin_shufflevector(At[m][0], At[m][1], 0, 1, 2, 3, 4, 5, 6, 7, 8, 9, 10, 11, 12, 13, 14, 15)); \
                            acc[ai][bj][m][n] = __builtin_amdgcn_mfma_scale_f32_16x16x128_f8f6f4(wa_, xa_, acc[ai][bj][m][n], 0, 0, 0, 0x79797979, 0, 0x7b7b7b7b); } \
        else { _Pragma("unroll") for (int k = 0; k < 2; ++k) acc[ai][bj][m][n] = __builtin_amdgcn_mfma_f32_16x16x32_bf16(Bt[n][k], At[m][k], acc[ai][bj][m][n], 0, 0, 0); } } \
        __builtin_amdgcn_s_setprio(0); } while (0)
#define PG8_WAIT_V(n) asm volatile("s_waitcnt vmcnt(" #n ")" ::: "memory")
#define PG8_WAIT_L(n) asm volatile("s_waitcnt lgkmcnt(" #n ")" ::: "memory")
#define PG8_BAR __builtin_amdgcn_s_barrier()
#define PG8_SCHED __builtin_amdgcn_sched_barrier(0)
#define PG8_AOFFS(v0, v1, U) do { _Pragma("unroll") for (int _i = 0; _i < 2; ++_i) { int R_, C_; stage_rc(tid * 16 + _i * 8192, R_, C_); \
        v0[_i] = (unsigned)(S.row(U, R_) * RB + C_ * 2); v1[_i] = (unsigned)(S.row(U, HALF + R_) * RB + C_ * 2); } } while (0)
    Unit cur, nxt; int ui = 0;
    if (!S.next(0, cur)) return;
#pragma unroll
    for (int i = 0; i < 2; ++i) { int R, C; stage_rc(tid * 16 + i * 8192, R, C); const int Rb = Epi::PERM ? ((R & ~31) + perm32(R & 31)) : R; voffB[i] = (unsigned)(Rb * RB + C * 2); }
    PG8_AOFFS(cv0, cv1, cur);
    f32x4 acc[2][2][4][2];
#pragma unroll
    for (int a = 0; a < 2; ++a)
#pragma unroll
        for (int b = 0; b < 2; ++b)
#pragma unroll
            for (int m = 0; m < 4; ++m)
#pragma unroll
                for (int n = 0; n < 2; ++n) acc[a][b][m][n] = (f32x4){0.f, 0.f, 0.f, 0.f};
    bf16x8 At[4][2], B0[2][2], B1[2][2];
    unsigned cA = (unsigned)__builtin_amdgcn_readfirstlane((int)(S.a_base(cur) - rootA)), cB = (unsigned)__builtin_amdgcn_readfirstlane((int)(S.b_base(cur) - rootB));
    S.a_ready(cur);
    PG8_STAGE_B(PG8_SB(0, 0), cB); PG8_STAGE_B(PG8_SB(0, 1), cB + hstep); PG8_STAGE(PG8_SA(0, 0), cA, cv0); PG8_STAGE_A1(PG8_SA(0, 1), cA, cv0, cv1);
    if (wr == 1) PG8_BAR;
    PG8_WAIT_V(2); PG8_BAR;
    PG8_STAGE_B(PG8_SB(1, 0), cB + kstep); PG8_STAGE(PG8_SA(1, 0), cA + kstep, cv0); PG8_STAGE_B(PG8_SB(1, 1), cB + hstep + kstep);
    PG8_WAIT_V(6); PG8_BAR;
    for (;;) {
        const bool has_next = S.next(ui + 1, nxt);
        const unsigned nA = has_next ? (unsigned)__builtin_amdgcn_readfirstlane((int)(S.a_base(nxt) - rootA)) : cA, nB = has_next ? (unsigned)__builtin_amdgcn_readfirstlane((int)(S.b_base(nxt) - rootB)) : cB;
        if constexpr (Sched::GATHER) { if (has_next) { PG8_AOFFS(nv0, nv1, nxt); } else { nv0[0] = cv0[0]; nv0[1] = cv0[1]; nv1[0] = cv1[0]; nv1[1] = cv1[1]; } }
        for (int t = 0; t < nt; t += 2) {
            const bool last = (t == nt - 2);
            const unsigned a1 = cA + (unsigned)(t + 1) * kstep;
            const unsigned a2 = last ? nA : cA + (unsigned)(t + 2) * kstep, b2 = last ? nB : cB + (unsigned)(t + 2) * kstep;
            const unsigned a3 = a2 + kstep, b3 = b2 + kstep;
            unsigned s0[2], s1[2];
            if constexpr (Sched::GATHER) { s0[0] = last ? nv0[0] : cv0[0]; s0[1] = last ? nv0[1] : cv0[1]; s1[0] = last ? nv1[0] : cv1[0]; s1[1] = last ? nv1[1] : cv1[1]; }
            else { s0[0] = cv0[0]; s0[1] = cv0[1]; s1[0] = 0u; s1[1] = 0u; }
            if (last && has_next) S.a_ready(nxt);
            PG8_LDB(B0, 0, 0); PG8_LDB(B1, 0, 1); PG8_SCHED; PG8_LDA(At, 0, 0); PG8_STAGE_A1(PG8_SA(1, 1), a1, cv0, cv1);
            PG8_WAIT_V(8); PG8_WAIT_L(0); PG8_BAR; PG8_MMA(0, 0, At, B0); PG8_MMA(0, 1, At, B1); PG8_BAR; PG8_SCHED;
            PG8_LDA(At, 0, 1); PG8_STAGE_B(PG8_SB(0, 0), b2); PG8_STAGE_B(PG8_SB(0, 1), b2 + hstep); PG8_STAGE(PG8_SA(0, 0), a2, s0);
            PG8_WAIT_V(8); PG8_WAIT_L(0); PG8_BAR; PG8_MMA(1, 0, At, B0); PG8_MMA(1, 1, At, B1); PG8_BAR; PG8_SCHED;
            PG8_LDB(B0, 1, 0); PG8_LDB(B1, 1, 1); PG8_SCHED; PG8_LDA(At, 1, 0); PG8_STAGE_A1(PG8_SA(0, 1), a2, s0, s1);
            PG8_WAIT_V(8); PG8_WAIT_L(0); PG8_BAR; PG8_MMA(0, 0, At, B0); PG8_MMA(0, 1, At, B1); PG8_BAR; PG8_SCHED;
            PG8_LDA(At, 1, 1); PG8_STAGE_B(PG8_SB(1, 0), b3); PG8_STAGE_B(PG8_SB(1, 1), b3 + hstep); PG8_STAGE(PG8_SA(1, 0), a3, s0);
            PG8_WAIT_V(8); PG8_WAIT_L(0); PG8_BAR; PG8_MMA(1, 0, At, B0); PG8_MMA(1, 1, At, B1); PG8_BAR; PG8_SCHED;
        }
        if constexpr (ALIGN_EPI) { if (wr == 0) PG8_BAR; }
        { int l2 = (int)__builtin_amdgcn_mbcnt_hi(~0u, __builtin_amdgcn_mbcnt_lo(~0u, 0u)); asm volatile("" : "+v"(l2)); E(acc, cur, wr, wc, l2 & 15, l2 >> 4); } S.done(cur);
        if (!has_next) break;
#pragma unroll
        for (int a = 0; a < 2; ++a)
#pragma unroll
            for (int b = 0; b < 2; ++b)
#pragma unroll
                for (int m = 0; m < 4; ++m)
#pragma unroll
                    for (int n = 0; n < 2; ++n) acc[a][b][m][n] = (f32x4){0.f, 0.f, 0.f, 0.f};
        cur = nxt; cA = nA; cB = nB; ++ui;
        if constexpr (Sched::GATHER) { cv0[0] = nv0[0]; cv0[1] = nv0[1]; cv1[0] = nv1[0]; cv1[1] = nv1[1]; }
        if constexpr (ALIGN_EPI) { if (wr == 1) PG8_BAR; }
    }
    PG8_WAIT_V(0);
    if constexpr (!ALIGN_EPI) { if (wr == 0) PG8_BAR; }
    PG8_BAR;
#undef PG8_SA
#undef PG8_SB
#undef PG8_STAGE
#undef PG8_STAGE_A1
#undef PG8_STAGE_B
#undef PG8_STAGE_RS
#undef PG8_LDA
#undef PG8_LDB
#undef PG8_MMA
#undef PG8_WAIT_V
#undef PG8_WAIT_L
#undef PG8_BAR
#undef PG8_SCHED
#undef PG8_AOFFS
}
}

#define GAS __attribute__((address_space(1)))
#define LAS __attribute__((address_space(3)))
typedef unsigned v4u __attribute__((ext_vector_type(4)));
typedef unsigned v2u __attribute__((ext_vector_type(2)));
typedef float f32x4 __attribute__((ext_vector_type(4)));
typedef float f32x2 __attribute__((ext_vector_type(2)));
typedef short bf16x8 __attribute__((ext_vector_type(8)));
typedef GAS unsigned gu32;
#define RLX_AGENT __ATOMIC_RELAXED, __HIP_MEMORY_SCOPE_AGENT
#define LDS_WAIT() asm volatile("s_waitcnt lgkmcnt(0)" ::: "memory")
#define VM_WAIT() asm volatile("s_waitcnt vmcnt(0)" ::: "memory")
constexpr int NWAVES = 8;
constexpr int PH_COMB = 4;

constexpr size_t WS_WIN = 0;
constexpr size_t WS_WOUT = 5 * MiB;
constexpr size_t WS_WGU = 7 * MiB;
constexpr size_t WS_WD = 39 * MiB;
constexpr size_t WS_WPLE = 55 * MiB;
constexpr size_t WS_WPG = 56 * MiB;
constexpr size_t WS_XN = 58 * MiB;
constexpr size_t WS_PB = 58 * MiB;
constexpr size_t WS_ARR = 98 * MiB;
constexpr size_t WS_PW = 211 * MiB;
constexpr size_t WS_CTL = 243 * MiB;
constexpr size_t WS_ACC = 244 * MiB;
constexpr size_t ZERO_BYTES = 2 * MiB;
constexpr size_t WS_KMEAN = WS_ACC, WS_SSQ1 = WS_ACC + 128 * 1024, WS_SSQ2 = WS_ACC + 192 * 1024;
constexpr size_t WS_YCAT = 58 * MiB;
constexpr size_t WS_H1B = 90 * MiB;
constexpr size_t WS_A2 = 122 * MiB;
constexpr size_t WS_YS = 142 * MiB;
constexpr size_t WS_H2B = 58 * MiB;
constexpr size_t WS_YA = 178 * MiB;
constexpr size_t WS_LP = 194 * MiB;
constexpr size_t WS_QL = 196 * MiB;
constexpr int CW_QCNT = 8192;
constexpr size_t WS_LTOK = 245 * MiB;
constexpr size_t WS_LSC = 247 * MiB;
constexpr size_t WS_RSTD2 = 251 * MiB;
constexpr size_t WS_WR = 251 * MiB + 512 * 1024;
constexpr size_t WS_ORC = 252 * MiB;
constexpr int CW_CNT = 1024;
constexpr int LCAP = 16384;
constexpr int CW_BAR = 4096;

constexpr int RING_OFF = 0, RING_BYTES = 131072;
constexpr int XTRA_OFF = 131072;
constexpr int LDS_BYTES = 163840;
constexpr int LDSCTL_OFF = LDS_BYTES - 512, MISC_OFF = LDSCTL_OFF + 320;

#define XB_TMO      128
#define XB_XCNT(j)  (256  + 64 * (j))
#define XB_XSUB(j)  (1280 + 64 * (j))
#define XB_XGEN(j)  (2304 + 64 * (j))
#define XB_TOP      3328
#define XB_TOPGEN   3392
#define XCD_BAR_WORDS 3456
#define XB_SPIN_CAP (1u << 18)
__device__ __forceinline__ unsigned xb_ld(unsigned* p)              { return __hip_atomic_load(p, __ATOMIC_RELAXED, __HIP_MEMORY_SCOPE_AGENT); }
__device__ __forceinline__ unsigned xb_add(unsigned* p, unsigned v) { return __hip_atomic_fetch_add(p, v, __ATOMIC_RELAXED, __HIP_MEMORY_SCOPE_AGENT); }
__device__ __forceinline__ unsigned xb_xcc_id() { return (unsigned)__builtin_amdgcn_s_getreg((3 << 11) | 20) & 0xFu; }
#define XB_SPIN(cond, bar) do { unsigned _sp = 0; while (cond) { __builtin_amdgcn_s_sleep(1); \
    if ((++_sp & 255u) == 0u) { if (xb_ld(&(bar)[XB_TMO])) break; if (_sp > XB_SPIN_CAP) { atomicAdd(&(bar)[XB_TMO], 1u); break; } } } } while (0)
struct XcdBarrier { unsigned* bar; unsigned x; volatile LAS unsigned* st; };
__device__ __forceinline__ XcdBarrier xcd_barrier_post(unsigned* bar, volatile LAS unsigned* st) {
    XcdBarrier b; b.bar = bar; b.x = xb_xcc_id(); b.st = st;
    if (threadIdx.x == 0) (void)xb_add(&bar[XB_XCNT(b.x)], 1u);
    return b;
}
__device__ __forceinline__ void xcd_barrier_complete(unsigned* bar, unsigned x, unsigned& nloc, unsigned& nx) {
    const unsigned G = gridDim.x * gridDim.y * gridDim.z;
    unsigned sum, cnt, mine, sp = 0u;
    for (;;) {
        sum = 0u; cnt = 0u; mine = 0u;
#pragma unroll
        for (unsigned j = 0; j < 16; ++j) { const unsigned c = xb_ld(&bar[XB_XCNT(j)]); sum += c; cnt += (c > 0u) ? 1u : 0u; mine = (j == x) ? c : mine; }
        if (sum == G) break;
        __builtin_amdgcn_s_sleep(1);
        if ((++sp & 255u) == 0u) { if (xb_ld(&bar[XB_TMO])) break; if (sp > XB_SPIN_CAP) { atomicAdd(&bar[XB_TMO], 1u); break; } }
    }
    nloc = mine > 0u ? mine : 1u; nx = cnt > 0u ? cnt : 1u;
}
__device__ __forceinline__ void xcd_barrier(const XcdBarrier& b) {
    asm volatile("s_waitcnt vmcnt(0)" ::: "memory");
    __syncthreads();
    if (threadIdx.x == 0) {
        unsigned* bar = b.bar;
        __builtin_amdgcn_s_waitcnt(0);
        unsigned nloc = b.st[0], nx = b.st[1];
        if (nloc == 0u) { xcd_barrier_complete(bar, b.x, nloc, nx); b.st[0] = nloc; b.st[1] = nx; }
        const unsigned old = xb_add(&bar[XB_XSUB(b.x)], 1u);
        const unsigned gen = old / nloc;
        if (old + 1u == (gen + 1u) * nloc) {
            __builtin_amdgcn_fence(__ATOMIC_RELEASE, "agent");
            asm volatile("s_waitcnt vmcnt(0)" ::: "memory");
            const unsigned og = xb_add(&bar[XB_TOP], 1u);
            const unsigned tg = og / nx;
            if (og + 1u == (tg + 1u) * nx) xb_add(&bar[XB_TOPGEN], 1u);
            else XB_SPIN(xb_ld(&bar[XB_TOPGEN]) == tg, bar);
            __builtin_amdgcn_fence(__ATOMIC_ACQUIRE, "agent");
            xb_add(&bar[XB_XGEN(b.x)], 1u);
            asm volatile("s_waitcnt vmcnt(0)" ::: "memory");
        } else {
            XB_SPIN(xb_ld(&bar[XB_XGEN(b.x)]) == gen, bar);
            __builtin_amdgcn_fence(__ATOMIC_ACQUIRE, "agent");
            asm volatile("s_waitcnt vmcnt(0)" ::: "memory");
        }
    }
    __syncthreads();
}

struct Args { const float* in[21]; float* out; unsigned char* ws; int ph_lo, ph_hi, li, pad; };

__device__ __forceinline__ unsigned pk4_fp8(float a, float b, float c, float d) { int w = 0; w = __builtin_amdgcn_cvt_pk_fp8_f32(a, b, w, false); w = __builtin_amdgcn_cvt_pk_fp8_f32(c, d, w, true); return (unsigned)w; }
constexpr bool MOE1_F8 = false;
constexpr float F8_WSCALE = 64.f, F8_ASCALE = 16.f;
__device__ __forceinline__ float gelu_fast(float x) {
    const float z = x * (0.7978845608f + 0.0356774081f * x * x);
    const float e = __builtin_amdgcn_exp2f(-2.885390082f * z);
    return x * __builtin_amdgcn_rcpf(1.f + e);
}
struct EpiInProj {
    static constexpr bool PERM = true;
    bf16_t* arr0; float* kmean; const float* gq; const float* gk; int pn0; int pad_;
    __device__ __forceinline__ void operator()(const pg8::f32x4 (&acc)[2][2][4][2], const pg8::Unit& u_, int wr, int wc, int fr, int fq) const {
        using namespace pg8;
        Unit u = u_; u.pn += pn0;
        const int kind = u.pn >> 1;
        bf16_t* base = arr0 + (size_t)kind * ARR + (size_t)(u.pm * 256 + wr * 64 + fr) * 512 + (u.pn & 1) * 256;
        if (kind == 2 || kind == 3) {
            const float* g = (kind == 2) ? gq : gk;
            f32x4 gv[2][2], ks[2][2];
#pragma unroll
            for (int bj = 0; bj < 2; ++bj)
#pragma unroll
                for (int n = 0; n < 2; ++n) { gv[bj][n] = *(const f32x4*)(g + 32 * bj + 8 * fq + 4 * n); ks[bj][n] = (f32x4){0.f, 0.f, 0.f, 0.f}; }
#pragma unroll
            for (int ai = 0; ai < 2; ++ai)
#pragma unroll
                for (int m = 0; m < 4; ++m) {
                    float ss = 0.f;
#pragma unroll
                    for (int bj = 0; bj < 2; ++bj)
#pragma unroll
                        for (int n = 0; n < 2; ++n) { const f32x4 x = acc[ai][bj][m][n]; ss += (x[0] * x[0] + x[1] * x[1]) + (x[2] * x[2] + x[3] * x[3]); }
                    ss += __shfl_xor(ss, 16); ss += __shfl_xor(ss, 32);
                    const float rs = rsqrtf(ss * (1.f / 64.f) + EPS);
                    bf16_t* rowp = arr0 + (size_t)kind * ARR + ((size_t)((u.pm >> 4) * NH + (u.pn & 1) * 4 + wc) * S_ + (u.pm & 15) * 256 + ai * HALF + wr * 64 + m * 16 + fr) * DH + 8 * fq;
#pragma unroll
                    for (int bj = 0; bj < 2; ++bj) {
                        const f32x4 v0 = acc[ai][bj][m][0] * rs * gv[bj][0], v1 = acc[ai][bj][m][1] * rs * gv[bj][1];
                        ks[bj][0] += v0; ks[bj][1] += v1;
                        u32x4 w; w.x = cvt_pk_bf16(v0[0], v0[1]); w.y = cvt_pk_bf16(v0[2], v0[3]); w.z = cvt_pk_bf16(v1[0], v1[1]); w.w = cvt_pk_bf16(v1[2], v1[3]);
                        *(u32x4*)(rowp + 32 * bj) = w;
                    }
                }
            if (kind == 3) {
                float* km = kmean + ((size_t)((u.pm >> 4) * NH + (u.pn & 1) * 4 + wc) * NBLK + (u.pm & 15)) * DH + 8 * fq;
#pragma unroll
                for (int bj = 0; bj < 2; ++bj)
#pragma unroll
                    for (int n = 0; n < 2; ++n)
#pragma unroll
                        for (int r = 0; r < 4; ++r) {
                            float v = ks[bj][n][r];
                            v += __shfl_xor(v, 1); v += __shfl_xor(v, 2); v += __shfl_xor(v, 4); v += __shfl_xor(v, 8);
                            if (fr == 0) atomicAdd(km + 32 * bj + 4 * n + r, v * (1.f / 256.f));
                        }
            }
        } else {
#pragma unroll
            for (int ai = 0; ai < 2; ++ai)
#pragma unroll
                for (int m = 0; m < 4; ++m) {
                    bf16_t* rowp = base + (size_t)(ai * HALF + m * 16) * 512 + wc * 32 + 8 * fq;
                    const size_t vrow = (size_t)(u.pm & 15) * 256 + ai * HALF + wr * 64 + m * 16 + fr;
#pragma unroll
                    for (int bj = 0; bj < 2; ++bj) {
                        f32x4 v0 = acc[ai][bj][m][0], v1 = acc[ai][bj][m][1];
                        if (kind <= 1) {
#pragma unroll
                            for (int r = 0; r < 4; ++r) { v0[r] = gelu_fast(v0[r]); v1[r] = gelu_fast(v1[r]); }
                        }
                        u32x4 w; w.x = cvt_pk_bf16(v0[0], v0[1]); w.y = cvt_pk_bf16(v0[2], v0[3]); w.z = cvt_pk_bf16(v1[0], v1[1]); w.w = cvt_pk_bf16(v1[2], v1[3]);
                        if (kind == 4) *(u32x4*)(arr0 + (size_t)4 * ARR + ((size_t)((u.pm >> 4) * NH + (u.pn & 1) * 4 + 2 * bj + (wc >> 1)) * S_ + vrow) * DH + (wc & 1) * 32 + 8 * fq) = w;
                        else *(u32x4*)(rowp + bj * HALF) = w;
                    }
                }
        }
    }
};
struct EpiBf16Plain {
    static constexpr bool PERM = true;
    bf16_t* O; int ldc;
    __device__ __forceinline__ void operator()(const pg8::f32x4 (&acc)[2][2][4][2], const pg8::Unit& u, int wr, int wc, int fr, int fq) const {
        using namespace pg8;
        bf16_t* base = O + (size_t)(u.pm * 256 + wr * 64 + fr) * ldc + u.pn * 256 + wc * 32 + 8 * fq;
#pragma unroll
        for (int ai = 0; ai < 2; ++ai)
#pragma unroll
            for (int m = 0; m < 4; ++m) {
                bf16_t* rowp = base + (size_t)(ai * HALF + m * 16) * ldc;
#pragma unroll
                for (int bj = 0; bj < 2; ++bj) {
                    const f32x4 v0 = acc[ai][bj][m][0], v1 = acc[ai][bj][m][1];
                    u32x4 w; w.x = cvt_pk_bf16(v0[0], v0[1]); w.y = cvt_pk_bf16(v0[2], v0[3]); w.z = cvt_pk_bf16(v1[0], v1[1]); w.w = cvt_pk_bf16(v1[2], v1[3]);
                    *(u32x4*)(rowp + bj * HALF) = w;
                }
            }
    }
};

struct EpiOutProj {
    static constexpr bool PERM = true;
    const float* x; bf16_t* h1b; float* ssq; unsigned char* h1f8;
    __device__ __forceinline__ void operator()(const pg8::f32x4 (&acc)[2][2][4][2], const pg8::Unit& u, int wr, int wc, int fr, int fq) const {
        using namespace pg8;
        const int row0 = u.pm * 256 + wr * 64 + fr, col0 = u.pn * 256 + wc * 32 + 8 * fq;
#pragma unroll
        for (int ai = 0; ai < 2; ++ai)
#pragma unroll
            for (int m = 0; m < 4; ++m) {
                const int row = row0 + ai * HALF + m * 16; const size_t off = (size_t)row * D_ + col0;
                float ss = 0.f;
#pragma unroll
                for (int bj = 0; bj < 2; ++bj) {
                    const f32x4 x0 = *(const f32x4*)(x + off + bj * HALF), x1 = *(const f32x4*)(x + off + bj * HALF + 4);
                    const f32x4 v0 = acc[ai][bj][m][0] + x0, v1 = acc[ai][bj][m][1] + x1;
                    u32x4 w; w.x = cvt_pk_bf16(v0[0], v0[1]); w.y = cvt_pk_bf16(v0[2], v0[3]); w.z = cvt_pk_bf16(v1[0], v1[1]); w.w = cvt_pk_bf16(v1[2], v1[3]);
                    *(u32x4*)(h1b + off + bj * HALF) = w;
                    if (MOE1_F8) { u32x2 q; q.x = pk4_fp8(v0[0] * F8_ASCALE, v0[1] * F8_ASCALE, v0[2] * F8_ASCALE, v0[3] * F8_ASCALE); q.y = pk4_fp8(v1[0] * F8_ASCALE, v1[1] * F8_ASCALE, v1[2] * F8_ASCALE, v1[3] * F8_ASCALE); *(u32x2*)(h1f8 + off + bj * HALF) = q; }
                    ss += (v0[0] * v0[0] + v0[1] * v0[1]) + (v0[2] * v0[2] + v0[3] * v0[3]) + (v1[0] * v1[0] + v1[1] * v1[1]) + (v1[2] * v1[2] + v1[3] * v1[3]);
                }
                ss += __shfl_xor(ss, 16); ss += __shfl_xor(ss, 32);
                if (fq == 0) atomicAdd(ssq + row, ss);
                if (m & 1) asm volatile("" ::: "memory");
            }
    }
};
struct EpiPleGate {
    static constexpr bool PERM = true;
    float* out; const bf16_t* pw; const float* rstd2; const bf16_t* h2b;
    __device__ __forceinline__ void operator()(const pg8::f32x4 (&acc)[2][2][4][2], const pg8::Unit& u, int wr, int wc, int fr, int fq) const {
        using namespace pg8;
        const int row0 = u.pm * 256 + wr * 64 + fr, col0 = u.pn * 256 + wc * 32 + 8 * fq;
#pragma unroll
        for (int ai = 0; ai < 2; ++ai)
#pragma unroll
            for (int m = 0; m < 4; ++m) {
                const int row = row0 + ai * HALF + m * 16; const size_t off = (size_t)row * D_ + col0;
                const float rs = rstd2[row] * -1.4426950408889634f;
#pragma unroll
                for (int bj = 0; bj < 2; ++bj) {
                    const u32x4 hv = *(const u32x4*)(h2b + off + bj * HALF);
                    const u32x4 pv = *(const u32x4*)(pw + off + bj * HALF);
                    f32x4 v0, v1;
#pragma unroll
                    for (int r = 0; r < 4; ++r) {
                        const unsigned pw0 = (r & 1) ? (pv[r >> 1] & 0xffff0000u) : (pv[r >> 1] << 16);
                        const unsigned pw1 = (r & 1) ? (pv[2 + (r >> 1)] & 0xffff0000u) : (pv[2 + (r >> 1)] << 16);
                        const float s0 = __builtin_amdgcn_rcpf(1.f + __builtin_amdgcn_exp2f(acc[ai][bj][m][0][r] * rs));
                        const float s1 = __builtin_amdgcn_rcpf(1.f + __builtin_amdgcn_exp2f(acc[ai][bj][m][1][r] * rs));
                        const unsigned hw0 = (r & 1) ? (hv[r >> 1] & 0xffff0000u) : (hv[r >> 1] << 16);
                        const unsigned hw1 = (r & 1) ? (hv[2 + (r >> 1)] & 0xffff0000u) : (hv[2 + (r >> 1)] << 16);
                        v0[r] = __uint_as_float(hw0) + __uint_as_float(pw0) * s0; v1[r] = __uint_as_float(hw1) + __uint_as_float(pw1) * s1;
                    }
                    *(f32x4*)(out + off + bj * HALF) = v0; *(f32x4*)(out + off + bj * HALF + 4) = v1;
                }
                if (m & 1) asm volatile("" ::: "memory");
            }
    }
};
struct MoeOrder1 {
    static constexpr bool GATHER = true, F8 = MOE1_F8;
    const char* A; const char* Bt; const unsigned* ltok; const LAS int* pref; int G, c, Lbeg, Lend;
    __device__ bool next(int i, pg8::Unit& u) const {
        const int L = Lbeg + i * G + c;
        if (c < 0 || L >= Lend) return false;
        const int tile = L >> 1; int e = 0;
#pragma unroll 1
        for (int j = 16; j > 0; j >>= 1) if (pref[e + j] <= tile) e += j;
        const int rt = tile - pref[e]; const int valid = min(256, pref[33 + e] - rt * 256);
        u.pm = tile; u.pn = L & 1; u.e = e; u.aux = valid | (rt << 16); return true;
    }
    __device__ __forceinline__ const char* a_base(const pg8::Unit&) const { return A; }
    __device__ __forceinline__ const char* b_base(const pg8::Unit& u) const { return Bt + ((size_t)u.e * 512 + u.pn * 256) * 1024 * (MOE1_F8 ? 1 : 2); }
    __device__ __forceinline__ const char* a_root() const { return A; }
    __device__ __forceinline__ const char* b_root() const { return Bt; }
    __device__ __forceinline__ int row(const pg8::Unit& u, int r) const { const int valid = u.aux & 0xffff ? (u.aux & 0xffff) : 256; const int rr = r < valid ? r : valid - 1;
        return (int)(ltok[(size_t)u.e * LCAP + (u.aux >> 16) * 256 + rr] & 0x3fffu); }
    __device__ __forceinline__ void a_ready(const pg8::Unit&) const {}
    __device__ __forceinline__ void done(const pg8::Unit&) const {}
};
struct MoeOrder2 {
    static constexpr bool GATHER = false, F8 = false;
    const char* A; const char* Bt; const LAS int* pref; int G, c, Lbeg, Lend;
    __device__ bool next(int i, pg8::Unit& u) const {
        const int L = Lbeg + i * G + c;
        if (c < 0 || L >= Lend) return false;
        const int tile = L >> 2; int e = 0;
#pragma unroll 1
        for (int j = 16; j > 0; j >>= 1) if (pref[e + j] <= tile) e += j;
        const int rt = tile - pref[e]; const int valid = min(256, pref[33 + e] - rt * 256);
        u.pm = tile; u.pn = L & 3; u.e = e; u.aux = valid | (rt << 16); return true;
    }
    __device__ __forceinline__ const char* a_base(const pg8::Unit& u) const { return A + (size_t)u.pm * 256 * 256 * 2; }
    __device__ __forceinline__ const char* b_base(const pg8::Unit& u) const { return Bt + ((size_t)u.e * 1024 + u.pn * 256) * 256 * 2; }
    __device__ __forceinline__ const char* a_root() const { return A; }
    __device__ __forceinline__ const char* b_root() const { return Bt; }
    __device__ __forceinline__ int row(const pg8::Unit&, int r) const { return r; }
    __device__ __forceinline__ void a_ready(const pg8::Unit&) const {}
    __device__ __forceinline__ void done(const pg8::Unit&) const {}
};
struct EpiMoe1 {
    static constexpr bool PERM = true;
    bf16_t* a2; const f32x2* lsc;
    __device__ __forceinline__ void operator()(const pg8::f32x4 (&acc)[2][2][4][2], const pg8::Unit& u, int wr, int wc, int fr, int fq) const {
        using namespace pg8;
        const int rt = u.aux >> 16;
#pragma unroll
        for (int ai = 0; ai < 2; ++ai)
#pragma unroll
            for (int m = 0; m < 4; ++m) {
                const int rl = ai * HALF + wr * 64 + m * 16 + fr;
                const f32x2 sc = lsc[(size_t)u.e * LCAP + rt * 256 + rl];
                const float rs = sc.x, cw = sc.y * sc.x;
                f32x4 o0, o1;
#pragma unroll
                for (int r = 0; r < 4; ++r) {
                    const float g0 = acc[ai][0][m][0][r] * rs, g1 = acc[ai][0][m][1][r] * rs;
                    o0[r] = g0 * __builtin_amdgcn_rcpf(1.f + __builtin_amdgcn_exp2f(-1.4426950408889634f * g0)) * acc[ai][1][m][0][r] * cw;
                    o1[r] = g1 * __builtin_amdgcn_rcpf(1.f + __builtin_amdgcn_exp2f(-1.4426950408889634f * g1)) * acc[ai][1][m][1][r] * cw;
                }
                u32x4 w; w.x = cvt_pk_bf16(o0[0], o0[1]); w.y = cvt_pk_bf16(o0[2], o0[3]); w.z = cvt_pk_bf16(o1[0], o1[1]); w.w = cvt_pk_bf16(o1[2], o1[3]);
                *(u32x4*)(a2 + ((size_t)u.pm * 256 + rl) * 256 + u.pn * 128 + wc * 32 + 8 * fq) = w;
            }
    }
};
struct EpiMoe2 {
    static constexpr bool PERM = true;
    bf16_t* ys; const unsigned* ltok;
    __device__ __forceinline__ void operator()(const pg8::f32x4 (&acc)[2][2][4][2], const pg8::Unit& u, int wr, int wc, int fr, int fq) const {
        using namespace pg8;
        const int rt = u.aux >> 16, valid = u.aux & 0xffff;
#pragma unroll
        for (int ai = 0; ai < 2; ++ai)
#pragma unroll
            for (int m = 0; m < 4; ++m) {
                const int rl = ai * HALF + wr * 64 + m * 16 + fr;
                if (rl < valid) {
                    const unsigned ts = ltok[(size_t)u.e * LCAP + rt * 256 + rl];
                    bf16_t* rowp = ys + ((size_t)(ts >> 16) * T_ + (ts & 0x3fffu)) * D_ + u.pn * 256 + wc * 32 + 8 * fq;
#pragma unroll
                    for (int bj = 0; bj < 2; ++bj) {
                        const f32x4 v0 = acc[ai][bj][m][0], v1 = acc[ai][bj][m][1];
                        u32x4 w; w.x = cvt_pk_bf16(v0[0], v0[1]); w.y = cvt_pk_bf16(v0[2], v0[3]); w.z = cvt_pk_bf16(v1[0], v1[1]); w.w = cvt_pk_bf16(v1[2], v1[3]);
                        *(u32x4*)(rowp + bj * HALF) = w;
                    }
                }
            }
    }
};

__device__ __forceinline__ float wave_sum_x(float v) {
#pragma unroll
    for (int o = 1; o < 64; o <<= 1) v += __shfl_xor(v, o);
    return v;
}
__device__ __forceinline__ unsigned pk2(float lo, float hi) { return f2bf(lo) | (f2bf(hi) << 16); }
__device__ __forceinline__ void p0_transpose_item(const float* W, int K, int N, bf16_t* WT, const float* gain, int mapmode, LAS float* scr, int item, int lane) {
    const int nblk = N / 32, kb = item / nblk, nb = item % nblk, k0 = 64 * kb, n0 = 32 * nb;
#pragma unroll 8
    for (int i = 0; i < 32; ++i) { const int kk = 2 * i + (lane >> 5); float v = W[(size_t)(k0 + kk) * N + n0 + (lane & 31)]; if (gain) v *= gain[k0 + kk]; scr[kk * 33 + (lane & 31)] = v; }
    LDS_WAIT(); asm volatile("" ::: "memory");
    int r0 = n0;
    if (mapmode == 1) { if (n0 >= 1024 && n0 < 2048) { const int cc = n0 & 255; r0 = (n0 & ~255) + 128 * ((cc >> 5) & 1) + 32 * (cc >> 6); } }
    else if (mapmode == 2) r0 = (n0 >> 7) * 256 + (n0 & 127);
    else if (mapmode == 3) r0 = (n0 >> 7) * 256 + 128 + (n0 & 127);
    const int c = lane & 7;
#pragma unroll
    for (int j = 0; j < 4; ++j) { const int n = (lane >> 3) + 8 * j; const LAS float* s = scr + (8 * c) * 33 + n;
        v4u o; o.x = pk2(s[0 * 33], s[1 * 33]); o.y = pk2(s[2 * 33], s[3 * 33]); o.z = pk2(s[4 * 33], s[5 * 33]); o.w = pk2(s[6 * 33], s[7 * 33]);
        *(GAS v4u*)(WT + (size_t)(r0 + n) * K + k0 + 8 * c) = o; }
    LDS_WAIT(); asm volatile("" ::: "memory");
}

typedef short s16x4 __attribute__((ext_vector_type(4)));
__device__ __forceinline__ s16x4 lds_tr16(LAS const void* p) { return __builtin_bit_cast(s16x4, __builtin_amdgcn_ds_read_tr16_b64_v4i16((LAS s16x4*)p)); }
typedef float f32x2_t __attribute__((ext_vector_type(2))); typedef __bf16 bf16x2_t __attribute__((ext_vector_type(2)));
__device__ __forceinline__ unsigned cvt_pk(float lo, float hi) { f32x2_t v = {lo, hi}; bf16x2_t b = __builtin_convertvector(v, bf16x2_t); return __builtin_bit_cast(unsigned, b); }

constexpr int MA_WS_STRIDE = 136, MA_VS_STRIDE = 144, MA_VS_OFF = 128 * MA_WS_STRIDE * 2;
__device__ __forceinline__ void mixa_load_w(LAS unsigned char* lds, const float* wsg, int tid) {
    for (int i = tid; i < 128 * 16; i += NWAVES * 64) {
        const int t = i >> 4, c = i & 15;
        const f32x4 a = *(const f32x4*)(wsg + t * 128 + 8 * c), b = *(const f32x4*)(wsg + t * 128 + 8 * c + 4);
        float v[8] = {a.x, a.y, a.z, a.w, b.x, b.y, b.z, b.w};
#pragma unroll
        for (int j = 0; j < 8; ++j) if (8 * c + j > t) v[j] = 0.f;
        v4u o; o.x = pk2(v[0], v[1]); o.y = pk2(v[2], v[3]); o.z = pk2(v[4], v[5]); o.w = pk2(v[6], v[7]);
        *(LAS v4u*)(lds + (t * MA_WS_STRIDE + 8 * c) * 2) = o;
    }
}
__device__ __forceinline__ void mixa_unit(LAS unsigned char* lds, int u, const bf16_t* UA, const bf16_t* VA, const float* g_v, const float* b_s, bf16_t* YA, int tid, int lane, int wave) {
    const int g = u & 3, bn = u >> 2, t0 = bn * 128, c0 = g * 128;
    const int fr = lane & 15, fq = lane >> 4;
    v4u vraw[4];
#pragma unroll
    for (int i = 0; i < 4; ++i) vraw[i] = *(const GAS v4u*)(VA + (size_t)(t0 + (tid >> 4) + 32 * i) * 512 + c0 + 8 * (tid & 15));
    v2u ur[8]; float bias[8];
#pragma unroll
    for (int j = 0; j < 8; ++j) { const int t = 16 * j + fr; ur[j] = *(const GAS v2u*)(UA + (size_t)(t0 + t) * 512 + c0 + 16 * wave + 4 * fq); bias[j] = b_s[g * 128 + t]; }
    const f32x4 gv = *(const f32x4*)(g_v + c0 + 16 * wave + 4 * fq);
#pragma unroll
    for (int i = 0; i < 4; ++i) {
        const int s_ = (tid >> 4) + 32 * i, c = tid & 15;
        const v4u raw = vraw[i];
        float v[8];
#pragma unroll
        for (int j = 0; j < 4; ++j) { v[2 * j] = __uint_as_float(raw[j] << 16); v[2 * j + 1] = __uint_as_float(raw[j] & 0xffff0000u); }
        float ss = 0.f;
#pragma unroll
        for (int j = 0; j < 8; ++j) ss += v[j] * v[j];
        ss += __shfl_xor(ss, 1); ss += __shfl_xor(ss, 2); ss += __shfl_xor(ss, 4); ss += __shfl_xor(ss, 8);
        const float rs = rsqrtf(ss * (1.f / 128.f) + EPS);
        v4u o; o.x = pk2(v[0] * rs, v[1] * rs); o.y = pk2(v[2] * rs, v[3] * rs); o.z = pk2(v[4] * rs, v[5] * rs); o.w = pk2(v[6] * rs, v[7] * rs);
        *(LAS v4u*)(lds + MA_VS_OFF + (s_ * MA_VS_STRIDE + 8 * c) * 2) = o;
    }
    LDS_WAIT(); __syncthreads();
    bf16x8 vf[4];
#pragma unroll
    for (int ks = 0; ks < 4; ++ks) {
        LAS const unsigned char* p = lds + MA_VS_OFF + ((32 * ks + 8 * fq + (fr >> 2)) * MA_VS_STRIDE + 16 * wave + 4 * (lane & 3)) * 2;
        const s16x4 lo = lds_tr16(p), hi = lds_tr16(p + 4 * MA_VS_STRIDE * 2);
        vf[ks] = (bf16x8){lo[0], lo[1], lo[2], lo[3], hi[0], hi[1], hi[2], hi[3]};
    }
#pragma unroll
    for (int j = 0; j < 8; ++j) {
        f32x4 acc = {0.f, 0.f, 0.f, 0.f};
#pragma unroll
        for (int ks = 0; ks < 4; ++ks) if (ks <= (j >> 1)) {
            const bf16x8 wf = *(const LAS bf16x8*)(lds + ((16 * j + fr) * MA_WS_STRIDE + 32 * ks + 8 * fq) * 2);
            acc = __builtin_amdgcn_mfma_f32_16x16x32_bf16(vf[ks], wf, acc, 0, 0, 0);
        }
        const int t = 16 * j + fr;
        const size_t off = (size_t)(t0 + t) * 512 + c0 + 16 * wave + 4 * fq;
        v2u o;
        o.x = pk2(__uint_as_float(ur[j].x << 16) * (acc[0] * gv[0] + bias[j]), __uint_as_float(ur[j].x & 0xffff0000u) * (acc[1] * gv[1] + bias[j]));
        o.y = pk2(__uint_as_float(ur[j].y << 16) * (acc[2] * gv[2] + bias[j]), __uint_as_float(ur[j].y & 0xffff0000u) * (acc[3] * gv[3] + bias[j]));
        *(GAS v2u*)(YA + off) = o;
    }
    LDS_WAIT(); __syncthreads();
}

__device__ __forceinline__ void combine_row(int m, const bf16_t* YA, const bf16_t* OP, const float* LP, const float* g_out_a, const float* g_out_b, bf16_t* YCAT, int lane) {
    const int nsel = min((m & (S_ - 1)) >> 8, 3);
    const int h = lane >> 3;
    float o[8], l = 0.f;
#pragma unroll
    for (int j = 0; j < 8; ++j) o[j] = 0.f;
#pragma unroll
    for (int sl = 0; sl < 4; ++sl) {
        if (sl == 3 || sl < nsel) {
            const v4u raw = *(const GAS v4u*)(OP + ((size_t)sl * T_ + m) * 512 + 8 * lane);
#pragma unroll
            for (int j = 0; j < 4; ++j) { o[2 * j] += __uint_as_float(raw[j] << 16); o[2 * j + 1] += __uint_as_float(raw[j] & 0xffff0000u); }
            l += LP[((size_t)sl * T_ + m) * 8 + h];
        }
    }
    const float il = 1.f / l;
    float sb = 0.f;
#pragma unroll
    for (int j = 0; j < 8; ++j) { o[j] *= il; sb += o[j] * o[j]; }
    const v4u ar = *(const GAS v4u*)(YA + (size_t)m * 512 + 8 * lane);
    float a[8], sa = 0.f;
#pragma unroll
    for (int j = 0; j < 4; ++j) { a[2 * j] = __uint_as_float(ar[j] << 16); a[2 * j + 1] = __uint_as_float(ar[j] & 0xffff0000u); }
#pragma unroll
    for (int j = 0; j < 8; ++j) sa += a[j] * a[j];
    sa = wave_sum_x(sa); sb = wave_sum_x(sb);
    const float ra = rsqrtf(sa * (1.f / 512.f) + EPS), rb = rsqrtf(sb * (1.f / 512.f) + EPS);
    const f32x4 ga0 = *(const f32x4*)(g_out_a + 8 * lane), ga1 = *(const f32x4*)(g_out_a + 8 * lane + 4);
    const f32x4 gb0 = *(const f32x4*)(g_out_b + 8 * lane), gb1 = *(const f32x4*)(g_out_b + 8 * lane + 4);
    v4u wa, wb;
    wa.x = pk2(a[0] * ra * ga0[0], a[1] * ra * ga0[1]); wa.y = pk2(a[2] * ra * ga0[2], a[3] * ra * ga0[3]); wa.z = pk2(a[4] * ra * ga1[0], a[5] * ra * ga1[1]); wa.w = pk2(a[6] * ra * ga1[2], a[7] * ra * ga1[3]);
    wb.x = pk2(o[0] * rb * gb0[0], o[1] * rb * gb0[1]); wb.y = pk2(o[2] * rb * gb0[2], o[3] * rb * gb0[3]); wb.z = pk2(o[4] * rb * gb1[0], o[5] * rb * gb1[1]); wb.w = pk2(o[6] * rb * gb1[2], o[7] * rb * gb1[3]);
    *(GAS v4u*)(YCAT + (size_t)m * D_ + 8 * lane) = wa;
    *(GAS v4u*)(YCAT + (size_t)m * D_ + 512 + 8 * lane) = wb;
}

__device__ __forceinline__ void gate_task(int task, const bf16_t* QN, const float* KMEAN, unsigned* qcnt, unsigned short* QL, int lane, LAS float* kml  ) {
    const int qq = task & 3; int r = task >> 2; const int i = (r % 15) + 1; r /= 15; const int h = r & 7, b = r >> 3;
    const int s_ = i * 256 + qq * 64 + lane;
    const bf16_t* qp = QN + ((size_t)(b * NH + h) * S_ + s_) * DH;
    float q[64];
#pragma unroll
    for (int c = 0; c < 8; ++c) { const v4u raw = *(const GAS v4u*)(qp + 8 * c);
#pragma unroll
        for (int j = 0; j < 4; ++j) { q[8 * c + 2 * j] = __uint_as_float(raw[j] << 16); q[8 * c + 2 * j + 1] = __uint_as_float(raw[j] & 0xffff0000u); } }
    float v0 = -INFINITY, v1 = -INFINITY, v2 = -INFINITY; int i0 = -1, i1 = -1, i2 = -1;
    const float* kmb = KMEAN + (size_t)((b * NH + h) * NBLK) * DH;
    {
        f32x4 t4[4];
#pragma unroll
        for (int c = 0; c < 4; ++c) t4[c] = *(const GAS f32x4*)(kmb + c * 256 + lane * 4);
#pragma unroll
        for (int c = 0; c < 4; ++c) *(LAS f32x4*)(kml + c * 256 + lane * 4) = t4[c];
        LDS_WAIT(); asm volatile("" ::: "memory");
    }
#pragma unroll 1
    for (int n = 0; n < i; ++n) {
        const LAS float* km = kml + n * DH;
        float sc = 0.f;
#pragma unroll
        for (int d4 = 0; d4 < 16; ++d4) { const f32x4 kv = *(const LAS f32x4*)(km + 4 * d4); sc += q[4 * d4] * kv.x; sc += q[4 * d4 + 1] * kv.y; sc += q[4 * d4 + 2] * kv.z; sc += q[4 * d4 + 3] * kv.w; }
        if (sc > v0) { v2 = v1; i2 = i1; v1 = v0; i1 = i0; v0 = sc; i0 = n; }
        else if (sc > v1) { v2 = v1; i2 = i1; v1 = sc; i1 = n; }
        else if (sc > v2) { v2 = sc; i2 = n; }
    }
    const int lbase = (b * NH + h) * NBLK;
    int mycount = 0, rk0 = 0, rk1 = 0, rk2 = 0;
    const unsigned long long lt = (1ull << lane) - 1ull;
#pragma unroll 1
    for (int n = 0; n < i; ++n) {
        const unsigned long long mask = __ballot((i0 == n) | (i1 == n) | (i2 == n));
        const int below = __popcll(mask & lt);
        if (lane == n) mycount = __popcll(mask);
        if (i0 == n) rk0 = below;
        if (i1 == n) rk1 = below;
        if (i2 == n) rk2 = below;
    }
    unsigned mybase = 0;
    if (lane < i && mycount > 0) mybase = __hip_atomic_fetch_add(qcnt + lbase + lane, (unsigned)mycount, RLX_AGENT);
#pragma unroll
    for (int k = 0; k < 3; ++k) {
        const int sel = (k == 0) ? i0 : (k == 1) ? i1 : i2;
        const int rank = (k == 0) ? rk0 : (k == 1) ? rk1 : rk2;
        const unsigned base = (unsigned)__shfl((int)mybase, sel < 0 ? 0 : sel);
        if (sel >= 0) QL[(size_t)(lbase + sel) * 4096 + base + rank] = (unsigned short)(s_ | (k << 12));
    }
}

constexpr int AT_IPREF = XTRA_OFF + 2048, AT_ICNT = XTRA_OFF + 4352, AT_MYIT = XTRA_OFF + 6400;
__device__ __forceinline__ void attn_stage_tile(LAS unsigned char* dst, const bf16_t* src  , int wave, int lane) {
#pragma unroll
    for (int i = 0; i < 4; ++i) {
        const int key = 8 * (wave * 4 + i) + (lane >> 3), ch = (lane & 7) ^ (key & 7);
        __builtin_amdgcn_global_load_lds((const unsigned*)(src + (size_t)key * DH + ch * 8), (LAS unsigned*)(dst + (wave * 4 + i) * 1024), 16, 0, 0);
    }
}
__device__ __forceinline__ bf16x8 scale_bf16x8(const v4u raw, float c) {
    v4u o;
#pragma unroll
    for (int j = 0; j < 4; ++j) o[j] = cvt_pk(__uint_as_float(raw[j] << 16) * c, __uint_as_float(raw[j] & 0xffff0000u) * c);
    return __builtin_bit_cast(bf16x8, o);
}

template <bool OWN>
__device__ __forceinline__ void attn_item(LAS const unsigned char* Kb, LAS const unsigned char* Vb, const bf16x8 (&qf)[2][2], const float MREF, f32x4 (&O)[4][2], float& lsum0, float& lsum1,
                                          const int fr, const int fq, const int lane, const int ql0, const int ql1) {
    bf16x8 KA[2][2], KB[2][2], VA[4], VB[4], P[2];
    f32x4 SA[2][2], SB[2][2];
    const int kb0 = fr * 128 + ((fq ^ (fr & 7)) << 4), kb1 = fr * 128 + (((4 + fq) ^ (fr & 7)) << 4);
    int vb[4];
    { const int kq = 4 * fq + (fr >> 2);
#pragma unroll
      for (int dt = 0; dt < 4; ++dt) vb[dt] = kq * 128 + (((2 * dt + ((lane & 3) >> 1)) ^ (kq & 7)) << 4) + (lane & 1) * 8; }
    const bf16x8 ones = (bf16x8){0x3f80, 0x3f80, 0x3f80, 0x3f80, 0x3f80, 0x3f80, 0x3f80, 0x3f80};
    f32x4 L0 = {0.f, 0.f, 0.f, 0.f}, L1 = {0.f, 0.f, 0.f, 0.f};
    const int emax0 = OWN ? __builtin_amdgcn_readfirstlane(ql0 >> 5) : 7, emax1 = OWN ? __builtin_amdgcn_readfirstlane(ql1 >> 5) : 7;
#define SBAR() __builtin_amdgcn_sched_barrier(0)
#define LDK(e, KF) do { _Pragma("unroll") for (int kt = 0; kt < 2; ++kt) { \
        KF[kt][0] = *(const LAS bf16x8*)(Kb + kb0 + (32 * (e) + 16 * kt) * 128); KF[kt][1] = *(const LAS bf16x8*)(Kb + kb1 + (32 * (e) + 16 * kt) * 128); } } while (0)
#define MMS(e, KF, S) do { _Pragma("unroll") for (int kt = 0; kt < 2; ++kt) { \
        if (!OWN || (e) <= emax0) { f32x4 a = {-MREF, -MREF, -MREF, -MREF}; a = __builtin_amdgcn_mfma_f32_16x16x32_bf16(KF[kt][0], qf[0][0], a, 0, 0, 0); S[kt][0] = __builtin_amdgcn_mfma_f32_16x16x32_bf16(KF[kt][1], qf[0][1], a, 0, 0, 0); } \
        if (!OWN || (e) <= emax1) { f32x4 a = {-MREF, -MREF, -MREF, -MREF}; a = __builtin_amdgcn_mfma_f32_16x16x32_bf16(KF[kt][0], qf[1][0], a, 0, 0, 0); S[kt][1] = __builtin_amdgcn_mfma_f32_16x16x32_bf16(KF[kt][1], qf[1][1], a, 0, 0, 0); } } } while (0)
#define EXPP1(e, S, qi, QL, EMAX) do { if (!OWN || (e) <= EMAX) { \
        _Pragma("unroll") for (int kt = 0; kt < 2; ++kt) _Pragma("unroll") for (int r = 0; r < 4; ++r) { float x = S[kt][qi][r]; \
            if (OWN) { if (32 * (e) + 16 * kt + 4 * fq + r > QL) x = -INFINITY; } S[kt][qi][r] = __builtin_amdgcn_exp2f(x); } \
        v4u w; w.x = cvt_pk(S[0][qi][0], S[0][qi][1]); w.y = cvt_pk(S[0][qi][2], S[0][qi][3]); w.z = cvt_pk(S[1][qi][0], S[1][qi][1]); w.w = cvt_pk(S[1][qi][2], S[1][qi][3]); P[qi] = __builtin_bit_cast(bf16x8, w); } } while (0)
#define EXPP(e, S) do { EXPP1(e, S, 0, ql0, emax0); EXPP1(e, S, 1, ql1, emax1); } while (0)
#define LDV(e, VF) do { _Pragma("unroll") for (int dt = 0; dt < 4; ++dt) { \
            const s16x4 lo = lds_tr16(Vb + vb[dt] + (32 * (e)) * 128); const s16x4 hi = lds_tr16(Vb + vb[dt] + (32 * (e) + 16) * 128); \
            VF[dt] = (bf16x8){lo[0], lo[1], lo[2], lo[3], hi[0], hi[1], hi[2], hi[3]}; } } while (0)
#define MMV(e, VF) do { if (!OWN || (e) <= emax0) L0 = __builtin_amdgcn_mfma_f32_16x16x32_bf16(ones, P[0], L0, 0, 0, 0); \
        if (!OWN || (e) <= emax1) L1 = __builtin_amdgcn_mfma_f32_16x16x32_bf16(ones, P[1], L1, 0, 0, 0); \
        _Pragma("unroll") for (int dt = 0; dt < 4; ++dt) { \
        if (!OWN || (e) <= emax0) O[dt][0] = __builtin_amdgcn_mfma_f32_16x16x32_bf16(VF[dt], P[0], O[dt][0], 0, 0, 0); \
        if (!OWN || (e) <= emax1) O[dt][1] = __builtin_amdgcn_mfma_f32_16x16x32_bf16(VF[dt], P[1], O[dt][1], 0, 0, 0); } } while (0)
    LDK(0, KA); SBAR();
    LDK(1, KB); SBAR(); MMS(0, KA, SA); SBAR();
    LDK(2, KA); LDV(0, VA); SBAR(); MMS(1, KB, SB); EXPP(0, SA); SBAR();
    LDK(3, KB); LDV(1, VB); SBAR(); MMV(0, VA); MMS(2, KA, SA); EXPP(1, SB); SBAR();
    LDK(4, KA); LDV(2, VA); SBAR(); MMV(1, VB); MMS(3, KB, SB); EXPP(2, SA); SBAR();
    LDK(5, KB); LDV(3, VB); SBAR(); MMV(2, VA); MMS(4, KA, SA); EXPP(3, SB); SBAR();
    LDK(6, KA); LDV(4, VA); SBAR(); MMV(3, VB); MMS(5, KB, SB); EXPP(4, SA); SBAR();
    LDK(7, KB); LDV(5, VB); SBAR(); MMV(4, VA); MMS(6, KA, SA); EXPP(5, SB); SBAR();
    LDV(6, VA); SBAR(); MMV(5, VB); MMS(7, KB, SB); EXPP(6, SA); SBAR();
    LDV(7, VB); SBAR(); MMV(6, VA); EXPP(7, SB); SBAR();
    MMV(7, VB);
#undef SBAR
    lsum0 = L0[0]; lsum1 = L1[0];
#undef LDK
#undef MMS
#undef EXPP1
#undef EXPP
#undef LDV
#undef MMV
}
__device__ __forceinline__ void attn_phase(LAS unsigned char* L, const bf16_t* QN, const bf16_t* KN, const bf16_t* VB, const float* g_q, const float* g_k,
                                           const unsigned* qcnt, const unsigned short* QL, bf16_t* OP, float* LP, bf16_t* DUMMY, int vcu, int G, int tid, int lane, int wave) {
    LAS int* ipref = (LAS int*)(L + AT_IPREF); LAS int* icnt = (LAS int*)(L + AT_ICNT); LAS int* myit = (LAS int*)(L + AT_MYIT);
    {
        const int c = (int)__hip_atomic_load(qcnt + tid, RLX_AGENT);
        const int nit = 1 + ((c + 255) >> 8);
        int incl = nit;
#pragma unroll
        for (int o = 1; o < 64; o <<= 1) { const int v = __shfl_up(incl, o); if (lane >= o) incl += v; }
        icnt[tid] = c;
        if (lane == 63) myit[64 + wave] = incl;
        __syncthreads();
        int woff = 0;
        for (int w = 0; w < wave; ++w) woff += myit[64 + w];
        ipref[tid] = woff + incl - nit;
        if (tid == 511) ipref[512] = woff + incl;
        __syncthreads();
    }
    const int nitems = ipref[512];
    const int nmine = (nitems - vcu + G - 1) / G;
    if (tid < nmine && tid < 64) {
        const int Lx = tid * G + vcu; int t = 0;
#pragma unroll 1
        for (int j = 256; j > 0; j >>= 1) if (ipref[t + j] <= Lx) t += j;
        myit[tid] = (t << 8) | (Lx - ipref[t]);
    }
    __syncthreads();
    float gqm = fabsf(g_q[lane]), gkm = fabsf(g_k[lane]);
#pragma unroll
    for (int o = 1; o < 64; o <<= 1) { gqm = fmaxf(gqm, __shfl_xor(gqm, o)); gkm = fmaxf(gkm, __shfl_xor(gkm, o)); }
    const float MREF = 11.6f * gqm * gkm + 0.125f;
    const float CS = 0.125f * 1.4426950408889634f;
    const int fr = lane & 15, fq = lane >> 4;
    const int nloop = nmine < 64 ? nmine : 64;
    if (nloop <= 0) return;
#define AT_DECODE(itw, E0, E1, V0, V1) do { const int t_ = (itw) >> 8, k_ = (itw) & 255; \
        if (k_ == 0) { int l2_ = lane; asm volatile("" : "+v"(l2_)); const int f2_ = l2_ & 15; E0 = ((t_ & 15) * 256 + 16 * wave + f2_) | (3 << 12); E1 = ((t_ & 15) * 256 + 16 * (15 - wave) + f2_) | (3 << 12); V0 = 1; V1 = 1; } \
        else { const int base_ = (k_ - 1) * 256, nq_ = min(256, icnt[t_] - base_); const int q0 = 32 * wave + fr, q1 = q0 + 16; \
               const unsigned short* ql_ = QL + (size_t)t_ * 4096 + base_; V0 = q0 < nq_; V1 = q1 < nq_; \
               const unsigned short* p0_ = ql_ + (V0 ? q0 : 0); const unsigned short* p1_ = ql_ + (V1 ? q1 : 0); \
               asm volatile("global_load_ushort %0, %1, off" : "=v"(E0) : "v"(p0_) : "memory"); asm volatile("global_load_ushort %0, %1, off" : "=v"(E1) : "v"(p1_) : "memory"); } } while (0)
#define AT_QLOAD(itw, E0, E1, QR) do { const int t_ = (itw) >> 8; const int b_ = t_ >> 7, h_ = (t_ >> 4) & 7; \
        const bf16_t* q0_ = QN + ((size_t)(b_ * NH + h_) * S_ + ((E0) & 0xfff)) * DH + 8 * fq; const bf16_t* q1_ = QN + ((size_t)(b_ * NH + h_) * S_ + ((E1) & 0xfff)) * DH + 8 * fq; \
        const bf16_t* q0b_ = q0_ + 32; const bf16_t* q1b_ = q1_ + 32; \
        asm volatile("global_load_dwordx4 %0, %1, off" : "=v"(QR[0]) : "v"(q0_) : "memory"); asm volatile("global_load_dwordx4 %0, %1, off" : "=v"(QR[1]) : "v"(q0b_) : "memory"); \
        asm volatile("global_load_dwordx4 %0, %1, off" : "=v"(QR[2]) : "v"(q1_) : "memory"); asm volatile("global_load_dwordx4 %0, %1, off" : "=v"(QR[3]) : "v"(q1b_) : "memory"); } while (0)
#define AT_STAGE(itw, bufi) do { const int t_ = (itw) >> 8; const int b_ = t_ >> 7, h_ = (t_ >> 4) & 7, j_ = t_ & 15; const size_t r0_ = ((size_t)(b_ * NH + h_) * S_ + j_ * 256) * DH; \
        attn_stage_tile(L + (bufi) * 65536, KN + r0_, wave, lane); attn_stage_tile(L + (bufi) * 65536 + 32768, VB + r0_, wave, lane); } while (0)
    int it0 = myit[0];
    int ec0, ec1, xl0 = 0, xl1 = 0, vc0, vc1, vn0 = 0, vn1 = 0;
    v4u qn[4];
    AT_STAGE(it0, 0);
    AT_DECODE(it0, ec0, ec1, vc0, vc1);
    asm volatile("s_waitcnt vmcnt(0)" : "+v"(ec0), "+v"(ec1) :: "memory");
    AT_QLOAD(it0, ec0, ec1, qn);
    if (nloop > 1) { const int it1 = myit[1]; AT_DECODE(it1, xl0, xl1, vn0, vn1); }
    f32x4 O[4][2]; float lsum0 = 0.f, lsum1 = 0.f; int pe0 = 0, pe1 = 0, ph_ = 0, pb_ = 0;
    LAS unsigned char* ost = L + XTRA_OFF + 8192 + wave * 2304;
#define AT_STORE_PREV() do { _Pragma("unroll") for (int qi = 0; qi < 2; ++qi) { const int e = qi ? pe1 : pe0; \
            _Pragma("unroll") for (int dt = 0; dt < 4; ++dt) { v2u w; w.x = cvt_pk(O[dt][qi][0], O[dt][qi][1]); w.y = cvt_pk(O[dt][qi][2], O[dt][qi][3]); *(LAS v2u*)(ost + fr * 144 + 32 * dt + 8 * fq) = w; } \
            { const size_t row = (size_t)((e >> 12) & 3) * T_ + (size_t)(pb_ * S_ + (e & 0xfff)); float* lpd = ((e & 0x8000) && fq == 0) ? LP + row * 8 + ph_ : (float*)DUMMY + 1024 + lane; *(GAS float*)lpd = qi ? lsum1 : lsum0; } \
            LDS_WAIT(); asm volatile("" ::: "memory"); \
            _Pragma("unroll") for (int hh = 0; hh < 2; ++hh) { const int rq = (lane >> 3) + 8 * hh; const int er = __shfl(e, rq); \
                const v4u val = *(const LAS v4u*)(ost + rq * 144 + (lane & 7) * 16); \
                const size_t row = (size_t)((er >> 12) & 3) * T_ + (size_t)(pb_ * S_ + (er & 0xfff)); bf16_t* od = (er & 0x8000) ? OP + row * 512 + ph_ * 64 + (lane & 7) * 8 : DUMMY + lane * 8; *(GAS v4u*)od = val; } \
            LDS_WAIT(); asm volatile("" ::: "memory"); } } while (0)
    for (int it = 0; it < nloop; ++it) {
        const int itw = myit[it];
        const int t_ = itw >> 8, own = ((itw & 255) == 0);
        const int h_ = (t_ >> 4) & 7;
        if (it == 0) asm volatile("s_waitcnt vmcnt(0) lgkmcnt(0)" : "+v"(qn[0]), "+v"(qn[1]), "+v"(qn[2]), "+v"(qn[3]), "+v"(xl0), "+v"(xl1) :: "memory");
        else asm volatile("s_waitcnt vmcnt(6) lgkmcnt(0)" : "+v"(qn[0]), "+v"(qn[1]), "+v"(qn[2]), "+v"(qn[3]), "+v"(xl0), "+v"(xl1) :: "memory");
        __builtin_amdgcn_s_barrier(); asm volatile("" ::: "memory");
        const int en0 = xl0, en1 = xl1;
        bf16x8 qf[2][2];
        qf[0][0] = scale_bf16x8(qn[0], CS); qf[0][1] = scale_bf16x8(qn[1], CS); qf[1][0] = scale_bf16x8(qn[2], CS); qf[1][1] = scale_bf16x8(qn[3], CS);
        int vx0 = 0, vx1 = 0;
        if (it + 1 < nloop) {
            const int itn = myit[it + 1];
            AT_STAGE(itn, (it + 1) & 1);
            AT_QLOAD(itn, en0, en1, qn);
            if (it + 2 < nloop) { const int itn2 = myit[it + 2]; AT_DECODE(itn2, xl0, xl1, vx0, vx1); }
        }
        asm volatile("" ::: "memory");
        LAS const unsigned char* Kb = L + (it & 1) * 65536; LAS const unsigned char* Vb = Kb + 32768;
        lsum0 = 0.f; lsum1 = 0.f;
#pragma unroll
        for (int dt = 0; dt < 4; ++dt) { O[dt][0] = (f32x4){0.f, 0.f, 0.f, 0.f}; O[dt][1] = (f32x4){0.f, 0.f, 0.f, 0.f}; }
        const int ql0 = (ec0 & 0xff), ql1 = (ec1 & 0xff);
        if (own) attn_item<true>(Kb, Vb, qf, MREF, O, lsum0, lsum1, fr, fq, lane, ql0, ql1);
        else attn_item<false>(Kb, Vb, qf, MREF, O, lsum0, lsum1, fr, fq, lane, ql0, ql1);
        pe0 = ec0 | (vc0 << 15); pe1 = ec1 | (vc1 << 15); ph_ = h_; pb_ = t_ >> 7;
        AT_STORE_PREV();
        ec0 = en0; ec1 = en1; vc0 = vn0; vc1 = vn1; vn0 = vx0; vn1 = vx1;
    }
    asm volatile("s_waitcnt vmcnt(0) lgkmcnt(0)" ::: "memory"); __builtin_amdgcn_s_barrier();
#undef AT_STORE_PREV
#undef AT_DECODE
#undef AT_QLOAD
#undef AT_STAGE
}

__global__ void __launch_bounds__(NWAVES * 64, 2) mk_fwd(Args args) {
    extern __shared__ __attribute__((aligned(16))) unsigned char lds[];
    LAS unsigned char* L = (LAS unsigned char*)lds;
    volatile LAS unsigned* MISC = (volatile LAS unsigned*)(L + MISC_OFF);
    const int tid = threadIdx.x, lane = tid & 63, wave = __builtin_amdgcn_readfirstlane(tid >> 6);
    const int G = gridDim.x; const int bx = blockIdx.x;
    const int vcu = (G % 8 == 0) ? (bx % 8) * (G / 8) + bx / 8 : bx;
    unsigned char* ws = args.ws;
    gu32* ctl = (gu32*)(ws + WS_CTL);
    const float* x = args.in[0]; const float* p_in = args.in[1]; const float* g_mix = args.in[2]; const float* w_in = args.in[3];
    const float* g_q = args.in[7]; const float* g_k = args.in[8];
    const float* w_out = args.in[11]; const float* g_ffn = args.in[12];
    const float* w_gate_e = args.in[15]; const float* w_up_e = args.in[16]; const float* w_down_e = args.in[17];
    const float* g_ple = args.in[18]; const float* w_ple = args.in[19]; const float* w_ple_gate = args.in[20];
    bf16_t* WIN = (bf16_t*)(ws + WS_WIN); bf16_t* WOUT = (bf16_t*)(ws + WS_WOUT); bf16_t* WGU = (bf16_t*)(ws + WS_WGU); bf16_t* WD = (bf16_t*)(ws + WS_WD);
    bf16_t* WPLE = (bf16_t*)(ws + WS_WPLE); bf16_t* WPG = (bf16_t*)(ws + WS_WPG);
    bf16_t* XN = (bf16_t*)(ws + WS_XN); bf16_t* PB = (bf16_t*)(ws + WS_PB); bf16_t* ARR0 = (bf16_t*)(ws + WS_ARR); bf16_t* PW = (bf16_t*)(ws + WS_PW);
    float* KMEAN = (float*)(ws + WS_KMEAN); float* SSQ1 = (float*)(ws + WS_SSQ1);
    const float* w_group = args.in[13]; const float* w_expert = args.in[14];
    bf16_t* YCAT = (bf16_t*)(ws + WS_YCAT); bf16_t* H1B = (bf16_t*)(ws + WS_H1B); bf16_t* A2 = (bf16_t*)(ws + WS_A2); bf16_t* YS = (bf16_t*)(ws + WS_YS); bf16_t* H2B = (bf16_t*)(ws + WS_H2B);
    unsigned* LTOK = (unsigned*)(ws + WS_LTOK); f32x2* LSC = (f32x2*)(ws + WS_LSC); float* RSTD2 = (float*)(ws + WS_RSTD2); bf16_t* WR = (bf16_t*)(ws + WS_WR);
    float* OUT = args.out;
    unsigned char* WGU8 = (unsigned char*)(ws + WS_WGU); unsigned char* WPG8 = (unsigned char*)(ws + WS_WPG); unsigned char* H1F8 = (unsigned char*)args.out; unsigned char* H2F8 = (unsigned char*)(ws + WS_A2);
    const float* g_v_a = args.in[4]; const float* w_s = args.in[5]; const float* b_s = args.in[6]; const float* g_out_a = args.in[9]; const float* g_out_b = args.in[10];
    unsigned short* QLp = (unsigned short*)(ws + WS_QL);
    bf16_t* YA = (bf16_t*)(ws + WS_YA); bf16_t* OP = (bf16_t*)args.out; float* LP = (float*)(ws + WS_LP);

    for (int u = tid; u < (LDS_BYTES - LDSCTL_OFF) / 4; u += NWAVES * 64) ((LAS unsigned*)(L + LDSCTL_OFF))[u] = 0u;
    __syncthreads();
    const int lo = args.ph_lo, hi = args.ph_hi;
    const bool multi = (hi - lo) > 1;
    XcdBarrier bar; bar.bar = (unsigned*)(ctl + CW_BAR); bar.x = 0; bar.st = nullptr;
    if (multi) bar = xcd_barrier_post((unsigned*)(ctl + CW_BAR), MISC + 8);
#ifdef PROBE_PHASE
    unsigned long long* TS = (unsigned long long*)(ws + WS_ORC);
#define STAMP(k) do { if (bx == 0 && tid == 0) TS[k] = __builtin_amdgcn_s_memrealtime(); } while (0)
#else
#define STAMP(k) do {} while (0)
#endif
#define IN(k) (lo <= (k) && (k) < hi)
#define SEAM(k) do { if (IN(k) && IN((k) + 1)) xcd_barrier(bar); STAMP((k) + 1); } while (0)

    STAMP(0);
    if (IN(0)) {
        const int gw = vcu * NWAVES + wave, NGW = G * NWAVES;
        {
            constexpr int T_IN = 16 * 10, T_OUT = 16 * 4, T_G = 32 * 16, T_U = T_G, T_D = 32 * 16, T_PLE = 4 * 4, T_PG = 16 * 4;
            constexpr int NTILES = T_IN + T_OUT + T_G + T_U + T_D + T_PLE + T_PG;
            constexpr int NTP = 257, TBUF = 64 * NTP * 4;
#define P0_DECODE(itv, SRC, DST, GAIN, KK, NN, K0, N0, MM) do { int r_ = (itv); int tl_ = 0; MM = 0; \
                if (r_ < T_IN) { SRC = w_in; DST = WIN; GAIN = g_mix; KK = 1024; NN = 2560; MM = 1; tl_ = r_; } \
                else if ((r_ -= T_IN) < T_OUT) { SRC = w_out; DST = WOUT; GAIN = nullptr; KK = 1024; NN = 1024; tl_ = r_; } \
                else if ((r_ -= T_OUT) < T_G) { const int e_ = r_ >> 4; SRC = w_gate_e + (size_t)e_ * 1024 * 256; DST = (bf16_t*)(WGU8 + (size_t)e_ * 512 * 1024 * (MOE1_F8 ? 1 : 2)); GAIN = g_ffn; KK = 1024; NN = 256; MM = 2; tl_ = r_ & 15; } \
                else if ((r_ -= T_G) < T_U) { const int e_ = r_ >> 4; SRC = w_up_e + (size_t)e_ * 1024 * 256; DST = (bf16_t*)(WGU8 + (size_t)e_ * 512 * 1024 * (MOE1_F8 ? 1 : 2)); GAIN = g_ffn; KK = 1024; NN = 256; MM = 3; tl_ = r_ & 15; } \
                else if ((r_ -= T_U) < T_D) { const int e_ = r_ >> 4; SRC = w_down_e + (size_t)e_ * 256 * 1024; DST = WD + (size_t)e_ * 1024 * 256; GAIN = nullptr; KK = 256; NN = 1024; tl_ = r_ & 15; } \
                else if ((r_ -= T_D) < T_PLE) { SRC = w_ple; DST = WPLE; GAIN = nullptr; KK = 256; NN = 1024; tl_ = r_; } \
                else { r_ -= T_PLE; SRC = w_ple_gate; DST = (bf16_t*)WPG8; GAIN = g_ple; KK = 1024; NN = 1024; MM = 4; tl_ = r_; } \
                const int nblk_ = NN / 256; K0 = 64 * (tl_ / nblk_); N0 = 256 * (tl_ % nblk_); } while (0)
#define P0_LOAD(SRC, GAIN, NN, K0, N0) do { _Pragma("unroll") for (int i_ = 0; i_ < 8; ++i_) { const int kk_ = 8 * wave + i_; \
                pv[i_] = *(const GAS f32x4*)(SRC + (size_t)(K0 + kk_) * NN + N0 + 4 * lane); pg[i_] = GAIN ? GAIN[K0 + kk_] : 1.f; } } while (0)
            const float* csrc = nullptr; bf16_t* cdst = nullptr; const float* cgain = nullptr; int cK = 0, cN = 0, ck0 = 0, cn0 = 0, cmm = 0;
            f32x4 pv[8]; float pg[8];
            int tl = vcu, pbuf = 0;
            if (tl < NTILES) { P0_DECODE(tl, csrc, cdst, cgain, cK, cN, ck0, cn0, cmm); P0_LOAD(csrc, cgain, cN, ck0, cn0); }
            while (tl < NTILES) {
                LAS float* tb = (LAS float*)(L + pbuf * TBUF);
#pragma unroll
                for (int i = 0; i < 8; ++i) { LAS float* d_ = tb + (8 * wave + i) * NTP + 4 * lane; const f32x4 v = pv[i] * pg[i]; d_[0] = v.x; d_[1] = v.y; d_[2] = v.z; d_[3] = v.w; }
                bf16_t* odst = cdst; const int oK = cK, ok0 = ck0, on0 = cn0, omm = cmm;
                const int tln = tl + G;
                LDS_WAIT(); __syncthreads();
                if (tln < NTILES) { P0_DECODE(tln, csrc, cdst, cgain, cK, cN, ck0, cn0, cmm); P0_LOAD(csrc, cgain, cN, ck0, cn0); }
                asm volatile("" ::: "memory");
                const int kc = lane & 7;
#pragma unroll
                for (int j = 0; j < 4; ++j) {
                    const int c = (tid >> 3) + 64 * j;
                    const LAS float* s_ = tb + (8 * kc) * NTP + c;
                    int drow = on0 + c;
                    if (omm == 1) { if (on0 >= 1024 && on0 < 2048) drow = on0 + 128 * ((c >> 5) & 1) + 32 * (c >> 6) + (c & 31); }
                    else if (omm == 2) drow = (c >> 7) * 256 + (c & 127);
                    else if (omm == 3) drow = (c >> 7) * 256 + 128 + (c & 127);
                    if (omm == 4 || (MOE1_F8 && omm >= 2)) {
                        v2u o8; o8.x = pk4_fp8(s_[0 * NTP] * F8_WSCALE, s_[1 * NTP] * F8_WSCALE, s_[2 * NTP] * F8_WSCALE, s_[3 * NTP] * F8_WSCALE); o8.y = pk4_fp8(s_[4 * NTP] * F8_WSCALE, s_[5 * NTP] * F8_WSCALE, s_[6 * NTP] * F8_WSCALE, s_[7 * NTP] * F8_WSCALE);
                        *(GAS v2u*)((unsigned char*)odst + (size_t)drow * oK + ok0 + 8 * kc) = o8;
                    } else {
                        v4u o; o.x = pk2(s_[0 * NTP], s_[1 * NTP]); o.y = pk2(s_[2 * NTP], s_[3 * NTP]); o.z = pk2(s_[4 * NTP], s_[5 * NTP]); o.w = pk2(s_[6 * NTP], s_[7 * NTP]);
                        *(GAS v4u*)(odst + (size_t)drow * oK + ok0 + 8 * kc) = o;
                    }
                }
                tl = tln; pbuf ^= 1;
            }
            LDS_WAIT(); __syncthreads();
#undef P0_DECODE
#undef P0_LOAD
        }
        for (int m = gw; m < T_; m += 2 * NGW) {
            const GAS f32x4* xr0 = (const GAS f32x4*)(x + (size_t)m * D_) + lane; const GAS f32x4* xr1 = (const GAS f32x4*)(x + (size_t)(m + NGW) * D_) + lane;
            f32x4 v0[4], v1[4]; float s0 = 0.f, s1 = 0.f;
#pragma unroll
            for (int j = 0; j < 4; ++j) { v0[j] = xr0[64 * j]; v1[j] = xr1[64 * j]; }
#pragma unroll
            for (int j = 0; j < 4; ++j) { s0 += (v0[j].x * v0[j].x + v0[j].y * v0[j].y) + (v0[j].z * v0[j].z + v0[j].w * v0[j].w); s1 += (v1[j].x * v1[j].x + v1[j].y * v1[j].y) + (v1[j].z * v1[j].z + v1[j].w * v1[j].w); }
            const float r0 = rsqrtf(wave_sum_x(s0) * (1.f / D_) + EPS), r1 = rsqrtf(wave_sum_x(s1) * (1.f / D_) + EPS);
            GAS v2u* o0 = (GAS v2u*)(XN + (size_t)m * D_) + lane; GAS v2u* o1 = (GAS v2u*)(XN + (size_t)(m + NGW) * D_) + lane;
#pragma unroll
            for (int j = 0; j < 4; ++j) { v2u w; w.x = pk2(v0[j].x * r0, v0[j].y * r0); w.y = pk2(v0[j].z * r0, v0[j].w * r0); o0[64 * j] = w;
                                          v2u w2; w2.x = pk2(v1[j].x * r1, v1[j].y * r1); w2.y = pk2(v1[j].z * r1, v1[j].w * r1); o1[64 * j] = w2; }
        }
        for (int i = gw * 64 + lane; i < 48 * 1024; i += NGW * 64) {
            const int jj = i >> 10, k = i & 1023; float v = 0.f;
            if (jj < 4) v = w_group[k * 4 + jj] * g_ffn[k];
            else if (jj >= 16) { const int hi = (jj >= 32), g = ((jj - 16) & 15) >> 2, r = jj & 3; v = w_expert[k * 32 + g * 8 + hi * 4 + r] * g_ffn[k]; }
            WR[i] = (bf16_t)f2bf(v);
        }
    }
    SEAM(0);
    if (IN(1)) {
        pg8::StaticOrder S; S.init(XN, WIN, T_, 2048, D_, G, bx);
        EpiInProj E{ARR0, KMEAN, g_q, g_k, 0, 0};
        pg8::gemm_phase<EpiInProj, pg8::StaticOrder, true>(L + RING_OFF, D_, S, E);
    }
    SEAM(1);
    if (IN(2)) {
        const int GH = G >> 1;
        if (bx < GH) {
            pg8::StaticOrder S; S.init(XN, WIN + (size_t)2048 * 1024, T_, 512, D_, GH, bx);
            EpiInProj E{ARR0, KMEAN, g_q, g_k, 8, 0};
            pg8::gemm_phase<EpiInProj, pg8::StaticOrder, true>(L + RING_OFF, D_, S, E);
            { const int u = 384 + bx; mixa_load_w(L + RING_OFF, w_s + (size_t)(u & 3) * 128 * 128, tid); mixa_unit(L + RING_OFF, u, ARR0, ARR0 + ARR, g_v_a, b_s, YA, tid, lane, wave); }
        } else {
            const int c2 = bx - GH, G2 = G - GH;
            { const int gw = c2 * NWAVES + wave, NGW = G2 * NWAVES;
              for (int tk = gw; tk < NB_ * NH * 15 * 4; tk += NGW) { const int task = (tk < NGW) ? tk : (NB_ * NH * 15 * 4 - 1) - (tk - NGW); if (task < NGW && tk >= NGW) continue; gate_task(task, ARR0 + 2 * ARR, KMEAN, (unsigned*)ctl + CW_QCNT, QLp, lane, (LAS float*)(L + RING_OFF + 81920 + wave * 4096)); }
              LDS_WAIT(); }
            int curg = -1;
            for (int u = c2; u < 384; u += G2) {
                const int g = u & 3;
                if (g != curg) { mixa_load_w(L + RING_OFF, w_s + (size_t)g * 128 * 128, tid); curg = g; }
                mixa_unit(L + RING_OFF, u, ARR0, ARR0 + ARR, g_v_a, b_s, YA, tid, lane, wave);
            }
        }
    }
    SEAM(2);
    if (IN(3)) attn_phase(L, ARR0 + 2 * ARR, ARR0 + 3 * ARR, ARR0 + 4 * ARR, g_q, g_k, (const unsigned*)ctl + CW_QCNT, QLp, OP, LP, (bf16_t*)(ws + 200 * MiB), vcu, G, tid, lane, wave);
    SEAM(3);
    if (IN(PH_COMB)) {
        const int gw = vcu * NWAVES + wave, NGW = G * NWAVES;
        for (int m = gw; m < T_; m += NGW) combine_row(m, YA, OP, LP, g_out_a, g_out_b, YCAT, lane);
    }
    SEAM(PH_COMB);
    if (IN(5)) {
        pg8::StaticOrder S; S.init(YCAT, WOUT, T_, D_, D_, G, bx);
        EpiOutProj E{x, H1B, SSQ1, H1F8};
        pg8::gemm_phase<EpiOutProj, pg8::StaticOrder, true>(L + RING_OFF, D_, S, E);
    }
    SEAM(5);
    if (IN(6)) {
        { const int gw = vcu * NWAVES + wave, NGW = G * NWAVES;
          for (int m = gw; m < T_; m += NGW) {
              const f32x4 v = ((const GAS f32x4*)(p_in + (size_t)m * DPLE))[lane];
              v2u w; w.x = pk2(v.x, v.y); w.y = pk2(v.z, v.w);
              ((GAS v2u*)(PB + (size_t)m * DPLE))[lane] = w;
          } }
        LAS int* hist = (LAS int*)(L + XTRA_OFF); LAS int* hbase = hist + 32;
        for (int chunk = vcu; chunk < T_ / 64; chunk += G) {
            if (tid < 32) hist[tid] = 0;
            __syncthreads();
            int e1 = -1, e2 = -1, rk1 = 0, rk2 = 0, tok = 0; float c1 = 0.f, c2 = 0.f, rs1 = 0.f;
            LAS float* part = (LAS float*)(L + RING_OFF + 100352);
            {
                const int fr = lane & 15, fq = lane >> 4;
                const int t0 = chunk * 64 + (wave & 3) * 16, kh = wave >> 2;
                f32x4 d0 = {0.f, 0.f, 0.f, 0.f}, d1 = d0, d2 = d0;
                const bf16_t* ap = H1B + (size_t)(t0 + fr) * D_ + 8 * fq + kh * 512;
                bf16x8 hf[16];
#pragma unroll
                for (int ks = 0; ks < 16; ++ks) hf[ks] = *(const bf16x8*)(ap + ks * 32);
                const float ssq_tok = SSQ1[t0 + fr];
#pragma unroll
                for (int i = 0; i < 12; ++i) { const int pc = tid + 512 * i, rr = pc >> 7, cc = pc & 127; *(LAS v4u*)(L + RING_OFF + rr * 2064 + cc * 16) = *(const GAS v4u*)(WR + (size_t)rr * D_ + cc * 8); }
                LDS_WAIT(); __syncthreads();
                LAS const unsigned char* bpl = L + RING_OFF + fr * 2064 + (8 * fq + kh * 512) * 2;
#pragma unroll
                for (int ks = 0; ks < 16; ++ks) {
                    const bf16x8 w0 = *(const LAS bf16x8*)(bpl + ks * 64), w1 = *(const LAS bf16x8*)(bpl + 16 * 2064 + ks * 64), w2 = *(const LAS bf16x8*)(bpl + 32 * 2064 + ks * 64);
                    d0 = __builtin_amdgcn_mfma_f32_16x16x32_bf16(w0, hf[ks], d0, 0, 0, 0);
                    d1 = __builtin_amdgcn_mfma_f32_16x16x32_bf16(w1, hf[ks], d1, 0, 0, 0);
                    d2 = __builtin_amdgcn_mfma_f32_16x16x32_bf16(w2, hf[ks], d2, 0, 0, 0);
                }
                if (kh == 1) {
#pragma unroll
                    for (int r = 0; r < 4; ++r) { part[((wave & 3) * 12 + r) * 64 + lane] = d0[r]; part[((wave & 3) * 12 + 4 + r) * 64 + lane] = d1[r]; part[((wave & 3) * 12 + 8 + r) * 64 + lane] = d2[r]; }
                }
                LDS_WAIT(); __syncthreads();
              if (kh == 0) {
#pragma unroll
                for (int r = 0; r < 4; ++r) { d0[r] += part[(wave * 12 + r) * 64 + lane]; d1[r] += part[(wave * 12 + 4 + r) * 64 + lane]; d2[r] += part[(wave * 12 + 8 + r) * 64 + lane]; }
                tok = t0 + fr;
                rs1 = rsqrtf(ssq_tok * (1.f / D_) + EPS);
                float gl[4];
#pragma unroll
                for (int r = 0; r < 4; ++r) gl[r] = __shfl(d0[r], fr) * rs1;
                int gs = 0; float gm = gl[0];
#pragma unroll
                for (int r = 1; r < 4; ++r) if (gl[r] > gm) { gm = gl[r]; gs = r; }
                float den = 0.f;
#pragma unroll
                for (int r = 0; r < 4; ++r) den += __expf(gl[r] - gm);
                const float pg = 1.f / den;
                float el[8];
#pragma unroll
                for (int r = 0; r < 4; ++r) { el[r] = d1[r] * rs1; el[4 + r] = d2[r] * rs1; }
                int a1 = 0; float m1 = el[0];
#pragma unroll
                for (int j = 1; j < 8; ++j) if (el[j] > m1) { m1 = el[j]; a1 = j; }
                int a2 = -1; float m2 = -INFINITY;
#pragma unroll
                for (int j = 0; j < 8; ++j) if (j != a1 && el[j] > m2) { m2 = el[j]; a2 = j; }
                const float ex2 = __expf(m2 - m1);
                if (fq == gs) {
                    e1 = gs * 8 + a1; e2 = gs * 8 + a2; c1 = pg / (1.f + ex2); c2 = pg * ex2 / (1.f + ex2);
                    rk1 = __hip_atomic_fetch_add(hist + e1, 1, __ATOMIC_RELAXED, __HIP_MEMORY_SCOPE_WORKGROUP);
                    rk2 = __hip_atomic_fetch_add(hist + e2, 1, __ATOMIC_RELAXED, __HIP_MEMORY_SCOPE_WORKGROUP);
                }
              }
            }
            __syncthreads();
            if (tid < 32) { const int hc = hist[tid]; hbase[tid] = hc > 0 ? (int)__hip_atomic_fetch_add((unsigned*)ctl + CW_CNT + 64 * tid, (unsigned)hc, RLX_AGENT) : 0; }
            __syncthreads();
            if (e1 >= 0) {
                const int p1 = hbase[e1] + rk1, p2 = hbase[e2] + rk2;
                LTOK[(size_t)e1 * LCAP + p1] = (unsigned)tok; LSC[(size_t)e1 * LCAP + p1] = (f32x2){rs1, c1};
                LTOK[(size_t)e2 * LCAP + p2] = (unsigned)tok | 0x10000u; LSC[(size_t)e2 * LCAP + p2] = (f32x2){rs1, c2};
            }
            __syncthreads();
        }
    }
    SEAM(6);
    if (IN(7) || IN(8) || IN(9)) {
        LAS int* pref = (LAS int*)(L + XTRA_OFF + 1024);
        __syncthreads();
        if (tid < 32) pref[33 + tid] = (int)__hip_atomic_load((unsigned*)ctl + CW_CNT + 64 * tid, RLX_AGENT);
        __syncthreads();
        if (tid == 0) { int acc_ = 0; for (int e = 0; e < 32; ++e) { pref[e] = acc_; acc_ += (pref[33 + e] + 255) >> 8; } pref[32] = acc_; }
        __syncthreads();
    }
    if (IN(7) || IN(8) || IN(9)) {
        const LAS int* pref = (const LAS int*)(L + XTRA_OFF + 1024);
        const int tot = pref[32], U1 = 2 * tot, first = U1 < G ? U1 : G, rem = U1 - first, T1 = first >> 1;
        if (IN(7)) {
            MoeOrder1 S{MOE1_F8 ? (const char*)H1F8 : (const char*)H1B, (const char*)WGU8, LTOK, pref, G, bx, 0, first};
            EpiMoe1 E{A2, LSC};
            pg8::gemm_phase<EpiMoe1, MoeOrder1, true>(L + RING_OFF, D_, S, E);
        }
        SEAM(7);
        if (IN(8)) {
            if (bx < rem) {
                MoeOrder1 S{MOE1_F8 ? (const char*)H1F8 : (const char*)H1B, (const char*)WGU8, LTOK, pref, rem, bx, first, U1};
                EpiMoe1 E{A2, LSC};
                pg8::gemm_phase<EpiMoe1, MoeOrder1, true>(L + RING_OFF, D_, S, E);
            } else {
                MoeOrder2 S{(const char*)A2, (const char*)WD, pref, G - rem, bx - rem, 0, 4 * T1};
                EpiMoe2 E{YS, LTOK};
                pg8::gemm_phase<EpiMoe2, MoeOrder2, true>(L + RING_OFF, DFF, S, E);
            }
        }
        SEAM(8);
        if (IN(9)) {
            { MoeOrder2 S{(const char*)A2, (const char*)WD, pref, G, bx, 4 * T1, 4 * tot};
              EpiMoe2 E{YS, LTOK};
              pg8::gemm_phase<EpiMoe2, MoeOrder2, true>(L + RING_OFF, DFF, S, E); }
            { pg8::StaticOrder S; S.init(PB, WPLE, T_, D_, DPLE, G, (bx + G / 2) % G);
              EpiBf16Plain E{PW, D_};
              pg8::gemm_phase<EpiBf16Plain, pg8::StaticOrder, true>(L + RING_OFF, DPLE, S, E); }
        }
    }
    SEAM(9);
    if (IN(10)) {
        const int gw = vcu * NWAVES + wave, NGW = G * NWAVES;
        for (int m = gw; m < T_; m += NGW) {
            const GAS v2u* hr = (const GAS v2u*)(H1B + (size_t)m * D_) + lane;
            const GAS v2u* y0 = (const GAS v2u*)(YS + (size_t)m * D_) + lane; const GAS v2u* y1 = (const GAS v2u*)(YS + (size_t)(T_ + m) * D_) + lane;
            GAS v2u* hb = (GAS v2u*)(H2B + (size_t)m * D_) + lane;
            float s = 0.f;
#pragma unroll
            for (int j = 0; j < 4; ++j) {
                const v2u hq = hr[64 * j]; const v2u a = y0[64 * j], b = y1[64 * j];
                f32x4 v; v.x = __uint_as_float(hq.x << 16); v.y = __uint_as_float(hq.x & 0xffff0000u); v.z = __uint_as_float(hq.y << 16); v.w = __uint_as_float(hq.y & 0xffff0000u);
                v.x += __uint_as_float(a.x << 16) + __uint_as_float(b.x << 16); v.y += __uint_as_float(a.x & 0xffff0000u) + __uint_as_float(b.x & 0xffff0000u);
                v.z += __uint_as_float(a.y << 16) + __uint_as_float(b.y << 16); v.w += __uint_as_float(a.y & 0xffff0000u) + __uint_as_float(b.y & 0xffff0000u);
                v2u w; w.x = pk2(v.x, v.y); w.y = pk2(v.z, v.w); hb[64 * j] = w;
                ((GAS unsigned*)(H2F8 + (size_t)m * D_))[lane + 64 * j] = pk4_fp8(v.x * F8_ASCALE, v.y * F8_ASCALE, v.z * F8_ASCALE, v.w * F8_ASCALE);
                s += (v.x * v.x + v.y * v.y) + (v.z * v.z + v.w * v.w);
            }
            s = wave_sum_x(s);
            if (lane == 0) RSTD2[m] = rsqrtf(s * (1.f / D_) + EPS);
        }
    }
    SEAM(10);
    if (IN(11)) {
        pg8::StaticOrderT<true> S; S.init(H2F8, WPG8, T_, D_, D_, G, bx);
        EpiPleGate E{OUT, PW, RSTD2, H2B};
        pg8::gemm_phase<EpiPleGate, pg8::StaticOrderT<true>, true>(L + RING_OFF, D_, S, E);
    }
#ifdef PROBE_PHASE
    if (multi) { xcd_barrier(bar); STAMP(12);
        if (bx == 0 && tid == 0) { const float us = (float)(TS[PROBE_PHASE + 1] - TS[PROBE_PHASE]) * 0.01f; OUT[0] += us; } }
#endif
#undef IN
#undef SEAM
}

extern "C" void kernel_launch(void* const* d_in, const int* in_sizes, int n_in, void* d_out, int out_size, void* d_ws, size_t ws_size, hipStream_t stream) {
    using namespace orc;
    const float* x = (const float*)d_in[0];
    const float* p = (const float*)d_in[1];
    const float* g_mix = (const float*)d_in[2];
    const float* w_in = (const float*)d_in[3];
    const float* g_v_a = (const float*)d_in[4];
    const float* w_s = (const float*)d_in[5];
    const float* b_s = (const float*)d_in[6];
    const float* g_q = (const float*)d_in[7];
    const float* g_k = (const float*)d_in[8];
    const float* g_out_a = (const float*)d_in[9];
    const float* g_out_b = (const float*)d_in[10];
    const float* w_out = (const float*)d_in[11];
    const float* g_ffn = (const float*)d_in[12];
    const float* w_group = (const float*)d_in[13];
    const float* w_expert = (const float*)d_in[14];
    const float* w_gate_e = (const float*)d_in[15];
    const float* w_up_e = (const float*)d_in[16];
    const float* w_down_e = (const float*)d_in[17];
    const float* g_ple = (const float*)d_in[18];
    const float* w_ple = (const float*)d_in[19];
    const float* w_ple_gate = (const float*)d_in[20];
    float* out = (float*)d_out;
    char* ws = (char*)d_ws;
    (void)g_mix; (void)w_in; (void)p; (void)w_ple; (void)w_out; (void)g_ffn; (void)w_group; (void)w_expert; (void)w_gate_e; (void)w_up_e; (void)w_down_e; (void)g_ple; (void)w_ple_gate; (void)x;

    static int grid = 0;
    if (grid == 0) {
        int dev = 0, cus = 0, per_cu = 0;
        if (hipGetDevice(&dev) != hipSuccess || hipDeviceGetAttribute(&cus, hipDeviceAttributeMultiprocessorCount, dev) != hipSuccess) { fprintf(stderr, "kernel_launch: device query failed\n"); grid = -1; return; }
        if (hipFuncSetAttribute((const void*)mk_fwd, hipFuncAttributeMaxDynamicSharedMemorySize, LDS_BYTES) != hipSuccess) { fprintf(stderr, "kernel_launch: hipFuncSetAttribute(%d) failed\n", LDS_BYTES); grid = -1; return; }
        if (hipOccupancyMaxActiveBlocksPerMultiprocessor(&per_cu, (const void*)mk_fwd, NWAVES * 64, LDS_BYTES) != hipSuccess || per_cu < 1) { fprintf(stderr, "kernel_launch: occupancy query says %d\n", per_cu); per_cu = 1; }
        (void)hipGetLastError();
        grid = cus * 1;
        if (ws_size < 256 * MiB) { fprintf(stderr, "kernel_launch: workspace too small\n"); grid = -1; return; }
    }
    if (grid < 0) return;
    hipMemsetAsync(ws + WS_CTL, 0, ZERO_BYTES, stream);
    Args a{};
    for (int i = 0; i < 21; ++i) a.in[i] = (const float*)d_in[i];
    a.out = out; a.ws = (unsigned char*)d_ws; a.li = 0; a.pad = 0;

    float* rstd_va = (float*)(ws + WS_ORC);
    int* sel = (int*)(ws + WS_ORC + 512 * 1024);
    Route* route = (Route*)(ws + WS_ORC + 2 * MiB);
    float* rstd_h = (float*)(ws + WS_ORC + 2 * MiB + 512 * 1024);
    float* rstd_h2 = (float*)(ws + WS_ORC + 3 * MiB);
    float* kmean = (float*)(ws + WS_KMEAN);
    const bf16_t* ua = (const bf16_t*)(ws + WS_ARR); const bf16_t* va = ua + ARR; const bf16_t* qn = ua + 2 * ARR; const bf16_t* kn = ua + 3 * ARR; const bf16_t* vb = ua + 4 * ARR;
    const bf16_t* pwb = (const bf16_t*)(ws + WS_PW);

#ifndef ONE_LAUNCH
#define ONE_LAUNCH 1
#endif
#ifndef LEVEL
#define LEVEL 4
#endif
#ifndef ATT_ORACLE
#define ATT_ORACLE 0
#endif
#define LAUNCH_PH(lo_, hi_) do { a.ph_lo = (lo_); a.ph_hi = (hi_); hipLaunchKernelGGL(mk_fwd, dim3(grid), dim3(NWAVES * 64), LDS_BYTES, stream, a); } while (0)
#if ONE_LAUNCH
    LAUNCH_PH(0, 12);
    (void)ua; (void)va; (void)qn; (void)kn; (void)vb; (void)sel; (void)kmean; (void)rstd_va; (void)route; (void)rstd_h; (void)rstd_h2; (void)pwb; (void)g_v_a; (void)w_s; (void)b_s; (void)g_q; (void)g_k; (void)g_out_a; (void)g_out_b;
#else
    LAUNCH_PH(0, 1); LAUNCH_PH(1, 2);
    LAUNCH_PH(2, 3);
#if ATT_ORACLE
    bf16_t* op = (bf16_t*)out; float* lp = (float*)(ws + WS_LP);
    hipMemsetAsync(op, 0, (size_t)3 * T_ * 512 * 2, stream);
    hipMemsetAsync(lp, 0, (size_t)3 * T_ * 8 * 4, stream);
    k_fill<<<T_ * 8 / 256, 256, 0, stream>>>(lp + (size_t)3 * T_ * 8, 1.0f, T_ * 8, 0);
    k_gate<bf16_t><<<T_ * NH / 256, 256, 0, stream>>>(qn, kmean, sel);
    k_attn<bf16_t, bf16_t><<<T_ * NH, 256, 0, stream>>>(qn, kn, vb, sel, op + (size_t)3 * T_ * 512, 512, 0);
#else
    LAUNCH_PH(3, 4);
    (void)qn; (void)kn; (void)vb; (void)sel; (void)kmean;
#endif
    LAUNCH_PH(4, 5);
    (void)ua; (void)va; (void)rstd_va; (void)g_v_a; (void)w_s; (void)b_s; (void)g_out_a; (void)g_out_b;
#if LEVEL >= 2
    LAUNCH_PH(5, 6);
#else
    k_sgemm<<<dim3(D_ / 64, T_ / 64), 256, 0, stream>>>((long)D_, ALPlain<bf16_t>{ycat, D_, 0}, BLPlain{w_out, D_, 0}, EPResid{x, out, D_, 0});
#endif
#if LEVEL >= 3
    LAUNCH_PH(6, 7); LAUNCH_PH(7, 8); LAUNCH_PH(8, 9); LAUNCH_PH(9, 10); LAUNCH_PH(10, 11);
#if LEVEL >= 4
    LAUNCH_PH(11, 12);
#else
    float* h2 = (float*)(ws);
    hipMemcpyAsync(h2, out, (size_t)T_ * D_ * 4, hipMemcpyDeviceToDevice, stream);
    k_row_rstd<float><<<T_ / 4, 256, 0, stream>>>(h2, rstd_h2, T_, D_, D_, 0);
    k_sgemm<<<dim3(D_ / 64, T_ / 64), 256, 0, stream>>>((long)D_, ALScaled<float>{h2, rstd_h2, g_ple, D_, 0}, BLPlain{w_ple_gate, D_, 0}, EPPle<bf16_t>{h2, pwb, out, D_, 0});
#endif
#else
    float* h2 = (float*)(ws + 90 * MiB);
    k_row_rstd<float><<<T_ / 4, 256, 0, stream>>>(out, rstd_h, T_, D_, D_, 0);
    k_route<<<T_ / 4, 256, 0, stream>>>(out, rstd_h, g_ffn, w_group, w_expert, route);
    k_moe<<<T_, 256, 0, stream>>>(out, rstd_h, g_ffn, route, w_gate_e, w_up_e, w_down_e, h2);
    k_row_rstd<float><<<T_ / 4, 256, 0, stream>>>(h2, rstd_h2, T_, D_, D_, 0);
    k_sgemm<<<dim3(D_ / 64, T_ / 64), 256, 0, stream>>>((long)D_, ALScaled<float>{h2, rstd_h2, g_ple, D_, 0}, BLPlain{w_ple_gate, D_, 0}, EPPle<bf16_t>{h2, pwb, out, D_, 0});
#endif
#endif
}
```

```cpp
#include <hip/hip_runtime.h>
#include <math.h>
#include <stdint.h>
#include <cstdio>

#ifndef MODE
#define MODE 1
#endif

typedef unsigned short bf16_t;
constexpr int NB_ = 4, S_ = 4096, D_ = 1024, T_ = NB_ * S_;
constexpr int DIN = 2560, NH = 8, DH = 64, BLK = 256, NBLK = 16;
constexpr int NE = 32, DFF = 256, DPLE = 256;
constexpr float EPS = 1e-6f;
constexpr size_t MiB = 1u << 20;
constexpr size_t ARR = (size_t)T_ * 512;

__host__ __device__ __forceinline__ unsigned f2bf(float f) { unsigned u = __builtin_bit_cast(unsigned, f); return (u + 0x7fffu + ((u >> 16) & 1u)) >> 16; }
__device__ __forceinline__ float bf2f(unsigned h) { return __uint_as_float(h << 16); }
__device__ __forceinline__ float ldv(const float* p, size_t i) { return p[i]; }
__device__ __forceinline__ float ldv(const bf16_t* p, size_t i) { return bf2f((unsigned)p[i]); }
__device__ __forceinline__ void stv(float* p, size_t i, float v) { p[i] = v; }
__device__ __forceinline__ void stv(bf16_t* p, size_t i, float v) { p[i] = (bf16_t)f2bf(v); }

namespace orc {
__device__ __forceinline__ float gelu_tanh(float x) {
    const float c = 0.7978845608028654f;
    return 0.5f * x * (1.f + tanhf(c * (x + 0.044715f * x * x * x)));
}
__device__ __forceinline__ float sigmoidf_(float x) { return 1.f / (1.f + expf(-x)); }
__device__ __forceinline__ float wave_sum(float v) {
#pragma unroll
    for (int o = 32; o > 0; o >>= 1) v += __shfl_xor(v, o);
    return v;
}
template <class TI>
__global__ void __launch_bounds__(256) k_row_rstd(const TI* __restrict__ x, float* __restrict__ rstd, int nrows, int ncols, int ld, int pad_) {
    const int row = blockIdx.x * 4 + (threadIdx.x >> 6), lane = threadIdx.x & 63;
    if (row >= nrows) return;
    float s = 0.f;
    for (int c = lane; c < ncols; c += 64) { const float v = ldv(x, (size_t)row * ld + c); s += v * v; }
    s = wave_sum(s);
    if (lane == 0) rstd[row] = rsqrtf(s / (float)ncols + EPS);
}
template <class TO>
__global__ void __launch_bounds__(256) k_rownorm_inplace(TO* __restrict__ y, const float* __restrict__ g, int nrows, int ncols, int ld, int c0) {
    const int row = blockIdx.x * 4 + (threadIdx.x >> 6), lane = threadIdx.x & 63;
    if (row >= nrows) return;
    float s = 0.f;
    for (int c = lane; c < ncols; c += 64) { const float v = ldv(y, (size_t)row * ld + c0 + c); s += v * v; }
    s = wave_sum(s);
    const float r = rsqrtf(s / (float)ncols + EPS);
    for (int c = lane; c < ncols; c += 64) { const size_t i = (size_t)row * ld + c0 + c; stv(y, i, ldv(y, i) * r * g[c]); }
}
template <class AL, class BL, class EP>
__global__ void __launch_bounds__(256) k_sgemm(long K, AL al, BL bl, EP ep) {
    __shared__ float As[16][65];
    __shared__ float Bs[16][65];
    const int tx = threadIdx.x & 15, ty = threadIdx.x >> 4;
    const int m0 = blockIdx.y * 64, n0 = blockIdx.x * 64;
    float acc[4][4];
#pragma unroll
    for (int i = 0; i < 4; ++i)
#pragma unroll
        for (int j = 0; j < 4; ++j) acc[i][j] = 0.f;
    for (int k0 = 0; k0 < K; k0 += 16) {
#pragma unroll
        for (int r = 0; r < 4; ++r) { const int i = threadIdx.x + r * 256; const int m = i >> 4, k = i & 15; As[k][m] = al(m0 + m, k0 + k); }
#pragma unroll
        for (int r = 0; r < 4; ++r) { const int i = threadIdx.x + r * 256; const int k = i >> 6, n = i & 63; Bs[k][n] = bl(k0 + k, n0 + n); }
        __syncthreads();
#pragma unroll
        for (int k = 0; k < 16; ++k) {
            float a[4], b[4];
#pragma unroll
            for (int i = 0; i < 4; ++i) a[i] = As[k][ty * 4 + i];
#pragma unroll
            for (int j = 0; j < 4; ++j) b[j] = Bs[k][tx * 4 + j];
#pragma unroll
            for (int i = 0; i < 4; ++i)
#pragma unroll
                for (int j = 0; j < 4; ++j) acc[i][j] += a[i] * b[j];
        }
        __syncthreads();
    }
#pragma unroll
    for (int i = 0; i < 4; ++i)
#pragma unroll
        for (int j = 0; j < 4; ++j) ep(m0 + ty * 4 + i, n0 + tx * 4 + j, acc[i][j]);
}
template <class TI> struct ALScaled { const TI* x; const float* rstd; const float* g; int ld; int pad;
    __device__ float operator()(int m, int k) const { return ldv(x, (size_t)m * ld + k) * rstd[m] * g[k]; } };
template <class TI> struct ALPlain { const TI* x; int ld; int pad;
    __device__ float operator()(int m, int k) const { return ldv(x, (size_t)m * ld + k); } };
struct BLPlain { const float* w; int ld; int pad;
    __device__ float operator()(int k, int n) const { return w[(size_t)k * ld + n]; } };
struct EPStore { float* c; int ld; int pad;
    __device__ void operator()(int m, int n, float v) const { c[(size_t)m * ld + n] = v; } };
struct EPSplit5 { float* a0;
    __device__ void operator()(int m, int n, float v) const { a0[(size_t)(n >> 9) * ARR + (size_t)m * 512 + (n & 511)] = v; } };
struct EPResid { const float* r; float* c; int ld; int pad;
    __device__ void operator()(int m, int n, float v) const { c[(size_t)m * ld + n] = r[(size_t)m * ld + n] + v; } };
template <class TP> struct EPPle { const float* h; const TP* pw; float* c; int ld; int pad;
    __device__ void operator()(int m, int n, float v) const { const size_t i = (size_t)m * ld + n; c[i] = h[i] + ldv(pw, i) * sigmoidf_(v); } };

__global__ void __launch_bounds__(256) k_post_gelu(float* __restrict__ a0) {
    const size_t i = (size_t)blockIdx.x * 256 + threadIdx.x;
    a0[i] = gelu_tanh(a0[i]);
}
__global__ void __launch_bounds__(256) k_qknorm(float* __restrict__ a0, const float* __restrict__ g_q, const float* __restrict__ g_k) {
    const int idx = blockIdx.x * 256 + threadIdx.x;
    if (idx >= T_ * 16) return;
    const int t = idx >> 4, which = (idx >> 3) & 1, h = idx & 7;
    float* p = a0 + (size_t)(2 + which) * ARR + (size_t)t * 512 + h * 64;
    const float* g = which ? g_k : g_q;
    float s = 0.f;
    for (int d = 0; d < 64; ++d) s += p[d] * p[d];
    const float r = rsqrtf(s / 64.f + EPS);
    for (int d = 0; d < 64; ++d) p[d] = p[d] * r * g[d];
}
template <class TI>
__global__ void __launch_bounds__(256) k_va_rstd(const TI* __restrict__ va, float* __restrict__ rstd_va) {
    const int idx = blockIdx.x * 4 + (threadIdx.x >> 6), lane = threadIdx.x & 63;
    const int t = idx >> 2, g = idx & 3;
    float s = 0.f;
    for (int d = lane; d < 128; d += 64) { const float v = ldv(va, (size_t)t * 512 + g * 128 + d); s += v * v; }
    s = wave_sum(s);
    if (lane == 0) rstd_va[idx] = rsqrtf(s / 128.f + EPS);
}
template <class TI, class TO>
__global__ void __launch_bounds__(256) k_mixa(const TI* __restrict__ ua, const TI* __restrict__ va, const float* __restrict__ rstd_va, const float* __restrict__ g_v,
                                              const float* __restrict__ w_s, const float* __restrict__ b_s, TO* __restrict__ ycat) {
    const int bc = blockIdx.x, g = blockIdx.y;
    const int t0 = bc * 128;
    for (int o = threadIdx.x; o < 128 * 128; o += 256) {
        const int tl = o >> 7, d = o & 127;
        float acc = 0.f;
        for (int s = 0; s <= tl; ++s) {
            const float v = ldv(va, (size_t)(t0 + s) * 512 + g * 128 + d) * rstd_va[(t0 + s) * 4 + g] * g_v[g * 128 + d];
            acc += w_s[((size_t)g * 128 + tl) * 128 + s] * v;
        }
        acc += b_s[g * 128 + tl];
        const float u = ldv(ua, (size_t)(t0 + tl) * 512 + g * 128 + d);
        stv(ycat, (size_t)(t0 + tl) * D_ + g * 128 + d, u * acc);
    }
}
template <class TI>
__global__ void __launch_bounds__(256) k_kmean(const TI* __restrict__ kn, float* __restrict__ kmean) {
    const int idx = blockIdx.x * 256 + threadIdx.x;
    if (idx >= NB_ * NH * NBLK * DH) return;
    const int d = idx & 63, n = (idx >> 6) & 15, h = (idx >> 10) & 7, b = idx >> 13;
    float s = 0.f;
    for (int r = 0; r < BLK; ++r) s += ldv(kn, (size_t)(b * S_ + n * BLK + r) * 512 + h * 64 + d);
    kmean[idx] = s / (float)BLK;
}
template <class TI>
__global__ void __launch_bounds__(256) k_gate(const TI* __restrict__ qn, const float* __restrict__ kmean, int* __restrict__ sel) {
    const int idx = blockIdx.x * 256 + threadIdx.x;
    if (idx >= T_ * NH) return;
    const int t = idx >> 3, h = idx & 7, b = t / S_, s = t % S_, qb = s / BLK;
    float v0 = -INFINITY, v1 = -INFINITY, v2 = -INFINITY; int i0 = -1, i1 = -1, i2 = -1;
    for (int n = 0; n < qb; ++n) {
        const float* km = kmean + ((size_t)(b * NH + h) * NBLK + n) * DH;
        float sc = 0.f;
        for (int d = 0; d < 64; ++d) sc += ldv(qn, (size_t)t * 512 + h * 64 + d) * km[d];
        if (sc > v0) { v2 = v1; i2 = i1; v1 = v0; i1 = i0; v0 = sc; i0 = n; }
        else if (sc > v1) { v2 = v1; i2 = i1; v1 = sc; i1 = n; }
        else if (sc > v2) { v2 = sc; i2 = n; }
    }
    sel[idx * 3 + 0] = i0; sel[idx * 3 + 1] = i1; sel[idx * 3 + 2] = i2;
}
template <class TI, class TO>
__global__ void __launch_bounds__(256) k_attn(const TI* __restrict__ qn, const TI* __restrict__ kn, const TI* __restrict__ vb, const int* __restrict__ sel, TO* __restrict__ ycat, int ldo, int coff) {
    __shared__ float qs[64];
    __shared__ float ps[4][256];
    __shared__ float red[4];
    __shared__ float part[4][64];
    const int idx = blockIdx.x;
    const int t = idx >> 3, h = idx & 7, b = t / S_, s = t % S_, qb = s / BLK;
    const int tid = threadIdx.x, lane = tid & 63, wid = tid >> 6;
    if (tid < 64) qs[tid] = ldv(qn, (size_t)t * 512 + h * 64 + tid);
    __syncthreads();
    const int b0 = sel[idx * 3 + 0], b1 = sel[idx * 3 + 1], b2 = sel[idx * 3 + 2], b3 = qb;
    float sc[4];
    float mx = -INFINITY;
#pragma unroll
    for (int j = 0; j < 4; ++j) {
        const int bj = (j == 0) ? b0 : (j == 1) ? b1 : (j == 2) ? b2 : b3;
        sc[j] = -INFINITY;
        if (bj >= 0) {
            const int kpos = bj * BLK + tid;
            if (j < 3 || kpos <= s) {
                float a = 0.f;
                for (int d = 0; d < 64; ++d) a += qs[d] * ldv(kn, (size_t)(b * S_ + kpos) * 512 + h * 64 + d);
                sc[j] = a * 0.125f;
            }
        }
        mx = fmaxf(mx, sc[j]);
    }
#pragma unroll
    for (int o = 32; o > 0; o >>= 1) mx = fmaxf(mx, __shfl_xor(mx, o));
    if (lane == 0) red[wid] = mx;
    __syncthreads();
    mx = fmaxf(fmaxf(red[0], red[1]), fmaxf(red[2], red[3]));
    __syncthreads();
    float sum = 0.f;
#pragma unroll
    for (int j = 0; j < 4; ++j) { const float p = (sc[j] == -INFINITY) ? 0.f : expf(sc[j] - mx); ps[j][tid] = p; sum += p; }
    sum = wave_sum(sum);
    if (lane == 0) red[wid] = sum;
    __syncthreads();
    sum = red[0] + red[1] + red[2] + red[3];
    float o = 0.f;
    {
        const int j = wid;
        const int bj = (j == 0) ? b0 : (j == 1) ? b1 : (j == 2) ? b2 : b3;
        if (bj >= 0) {
            for (int k = 0; k < 256; ++k) {
                const float p = ps[j][k];
                if (p != 0.f) o += p * ldv(vb, (size_t)(b * S_ + bj * BLK + k) * 512 + h * 64 + lane);
            }
        }
    }
    part[wid][lane] = o;
    __syncthreads();
    if (tid < 64) stv(ycat, (size_t)t * ldo + coff + h * 64 + tid, (part[0][tid] + part[1][tid] + part[2][tid] + part[3][tid]) / sum);
}
__global__ void __launch_bounds__(256) k_fill(float* __restrict__ p, float v, int n, int pad_) { const int i = blockIdx.x * 256 + threadIdx.x; if (i < n) p[i] = v; }
struct Route { int e1, e2; float c1, c2; };
__global__ void __launch_bounds__(256) k_route(const float* __restrict__ h, const float* __restrict__ rstd, const float* __restrict__ g,
                                               const float* __restrict__ w_group, const float* __restrict__ w_expert, Route* __restrict__ route) {
    const int t = blockIdx.x * 4 + (threadIdx.x >> 6), lane = threadIdx.x & 63;
    float acc[36];
#pragma unroll
    for (int j = 0; j < 36; ++j) acc[j] = 0.f;
    const float r = rstd[t];
    for (int k = lane; k < D_; k += 64) {
        const float xv = h[(size_t)t * D_ + k] * r * g[k];
#pragma unroll
        for (int j = 0; j < 4; ++j) acc[j] += xv * w_group[k * 4 + j];
#pragma unroll
        for (int j = 0; j < 32; ++j) acc[4 + j] += xv * w_expert[k * 32 + j];
    }
#pragma unroll
    for (int j = 0; j < 36; ++j) acc[j] = wave_sum(acc[j]);
    if (lane == 0) {
        int gs = 0; float gm = acc[0];
#pragma unroll
        for (int j = 1; j < 4; ++j) if (acc[j] > gm) { gm = acc[j]; gs = j; }
        float den = 0.f;
#pragma unroll
        for (int j = 0; j < 4; ++j) den += expf(acc[j] - gm);
        const float pg = 1.f / den;
        float el[8];
#pragma unroll
        for (int j = 0; j < 8; ++j) {
            float v = acc[4 + j];
#pragma unroll
            for (int gg = 1; gg < 4; ++gg) v = (gs == gg) ? acc[4 + gg * 8 + j] : v;
            el[j] = v;
        }
        int a1 = 0; float m1 = el[0];
#pragma unroll
        for (int j = 1; j < 8; ++j) if (el[j] > m1) { m1 = el[j]; a1 = j; }
        int a2 = -1; float m2 = -INFINITY;
#pragma unroll
        for (int j = 0; j < 8; ++j) if (j != a1 && el[j] > m2) { m2 = el[j]; a2 = j; }
        const float e2 = expf(m2 - m1);
        Route rt; rt.e1 = gs * 8 + a1; rt.e2 = gs * 8 + a2; rt.c1 = pg / (1.f + e2); rt.c2 = pg * e2 / (1.f + e2);
        route[t] = rt;
    }
}
__global__ void __launch_bounds__(256) k_moe(const float* __restrict__ h, const float* __restrict__ rstd, const float* __restrict__ g, const Route* __restrict__ route,
                                             const float* __restrict__ wg, const float* __restrict__ wu, const float* __restrict__ wd, float* __restrict__ h2) {
    __shared__ float xs[D_];
    __shared__ float as[DFF];
    const int t = blockIdx.x, tid = threadIdx.x;
    const float r = rstd[t];
    for (int k = tid; k < D_; k += 256) xs[k] = h[(size_t)t * D_ + k] * r * g[k];
    __syncthreads();
    const Route rt = route[t];
    float out[4] = {0.f, 0.f, 0.f, 0.f};
    for (int slot = 0; slot < 2; ++slot) {
        const int e = slot ? rt.e2 : rt.e1; const float cw = slot ? rt.c2 : rt.c1;
        const float* pg_ = wg + (size_t)e * D_ * DFF; const float* pu_ = wu + (size_t)e * D_ * DFF; const float* pd_ = wd + (size_t)e * DFF * D_;
        float hh = 0.f, uu = 0.f;
        for (int k = 0; k < D_; ++k) { const float xv = xs[k]; hh += xv * pg_[(size_t)k * DFF + tid]; uu += xv * pu_[(size_t)k * DFF + tid]; }
        __syncthreads();
        as[tid] = hh * sigmoidf_(hh) * uu * cw;
        __syncthreads();
        for (int f = 0; f < DFF; ++f) {
            const float a = as[f];
#pragma unroll
            for (int i = 0; i < 4; ++i) out[i] += a * pd_[(size_t)f * D_ + tid + 256 * i];
        }
    }
#pragma unroll
    for (int i = 0; i < 4; ++i) h2[(size_t)t * D_ + tid + 256 * i] = h[(size_t)t * D_ + tid + 256 * i] + out[i];
}
}

namespace pg8 {
#define PG8_LAS __attribute__((address_space(3)))
typedef short bf16x8 __attribute__((ext_vector_type(8)));
typedef float f32x4 __attribute__((ext_vector_type(4)));
typedef float f32x2 __attribute__((ext_vector_type(2)));
typedef unsigned u32x4 __attribute__((ext_vector_type(4)));
typedef unsigned u32x2 __attribute__((ext_vector_type(2)));
constexpr int BM = 256, BK = 64, HALF = 128, HTB = HALF * BK * 2, STAGE_BYTES = 8 * HTB, NXCD = 8, WGM = 8;

__host__ __device__ __forceinline__ int lds_byte(int r, int c) { const int st = (r >> 4) * 2 + (c >> 5), rr = r & 15, cc = c & 31, ob = rr * 64 + cc * 2; return st * 1024 + (ob ^ (((ob >> 9) & 1) << 5)); }
__host__ __device__ __forceinline__ void stage_rc(int b, int& R, int& C) { const int st = b / 1024, sb = b % 1024, swz = sb ^ (((sb >> 9) & 1) << 5); R = (st >> 1) * 16 + swz / 64; C = (st & 1) * 32 + (swz % 64) / 2; }
__host__ __device__ __forceinline__ int perm32(int rho) { const int n = rho >> 4, i = rho & 15; return 8 * (i >> 2) + 4 * n + (i & 3); }

struct Unit { int pm, pn, e, aux; };

__device__ __forceinline__ unsigned cvt_pk_bf16(float lo, float hi) { unsigned r; asm volatile("v_cvt_pk_bf16_f32 %0, %1, %2" : "=v"(r) : "v"(lo), "v"(hi)); return r; }

template <bool F8_> struct StaticOrderT {
    static constexpr bool GATHER = false, F8 = F8_;
    const char* A; const char* Bt; int K; int nM, nN, nwg, G, c;
    __device__ void init(const void* A_, const void* Bt_, int M, int N, int K_, int G_, int c_) { A = (const char*)A_; Bt = (const char*)Bt_; K = K_; nM = M / BM; nN = N / BM; nwg = nM * nN; G = G_; c = c_; }
    __device__ bool next(int i, Unit& u) const {
        const long L = (long)i * G + c; if (L >= nwg) return false;
        int wgid = (int)L; { const int q = nwg / NXCD, r = nwg % NXCD, xcd = wgid % NXCD, off = wgid / NXCD; wgid = (xcd < r ? xcd * (q + 1) : r * (q + 1) + (xcd - r) * q) + off; }
        const int nig = WGM * nN, gid = wgid / nig, fm = gid * WGM, gsz = (nM - fm) < WGM ? (nM - fm) : WGM;
        u.pm = fm + ((wgid % nig) % gsz); u.pn = (wgid % nig) / gsz; u.e = 0; u.aux = 0; return true;
    }
    __device__ __forceinline__ const char* a_base(const Unit& u) const { return A + (size_t)u.pm * BM * K * (F8_ ? 1 : 2); }
    __device__ __forceinline__ const char* b_base(const Unit& u) const { return Bt + (size_t)u.pn * BM * K * (F8_ ? 1 : 2); }
    __device__ __forceinline__ const char* a_root() const { return A; }
    __device__ __forceinline__ const char* b_root() const { return Bt; }
    __device__ __forceinline__ int row(const Unit&, int r) const { return r; }
    __device__ __forceinline__ void a_ready(const Unit&) const {}
    __device__ __forceinline__ void done(const Unit&) const {}
};

typedef StaticOrderT<false> StaticOrder;
typedef int v8i __attribute__((ext_vector_type(8)));
template <class Epi, class Sched, bool ALIGN_EPI>
__device__ __forceinline__ void gemm_phase(PG8_LAS unsigned char* lds, const int K, const Sched& S, const Epi& E) {
    int tid_o = threadIdx.x; asm volatile("" : "+v"(tid_o));
    const int tid = tid_o, wid = __builtin_amdgcn_readfirstlane(tid >> 6), lane = tid & 63, wr = wid >> 2, wc = wid & 3, fr = lane & 15, fq = lane >> 4;
    constexpr bool F8 = Sched::F8;
    const int RB = F8 ? K : 2 * K;
    int nt = RB / 128;
    if constexpr (F8) asm volatile("" : "+s"(nt));
    unsigned voffB[2]; unsigned cv0[2], cv1[2], nv0[2], nv1[2];
    const unsigned kstep = (unsigned)(BK * 2);
    const unsigned hstep = (unsigned)(HALF * RB);
    const char* rootA = S.a_root(); const char* rootB = S.b_root();
    const __amdgpu_buffer_rsrc_t rsA = __builtin_amdgcn_make_buffer_rsrc((void*)rootA, 0, 0x7fffffff, 0x00020000), rsB = __builtin_amdgcn_make_buffer_rsrc((void*)rootB, 0, 0x7fffffff, 0x00020000);
    const unsigned ldsw = (unsigned)wid * 1024u;
    const int fc = F8 ? ((fq >> 1) * 32 + (fq & 1) * 16) : fq * 8;
    constexpr int KSTR = F8 ? 16 : 1024;
    const int aoff = lds_byte(wr * 64 + fr, fc), boff = lds_byte(wc * 32 + fr, fc);
#define PG8_SA(b, h) (((b) * 2 + (h)) * HTB)
#define PG8_SB(b, h) ((4 + (b) * 2 + (h)) * HTB)
#define PG8_STAGE_RS(bufoff, RS, soff, voff) do { _Pragma("unroll") for (int _i = 0; _i < 2; ++_i) \
        __builtin_amdgcn_raw_ptr_buffer_load_lds(RS, (PG8_LAS void*)(lds + (bufoff) + ldsw + _i * 8192), 16, (int)(voff)[_i], (int)(soff), 0, 0); } while (0)
#define PG8_STAGE_B(bufoff, soff) PG8_STAGE_RS(bufoff, rsB, soff, voffB)
#define PG8_STAGE(bufoff, soff, voff) PG8_STAGE_RS(bufoff, rsA, soff, voff)
#define PG8_STAGE_A1(bufoff, soff, v0_, v1_) do { if constexpr (Sched::GATHER) { PG8_STAGE(bufoff, soff, v1_); } else { PG8_STAGE(bufoff, (soff) + hstep, v0_); } } while (0)
#define PG8_LDA(dst, b, h) do { _Pragma("unroll") for (int m = 0; m < 4; ++m) _Pragma("unroll") for (int k = 0; k < 2; ++k) dst[m][k] = *(const PG8_LAS bf16x8*)(lds + PG8_SA(b, h) + aoff + m * 2048 + k * KSTR); } while (0)
#define PG8_LDB(dst, b, h) do { _Pragma("unroll") for (int n = 0; n < 2; ++n) _Pragma("unroll") for (int k = 0; k < 2; ++k) dst[n][k] = *(const PG8_LAS bf16x8*)(lds + PG8_SB(b, h) + boff + n * 2048 + k * KSTR); } while (0)
#define PG8_MMA(ai, bj, At, Bt) do { __builtin_amdgcn_s_setprio(1); _Pragma("unroll") for (int m = 0; m < 4; ++m) _Pragma("unroll") for (int n = 0; n < 2; ++n) { \
        if constexpr (F8) { const v8i wa_ = __builtin_bit_cast(v8i, __builtin_shufflevector(Bt[n][0], Bt[n][1], 0, 1, 2, 3, 4, 5, 6, 7, 8, 9, 10, 11, 12, 13, 14, 15)); \
                            const v8i xa_ = __builtin_bit_cast(v8i, __builtin_shufflevector(At[m][0], At[m][1], 0, 1, 2, 3, 4, 5, 6, 7, 8, 9, 10, 11, 12, 13, 14, 15)); \
                            acc[ai][bj][m][n] = __builtin_amdgcn_mfma_scale_f32_16x16x128_f8f6f4(wa_, xa_, acc[ai][bj][m][n], 0, 0, 0, 0x79797979, 0, 0x7b7b7b7b); } \
        else { _Pragma("unroll") for (int k = 0; k < 2; ++k) acc[ai][bj][m][n] = __builtin_amdgcn_mfma_f32_16x16x32_bf16(Bt[n][k], At[m][k], acc[ai][bj][m][n], 0, 0, 0); } } \
        __builtin_amdgcn_s_setprio(0); } while (0)
#define PG8_WAIT_V(n) asm volatile("s_waitcnt vmcnt(" #n ")" ::: "memory")
#define PG8_WAIT_L(n) asm volatile("s_waitcnt lgkmcnt(" #n ")" ::: "memory")
#define PG8_BAR __builtin_amdgcn_s_barrier()
#define PG8_SCHED __builtin_amdgcn_sched_barrier(0)
#define PG8_AOFFS(v0, v1, U) do { _Pragma("unroll") for (int _i = 0; _i < 2; ++_i) { int R_, C_; stage_rc(tid * 16 + _i * 8192, R_, C_); \
        v0[_i] = (unsigned)(S.row(U, R_) * RB + C_ * 2); v1[_i] = (unsigned)(S.row(U, HALF + R_) * RB + C_ * 2); } } while (0)
    Unit cur, nxt; int ui = 0;
    if (!S.next(0, cur)) return;
#pragma unroll
    for (int i = 0; i < 2; ++i) { int R, C; stage_rc(tid * 16 + i * 8192, R, C); const int Rb = Epi::PERM ? ((R & ~31) + perm32(R & 31)) : R; voffB[i] = (unsigned)(Rb * RB + C * 2); }
    PG8_AOFFS(cv0, cv1, cur);
    f32x4 acc[2][2][4][2];
#pragma unroll
    for (int a = 0; a < 2; ++a)
#pragma unroll
        for (int b = 0; b < 2; ++b)
#pragma unroll
            for (int m = 0; m < 4; ++m)
#pragma unroll
                for (int n = 0; n < 2; ++n) acc[a][b][m][n] = (f32x4){0.f, 0.f, 0.f, 0.f};
    bf16x8 At[4][2], B0[2][2], B1[2][2];
    unsigned cA = (unsigned)__builtin_amdgcn_readfirstlane((int)(S.a_base(cur) - rootA)), cB = (unsigned)__builtin_amdgcn_readfirstlane((int)(S.b_base(cur) - rootB));
    S.a_ready(cur);
    PG8_STAGE_B(PG8_SB(0, 0), cB); PG8_STAGE_B(PG8_SB(0, 1), cB + hstep); PG8_STAGE(PG8_SA(0, 0), cA, cv0); PG8_STAGE_A1(PG8_SA(0, 1), cA, cv0, cv1);
    if (wr == 1) PG8_BAR;
    PG8_WAIT_V(2); PG8_BAR;
    PG8_STAGE_B(PG8_SB(1, 0), cB + kstep); PG8_STAGE(PG8_SA(1, 0), cA + kstep, cv0); PG8_STAGE_B(PG8_SB(1, 1), cB + hstep + kstep);
    PG8_WAIT_V(6); PG8_BAR;
    for (;;) {
        const bool has_next = S.next(ui + 1, nxt);
        const unsigned nA = has_next ? (unsigned)__builtin_amdgcn_readfirstlane((int)(S.a_base(nxt) - rootA)) : cA, nB = has_next ? (unsigned)__builtin_amdgcn_readfirstlane((int)(S.b_base(nxt) - rootB)) : cB;
        if constexpr (Sched::GATHER) { if (has_next) { PG8_AOFFS(nv0, nv1, nxt); } else { nv0[0] = cv0[0]; nv0[1] = cv0[1]; nv1[0] = cv1[0]; nv1[1] = cv1[1]; } }
        for (int t = 0; t < nt; t += 2) {
            const bool last = (t == nt - 2);
            const unsigned a1 = cA + (unsigned)(t + 1) * kstep;
            const unsigned a2 = last ? nA : cA + (unsigned)(t + 2) * kstep, b2 = last ? nB : cB + (unsigned)(t + 2) * kstep;
            const unsigned a3 = a2 + kstep, b3 = b2 + kstep;
            unsigned s0[2], s1[2];
            if constexpr (Sched::GATHER) { s0[0] = last ? nv0[0] : cv0[0]; s0[1] = last ? nv0[1] : cv0[1]; s1[0] = last ? nv1[0] : cv1[0]; s1[1] = last ? nv1[1] : cv1[1]; }
            else { s0[0] = cv0[0]; s0[1] = cv0[1]; s1[0] = 0u; s1[1] = 0u; }
            if (last && has_next) S.a_ready(nxt);
            PG8_LDB(B0, 0, 0); PG8_LDB(B1, 0, 1); PG8_SCHED; PG8_LDA(At, 0, 0); PG8_STAGE_A1(PG8_SA(1, 1), a1, cv0, cv1);
            PG8_WAIT_V(8); PG8_WAIT_L(0); PG8_BAR; PG8_MMA(0, 0, At, B0); PG8_MMA(0, 1, At, B1); PG8_BAR; PG8_SCHED;
            PG8_LDA(At, 0, 1); PG8_STAGE_B(PG8_SB(0, 0), b2); PG8_STAGE_B(PG8_SB(0, 1), b2 + hstep); PG8_STAGE(PG8_SA(0, 0), a2, s0);
            PG8_WAIT_V(8); PG8_WAIT_L(0); PG8_BAR; PG8_MMA(1, 0, At, B0); PG8_MMA(1, 1, At, B1); PG8_BAR; PG8_SCHED;
            PG8_LDB(B0, 1, 0); PG8_LDB(B1, 1, 1); PG8_SCHED; PG8_LDA(At, 1, 0); PG8_STAGE_A1(PG8_SA(0, 1), a2, s0, s1);
            PG8_WAIT_V(8); PG8_WAIT_L(0); PG8_BAR; PG8_MMA(0, 0, At, B0); PG8_MMA(0, 1, At, B1); PG8_BAR; PG8_SCHED;
            PG8_LDA(At, 1, 1); PG8_STAGE_B(PG8_SB(1, 0), b3); PG8_STAGE_B(PG8_SB(1, 1), b3 + hstep); PG8_STAGE(PG8_SA(1, 0), a3, s0);
            PG8_WAIT_V(8); PG8_WAIT_L(0); PG8_BAR; PG8_MMA(1, 0, At, B0); PG8_MMA(1, 1, At, B1); PG8_BAR; PG8_SCHED;
        }
        if constexpr (ALIGN_EPI) { if (wr == 0) PG8_BAR; }
        { int l2 = (int)__builtin_amdgcn_mbcnt_hi(~0u, __builtin_amdgcn_mbcnt_lo(~0u, 0u)); asm volatile("" : "+v"(l2)); E(acc, cur, wr, wc, l2 & 15, l2 >> 4); } S.done(cur);
        if (!has_next) break;
#pragma unroll
        for (int a = 0; a < 2; ++a)
#pragma unroll
            for (int b = 0; b < 2; ++b)
#pragma unroll
                for (int m = 0; m < 4; ++m)
#pragma unroll
                    for (int n = 0; n < 2; ++n) acc[a][b][m][n] = (f32x4){0.f, 0.f, 0.f, 0.f};
        cur = nxt; cA = nA; cB = nB; ++ui;
        if constexpr (Sched::GATHER) { cv0[0] = nv0[0]; cv0[1] = nv0[1]; cv1[0] = nv1[0]; cv1[1] = nv1[1]; }
        if constexpr (ALIGN_EPI) { if (wr == 1) PG8_BAR; }
    }
    PG8_WAIT_V(0);
    if constexpr (!ALIGN_EPI) { if (wr == 0) PG8_BAR; }
    PG8_BAR;
#undef PG8_SA
#undef PG8_SB
#undef PG8_STAGE
#undef PG8_STAGE_A1
#undef PG8_STAGE_B
#undef PG8_STAGE_RS
#undef PG8_LDA
#undef PG8_LDB
#undef PG8_MMA
#undef PG8_WAIT_V
#undef PG8_WAIT_L
#undef PG8_BAR
#undef PG8_SCHED
#undef PG8_AOFFS
}
}

#define GAS __attribute__((address_space(1)))
#define LAS __attribute__((address_space(3)))
typedef unsigned v4u __attribute__((ext_vector_type(4)));
typedef unsigned v2u __attribute__((ext_vector_type(2)));
typedef float f32x4 __attribute__((ext_vector_type(4)));
typedef float f32x2 __attribute__((ext_vector_type(2)));
typedef short bf16x8 __attribute__((ext_vector_type(8)));
typedef GAS unsigned gu32;
#define RLX_AGENT __ATOMIC_RELAXED, __HIP_MEMORY_SCOPE_AGENT
#define LDS_WAIT() asm volatile("s_waitcnt lgkmcnt(0)" ::: "memory")
#define VM_WAIT() asm volatile("s_waitcnt vmcnt(0)" ::: "memory")
constexpr int NWAVES = 8;
constexpr int PH_COMB = 4;

constexpr size_t WS_WIN = 0;
constexpr size_t WS_WOUT = 5 * MiB;
constexpr size_t WS_WGU = 7 * MiB;
constexpr size_t WS_WD = 39 * MiB;
constexpr size_t WS_WPLE = 55 * MiB;
constexpr size_t WS_WPG = 56 * MiB;
constexpr size_t WS_XN = 58 * MiB;
constexpr size_t WS_PB = 58 * MiB;
constexpr size_t WS_ARR = 98 * MiB;
constexpr size_t WS_PW = 211 * MiB;
constexpr size_t WS_CTL = 243 * MiB;
constexpr size_t WS_ACC = 244 * MiB;
constexpr size_t ZERO_BYTES = 2 * MiB;
constexpr size_t WS_KMEAN = WS_ACC, WS_SSQ1 = WS_ACC + 128 * 1024, WS_SSQ2 = WS_ACC + 192 * 1024;
constexpr size_t WS_YCAT = 58 * MiB;
constexpr size_t WS_H1B = 90 * MiB;
constexpr size_t WS_A2 = 122 * MiB;
constexpr size_t WS_YS = 142 * MiB;
constexpr size_t WS_H2B = 58 * MiB;
constexpr size_t WS_YA = 178 * MiB;
constexpr size_t WS_LP = 194 * MiB;
constexpr size_t WS_QL = 196 * MiB;
constexpr int CW_QCNT = 8192;
constexpr size_t WS_LTOK = 245 * MiB;
constexpr size_t WS_LSC = 247 * MiB;
constexpr size_t WS_RSTD2 = 251 * MiB;
constexpr size_t WS_WR = 251 * MiB + 512 * 1024;
constexpr size_t WS_ORC = 252 * MiB;
constexpr int CW_CNT = 1024;
constexpr int LCAP = 16384;
constexpr int CW_BAR = 4096;

constexpr int RING_OFF = 0, RING_BYTES = 131072;
constexpr int XTRA_OFF = 131072;
constexpr int LDS_BYTES = 163840;
constexpr int LDSCTL_OFF = LDS_BYTES - 512, MISC_OFF = LDSCTL_OFF + 320;

#define XB_TMO      128
#define XB_XCNT(j)  (256  + 64 * (j))
#define XB_XSUB(j)  (1280 + 64 * (j))
#define XB_XGEN(j)  (2304 + 64 * (j))
#define XB_TOP      3328
#define XB_TOPGEN   3392
#define XCD_BAR_WORDS 3456
#define XB_SPIN_CAP (1u << 18)
__device__ __forceinline__ unsigned xb_ld(unsigned* p)              { return __hip_atomic_load(p, __ATOMIC_RELAXED, __HIP_MEMORY_SCOPE_AGENT); }
__device__ __forceinline__ unsigned xb_add(unsigned* p, unsigned v) { return __hip_atomic_fetch_add(p, v, __ATOMIC_RELAXED, __HIP_MEMORY_SCOPE_AGENT); }
__device__ __forceinline__ unsigned xb_xcc_id() { return (unsigned)__builtin_amdgcn_s_getreg((3 << 11) | 20) & 0xFu; }
#define XB_SPIN(cond, bar) do { unsigned _sp = 0; while (cond) { __builtin_amdgcn_s_sleep(1); \
    if ((++_sp & 255u) == 0u) { if (xb_ld(&(bar)[XB_TMO])) break; if (_sp > XB_SPIN_CAP) { atomicAdd(&(bar)[XB_TMO], 1u); break; } } } } while (0)
struct XcdBarrier { unsigned* bar; unsigned x; volatile LAS unsigned* st; };
__device__ __forceinline__ XcdBarrier xcd_barrier_post(unsigned* bar, volatile LAS unsigned* st) {
    XcdBarrier b; b.bar = bar; b.x = xb_xcc_id(); b.st = st;
    if (threadIdx.x == 0) (void)xb_add(&bar[XB_XCNT(b.x)], 1u);
    return b;
}
__device__ __forceinline__ void xcd_barrier_complete(unsigned* bar, unsigned x, unsigned& nloc, unsigned& nx) {
    const unsigned G = gridDim.x * gridDim.y * gridDim.z;
    unsigned sum, cnt, mine, sp = 0u;
    for (;;) {
        sum = 0u; cnt = 0u; mine = 0u;
#pragma unroll
        for (unsigned j = 0; j < 16; ++j) { const unsigned c = xb_ld(&bar[XB_XCNT(j)]); sum += c; cnt += (c > 0u) ? 1u : 0u; mine = (j == x) ? c : mine; }
        if (sum == G) break;
        __builtin_amdgcn_s_sleep(1);
        if ((++sp & 255u) == 0u) { if (xb_ld(&bar[XB_TMO])) break; if (sp > XB_SPIN_CAP) { atomicAdd(&bar[XB_TMO], 1u); break; } }
    }
    nloc = mine > 0u ? mine : 1u; nx = cnt > 0u ? cnt : 1u;
}
__device__ __forceinline__ void xcd_barrier(const XcdBarrier& b) {
    asm volatile("s_waitcnt vmcnt(0)" ::: "memory");
    __syncthreads();
    if (threadIdx.x == 0) {
        unsigned* bar = b.bar;
        __builtin_amdgcn_s_waitcnt(0);
        unsigned nloc = b.st[0], nx = b.st[1];
        if (nloc == 0u) { xcd_barrier_complete(bar, b.x, nloc, nx); b.st[0] = nloc; b.st[1] = nx; }
        const unsigned old = xb_add(&bar[XB_XSUB(b.x)], 1u);
        const unsigned gen = old / nloc;
        if (old + 1u == (gen + 1u) * nloc) {
            __builtin_amdgcn_fence(__ATOMIC_RELEASE, "agent");
            asm volatile("s_waitcnt vmcnt(0)" ::: "memory");
            const unsigned og = xb_add(&bar[XB_TOP], 1u);
            const unsigned tg = og / nx;
            if (og + 1u == (tg + 1u) * nx) xb_add(&bar[XB_TOPGEN], 1u);
            else XB_SPIN(xb_ld(&bar[XB_TOPGEN]) == tg, bar);
            __builtin_amdgcn_fence(__ATOMIC_ACQUIRE, "agent");
            xb_add(&bar[XB_XGEN(b.x)], 1u);
            asm volatile("s_waitcnt vmcnt(0)" ::: "memory");
        } else {
            XB_SPIN(xb_ld(&bar[XB_XGEN(b.x)]) == gen, bar);
            __builtin_amdgcn_fence(__ATOMIC_ACQUIRE, "agent");
            asm volatile("s_waitcnt vmcnt(0)" ::: "memory");
        }
    }
    __syncthreads();
}

struct Args { const float* in[21]; float* out; unsigned char* ws; int ph_lo, ph_hi, li, pad; };

__device__ __forceinline__ unsigned pk4_fp8(float a, float b, float c, float d) { int w = 0; w = __builtin_amdgcn_cvt_pk_fp8_f32(a, b, w, false); w = __builtin_amdgcn_cvt_pk_fp8_f32(c, d, w, true); return (unsigned)w; }
constexpr bool MOE1_F8 = false;
constexpr float F8_WSCALE = 64.f, F8_ASCALE = 16.f;
__device__ __forceinline__ float gelu_fast(float x) {
    const float z = x * (0.7978845608f + 0.0356774081f * x * x);
    const float e = __builtin_amdgcn_exp2f(-2.885390082f * z);
    return x * __builtin_amdgcn_rcpf(1.f + e);
}
struct EpiInProj {
    static constexpr bool PERM = true;
    bf16_t* arr0; float* kmean; const float* gq; const float* gk; int pn0; int pad_;
    __device__ __forceinline__ void operator()(const pg8::f32x4 (&acc)[2][2][4][2], const pg8::Unit& u_, int wr, int wc, int fr, int fq) const {
        using namespace pg8;
        Unit u = u_; u.pn += pn0;
        const int kind = u.pn >> 1;
        bf16_t* base = arr0 + (size_t)kind * ARR + (size_t)(u.pm * 256 + wr * 64 + fr) * 512 + (u.pn & 1) * 256;
        if (kind == 2 || kind == 3) {
            const float* g = (kind == 2) ? gq : gk;
            f32x4 gv[2][2], ks[2][2];
#pragma unroll
            for (int bj = 0; bj < 2; ++bj)
#pragma unroll
                for (int n = 0; n < 2; ++n) { gv[bj][n] = *(const f32x4*)(g + 32 * bj + 8 * fq + 4 * n); ks[bj][n] = (f32x4){0.f, 0.f, 0.f, 0.f}; }
#pragma unroll
            for (int ai = 0; ai < 2; ++ai)
#pragma unroll
                for (int m = 0; m < 4; ++m) {
                    float ss = 0.f;
#pragma unroll
                    for (int bj = 0; bj < 2; ++bj)
#pragma unroll
                        for (int n = 0; n < 2; ++n) { const f32x4 x = acc[ai][bj][m][n]; ss += (x[0] * x[0] + x[1] * x[1]) + (x[2] * x[2] + x[3] * x[3]); }
                    ss += __shfl_xor(ss, 16); ss += __shfl_xor(ss, 32);
                    const float rs = rsqrtf(ss * (1.f / 64.f) + EPS);
                    bf16_t* rowp = arr0 + (size_t)kind * ARR + ((size_t)((u.pm >> 4) * NH + (u.pn & 1) * 4 + wc) * S_ + (u.pm & 15) * 256 + ai * HALF + wr * 64 + m * 16 + fr) * DH + 8 * fq;
#pragma unroll
                    for (int bj = 0; bj < 2; ++bj) {
                        const f32x4 v0 = acc[ai][bj][m][0] * rs * gv[bj][0], v1 = acc[ai][bj][m][1] * rs * gv[bj][1];
                        ks[bj][0] += v0; ks[bj][1] += v1;
                        u32x4 w; w.x = cvt_pk_bf16(v0[0], v0[1]); w.y = cvt_pk_bf16(v0[2], v0[3]); w.z = cvt_pk_bf16(v1[0], v1[1]); w.w = cvt_pk_bf16(v1[2], v1[3]);
                        *(u32x4*)(rowp + 32 * bj) = w;
                    }
                }
            if (kind == 3) {
                float* km = kmean + ((size_t)((u.pm >> 4) * NH + (u.pn & 1) * 4 + wc) * NBLK + (u.pm & 15)) * DH + 8 * fq;
#pragma unroll
                for (int bj = 0; bj < 2; ++bj)
#pragma unroll
                    for (int n = 0; n < 2; ++n)
#pragma unroll
                        for (int r = 0; r < 4; ++r) {
                            float v = ks[bj][n][r];
                            v += __shfl_xor(v, 1); v += __shfl_xor(v, 2); v += __shfl_xor(v, 4); v += __shfl_xor(v, 8);
                            if (fr == 0) atomicAdd(km + 32 * bj + 4 * n + r, v * (1.f / 256.f));
                        }
            }
        } else {
#pragma unroll
            for (int ai = 0; ai < 2; ++ai)
#pragma unroll
                for (int m = 0; m < 4; ++m) {
                    bf16_t* rowp = base + (size_t)(ai * HALF + m * 16) * 512 + wc * 32 + 8 * fq;
                    const size_t vrow = (size_t)(u.pm & 15) * 256 + ai * HALF + wr * 64 + m * 16 + fr;
#pragma unroll
                    for (int bj = 0; bj < 2; ++bj) {
                        f32x4 v0 = acc[ai][bj][m][0], v1 = acc[ai][bj][m][1];
                        if (kind <= 1) {
#pragma unroll
                            for (int r = 0; r < 4; ++r) { v0[r] = gelu_fast(v0[r]); v1[r] = gelu_fast(v1[r]); }
                        }
                        u32x4 w; w.x = cvt_pk_bf16(v0[0], v0[1]); w.y = cvt_pk_bf16(v0[2], v0[3]); w.z = cvt_pk_bf16(v1[0], v1[1]); w.w = cvt_pk_bf16(v1[2], v1[3]);
                        if (kind == 4) *(u32x4*)(arr0 + (size_t)4 * ARR + ((size_t)((u.pm >> 4) * NH + (u.pn & 1) * 4 + 2 * bj + (wc >> 1)) * S_ + vrow) * DH + (wc & 1) * 32 + 8 * fq) = w;
                        else *(u32x4*)(rowp + bj * HALF) = w;
                    }
                }
        }
    }
};
struct EpiBf16Plain {
    static constexpr bool PERM = true;
    bf16_t* O; int ldc;
    __device__ __forceinline__ void operator()(const pg8::f32x4 (&acc)[2][2][4][2], const pg8::Unit& u, int wr, int wc, int fr, int fq) const {
        using namespace pg8;
        bf16_t* base = O + (size_t)(u.pm * 256 + wr * 64 + fr) * ldc + u.pn * 256 + wc * 32 + 8 * fq;
#pragma unroll
        for (int ai = 0; ai < 2; ++ai)
#pragma unroll
            for (int m = 0; m < 4; ++m) {
                bf16_t* rowp = base + (size_t)(ai * HALF + m * 16) * ldc;
#pragma unroll
                for (int bj = 0; bj < 2; ++bj) {
                    const f32x4 v0 = acc[ai][bj][m][0], v1 = acc[ai][bj][m][1];
                    u32x4 w; w.x = cvt_pk_bf16(v0[0], v0[1]); w.y = cvt_pk_bf16(v0[2], v0[3]); w.z = cvt_pk_bf16(v1[0], v1[1]); w.w = cvt_pk_bf16(v1[2], v1[3]);
                    *(u32x4*)(rowp + bj * HALF) = w;
                }
            }
    }
};

struct EpiOutProj {
    static constexpr bool PERM = true;
    const float* x; bf16_t* h1b; float* ssq; unsigned char* h1f8;
    __device__ __forceinline__ void operator()(const pg8::f32x4 (&acc)[2][2][4][2], const pg8::Unit& u, int wr, int wc, int fr, int fq) const {
        using namespace pg8;
        const int row0 = u.pm * 256 + wr * 64 + fr, col0 = u.pn * 256 + wc * 32 + 8 * fq;
#pragma unroll
        for (int ai = 0; ai < 2; ++ai)
#pragma unroll
            for (int m = 0; m < 4; ++m) {
                const int row = row0 + ai * HALF + m * 16; const size_t off = (size_t)row * D_ + col0;
                float ss = 0.f;
#pragma unroll
                for (int bj = 0; bj < 2; ++bj) {
                    const f32x4 x0 = *(const f32x4*)(x + off + bj * HALF), x1 = *(const f32x4*)(x + off + bj * HALF + 4);
                    const f32x4 v0 = acc[ai][bj][m][0] + x0, v1 = acc[ai][bj][m][1] + x1;
                    u32x4 w; w.x = cvt_pk_bf16(v0[0], v0[1]); w.y = cvt_pk_bf16(v0[2], v0[3]); w.z = cvt_pk_bf16(v1[0], v1[1]); w.w = cvt_pk_bf16(v1[2], v1[3]);
                    *(u32x4*)(h1b + off + bj * HALF) = w;
                    if (MOE1_F8) { u32x2 q; q.x = pk4_fp8(v0[0] * F8_ASCALE, v0[1] * F8_ASCALE, v0[2] * F8_ASCALE, v0[3] * F8_ASCALE); q.y = pk4_fp8(v1[0] * F8_ASCALE, v1[1] * F8_ASCALE, v1[2] * F8_ASCALE, v1[3] * F8_ASCALE); *(u32x2*)(h1f8 + off + bj * HALF) = q; }
                    ss += (v0[0] * v0[0] + v0[1] * v0[1]) + (v0[2] * v0[2] + v0[3] * v0[3]) + (v1[0] * v1[0] + v1[1] * v1[1]) + (v1[2] * v1[2] + v1[3] * v1[3]);
                }
                ss += __shfl_xor(ss, 16); ss += __shfl_xor(ss, 32);
                if (fq == 0) atomicAdd(ssq + row, ss);
                if (m & 1) asm volatile("" ::: "memory");
            }
    }
};
struct EpiPleGate {
    static constexpr bool PERM = true;
    float* out; const bf16_t* pw; const float* rstd2; const bf16_t* h2b;
    __device__ __forceinline__ void operator()(const pg8::f32x4 (&acc)[2][2][4][2], const pg8::Unit& u, int wr, int wc, int fr, int fq) const {
        using namespace pg8;
        const int row0 = u.pm * 256 + wr * 64 + fr, col0 = u.pn * 256 + wc * 32 + 8 * fq;
#pragma unroll
        for (int ai = 0; ai < 2; ++ai)
#pragma unroll
            for (int m = 0; m < 4; ++m) {
                const int row = row0 + ai * HALF + m * 16; const size_t off = (size_t)row * D_ + col0;
                const float rs = rstd2[row] * -1.4426950408889634f;
#pragma unroll
                for (int bj = 0; bj < 2; ++bj) {
                    const u32x4 hv = *(const u32x4*)(h2b + off + bj * HALF);
                    const u32x4 pv = *(const u32x4*)(pw + off + bj * HALF);
                    f32x4 v0, v1;
#pragma unroll
                    for (int r = 0; r < 4; ++r) {
                        const unsigned pw0 = (r & 1) ? (pv[r >> 1] & 0xffff0000u) : (pv[r >> 1] << 16);
                        const unsigned pw1 = (r & 1) ? (pv[2 + (r >> 1)] & 0xffff0000u) : (pv[2 + (r >> 1)] << 16);
                        const float s0 = __builtin_amdgcn_rcpf(1.f + __builtin_amdgcn_exp2f(acc[ai][bj][m][0][r] * rs));
                        const float s1 = __builtin_amdgcn_rcpf(1.f + __builtin_amdgcn_exp2f(acc[ai][bj][m][1][r] * rs));
                        const unsigned hw0 = (r & 1) ? (hv[r >> 1] & 0xffff0000u) : (hv[r >> 1] << 16);
                        const unsigned hw1 = (r & 1) ? (hv[2 + (r >> 1)] & 0xffff0000u) : (hv[2 + (r >> 1)] << 16);
                        v0[r] = __uint_as_float(hw0) + __uint_as_float(pw0) * s0; v1[r] = __uint_as_float(hw1) + __uint_as_float(pw1) * s1;
                    }
                    *(f32x4*)(out + off + bj * HALF) = v0; *(f32x4*)(out + off + bj * HALF + 4) = v1;
                }
                if (m & 1) asm volatile("" ::: "memory");
            }
    }
};
struct MoeOrder1 {
    static constexpr bool GATHER = true, F8 = MOE1_F8;
    const char* A; const char* Bt; const unsigned* ltok; const LAS int* pref; int G, c, Lbeg, Lend;
    __device__ bool next(int i, pg8::Unit& u) const {
        const int L = Lbeg + i * G + c;
        if (c < 0 || L >= Lend) return false;
        const int tile = L >> 1; int e = 0;
#pragma unroll 1
        for (int j = 16; j > 0; j >>= 1) if (pref[e + j] <= tile) e += j;
        const int rt = tile - pref[e]; const int valid = min(256, pref[33 + e] - rt * 256);
        u.pm = tile; u.pn = L & 1; u.e = e; u.aux = valid | (rt << 16); return true;
    }
    __device__ __forceinline__ const char* a_base(const pg8::Unit&) const { return A; }
    __device__ __forceinline__ const char* b_base(const pg8::Unit& u) const { return Bt + ((size_t)u.e * 512 + u.pn * 256) * 1024 * (MOE1_F8 ? 1 : 2); }
    __device__ __forceinline__ const char* a_root() const { return A; }
    __device__ __forceinline__ const char* b_root() const { return Bt; }
    __device__ __forceinline__ int row(const pg8::Unit& u, int r) const { const int valid = u.aux & 0xffff ? (u.aux & 0xffff) : 256; const int rr = r < valid ? r : valid - 1;
        return (int)(ltok[(size_t)u.e * LCAP + (u.aux >> 16) * 256 + rr] & 0x3fffu); }
    __device__ __forceinline__ void a_ready(const pg8::Unit&) const {}
    __device__ __forceinline__ void done(const pg8::Unit&) const {}
};
struct MoeOrder2 {
    static constexpr bool GATHER = false, F8 = false;
    const char* A; const char* Bt; const LAS int* pref; int G, c, Lbeg, Lend;
    __device__ bool next(int i, pg8::Unit& u) const {
        const int L = Lbeg + i * G + c;
        if (c < 0 || L >= Lend) return false;
        const int tile = L >> 2; int e = 0;
#pragma unroll 1
        for (int j = 16; j > 0; j >>= 1) if (pref[e + j] <= tile) e += j;
        const int rt = tile - pref[e]; const int valid = min(256, pref[33 + e] - rt * 256);
        u.pm = tile; u.pn = L & 3; u.e = e; u.aux = valid | (rt << 16); return true;
    }
    __device__ __forceinline__ const char* a_base(const pg8::Unit& u) const { return A + (size_t)u.pm * 256 * 256 * 2; }
    __device__ __forceinline__ const char* b_base(const pg8::Unit& u) const { return Bt + ((size_t)u.e * 1024 + u.pn * 256) * 256 * 2; }
    __device__ __forceinline__ const char* a_root() const { return A; }
    __device__ __forceinline__ const char* b_root() const { return Bt; }
    __device__ __forceinline__ int row(const pg8::Unit&, int r) const { return r; }
    __device__ __forceinline__ void a_ready(const pg8::Unit&) const {}
    __device__ __forceinline__ void done(const pg8::Unit&) const {}
};
struct EpiMoe1 {
    static constexpr bool PERM = true;
    bf16_t* a2; const f32x2* lsc;
    __device__ __forceinline__ void operator()(const pg8::f32x4 (&acc)[2][2][4][2], const pg8::Unit& u, int wr, int wc, int fr, int fq) const {
        using namespace pg8;
        const int rt = u.aux >> 16;
#pragma unroll
        for (int ai = 0; ai < 2; ++ai)
#pragma unroll
            for (int m = 0; m < 4; ++m) {
                const int rl = ai * HALF + wr * 64 + m * 16 + fr;
                const f32x2 sc = lsc[(size_t)u.e * LCAP + rt * 256 + rl];
                const float rs = sc.x, cw = sc.y * sc.x;
                f32x4 o0, o1;
#pragma unroll
                for (int r = 0; r < 4; ++r) {
                    const float g0 = acc[ai][0][m][0][r] * rs, g1 = acc[ai][0][m][1][r] * rs;
                    o0[r] = g0 * __builtin_amdgcn_rcpf(1.f + __builtin_amdgcn_exp2f(-1.4426950408889634f * g0)) * acc[ai][1][m][0][r] * cw;
                    o1[r] = g1 * __builtin_amdgcn_rcpf(1.f + __builtin_amdgcn_exp2f(-1.4426950408889634f * g1)) * acc[ai][1][m][1][r] * cw;
                }
                u32x4 w; w.x = cvt_pk_bf16(o0[0], o0[1]); w.y = cvt_pk_bf16(o0[2], o0[3]); w.z = cvt_pk_bf16(o1[0], o1[1]); w.w = cvt_pk_bf16(o1[2], o1[3]);
                *(u32x4*)(a2 + ((size_t)u.pm * 256 + rl) * 256 + u.pn * 128 + wc * 32 + 8 * fq) = w;
            }
    }
};
struct EpiMoe2 {
    static constexpr bool PERM = true;
    bf16_t* ys; const unsigned* ltok;
    __device__ __forceinline__ void operator()(const pg8::f32x4 (&acc)[2][2][4][2], const pg8::Unit& u, int wr, int wc, int fr, int fq) const {
        using namespace pg8;
        const int rt = u.aux >> 16, valid = u.aux & 0xffff;
#pragma unroll
        for (int ai = 0; ai < 2; ++ai)
#pragma unroll
            for (int m = 0; m < 4; ++m) {
                const int rl = ai * HALF + wr * 64 + m * 16 + fr;
                if (rl < valid) {
                    const unsigned ts = ltok[(size_t)u.e * LCAP + rt * 256 + rl];
                    bf16_t* rowp = ys + ((size_t)(ts >> 16) * T_ + (ts & 0x3fffu)) * D_ + u.pn * 256 + wc * 32 + 8 * fq;
#pragma unroll
                    for (int bj = 0; bj < 2; ++bj) {
                        const f32x4 v0 = acc[ai][bj][m][0], v1 = acc[ai][bj][m][1];
                        u32x4 w; w.x = cvt_pk_bf16(v0[0], v0[1]); w.y = cvt_pk_bf16(v0[2], v0[3]); w.z = cvt_pk_bf16(v1[0], v1[1]); w.w = cvt_pk_bf16(v1[2], v1[3]);
                        *(u32x4*)(rowp + bj * HALF) = w;
                    }
                }
            }
    }
};

__device__ __forceinline__ float wave_sum_x(float v) {
#pragma unroll
    for (int o = 1; o < 64; o <<= 1) v += __shfl_xor(v, o);
    return v;
}
__device__ __forceinline__ unsigned pk2(float lo, float hi) { return f2bf(lo) | (f2bf(hi) << 16); }
__device__ __forceinline__ void p0_transpose_item(const float* W, int K, int N, bf16_t* WT, const float* gain, int mapmode, LAS float* scr, int item, int lane) {
    const int nblk = N / 32, kb = item / nblk, nb = item % nblk, k0 = 64 * kb, n0 = 32 * nb;
#pragma unroll 8
    for (int i = 0; i < 32; ++i) { const int kk = 2 * i + (lane >> 5); float v = W[(size_t)(k0 + kk) * N + n0 + (lane & 31)]; if (gain) v *= gain[k0 + kk]; scr[kk * 33 + (lane & 31)] = v; }
    LDS_WAIT(); asm volatile("" ::: "memory");
    int r0 = n0;
    if (mapmode == 1) { if (n0 >= 1024 && n0 < 2048) { const int cc = n0 & 255; r0 = (n0 & ~255) + 128 * ((cc >> 5) & 1) + 32 * (cc >> 6); } }
    else if (mapmode == 2) r0 = (n0 >> 7) * 256 + (n0 & 127);
    else if (mapmode == 3) r0 = (n0 >> 7) * 256 + 128 + (n0 & 127);
    const int c = lane & 7;
#pragma unroll
    for (int j = 0; j < 4; ++j) { const int n = (lane >> 3) + 8 * j; const LAS float* s = scr + (8 * c) * 33 + n;
        v4u o; o.x = pk2(s[0 * 33], s[1 * 33]); o.y = pk2(s[2 * 33], s[3 * 33]); o.z = pk2(s[4 * 33], s[5 * 33]); o.w = pk2(s[6 * 33], s[7 * 33]);
        *(GAS v4u*)(WT + (size_t)(r0 + n) * K + k0 + 8 * c) = o; }
    LDS_WAIT(); asm volatile("" ::: "memory");
}

typedef short s16x4 __attribute__((ext_vector_type(4)));
__device__ __forceinline__ s16x4 lds_tr16(LAS const void* p) { return __builtin_bit_cast(s16x4, __builtin_amdgcn_ds_read_tr16_b64_v4i16((LAS s16x4*)p)); }
typedef float f32x2_t __attribute__((ext_vector_type(2))); typedef __bf16 bf16x2_t __attribute__((ext_vector_type(2)));
__device__ __forceinline__ unsigned cvt_pk(float lo, float hi) { f32x2_t v = {lo, hi}; bf16x2_t b = __builtin_convertvector(v, bf16x2_t); return __builtin_bit_cast(unsigned, b); }

constexpr int MA_WS_STRIDE = 136, MA_VS_STRIDE = 144, MA_VS_OFF = 128 * MA_WS_STRIDE * 2;
__device__ __forceinline__ void mixa_load_w(LAS unsigned char* lds, const float* wsg, int tid) {
    for (int i = tid; i < 128 * 16; i += NWAVES * 64) {
        const int t = i >> 4, c = i & 15;
        const f32x4 a = *(const f32x4*)(wsg + t * 128 + 8 * c), b = *(const f32x4*)(wsg + t * 128 + 8 * c + 4);
        float v[8] = {a.x, a.y, a.z, a.w, b.x, b.y, b.z, b.w};
#pragma unroll
        for (int j = 0; j < 8; ++j) if (8 * c + j > t) v[j] = 0.f;
        v4u o; o.x = pk2(v[0], v[1]); o.y = pk2(v[2], v[3]); o.z = pk2(v[4], v[5]); o.w = pk2(v[6], v[7]);
        *(LAS v4u*)(lds + (t * MA_WS_STRIDE + 8 * c) * 2) = o;
    }
}
__device__ __forceinline__ void mixa_unit(LAS unsigned char* lds, int u, const bf16_t* UA, const bf16_t* VA, const float* g_v, const float* b_s, bf16_t* YA, int tid, int lane, int wave) {
    const int g = u & 3, bn = u >> 2, t0 = bn * 128, c0 = g * 128;
    const int fr = lane & 15, fq = lane >> 4;
    v4u vraw[4];
#pragma unroll
    for (int i = 0; i < 4; ++i) vraw[i] = *(const GAS v4u*)(VA + (size_t)(t0 + (tid >> 4) + 32 * i) * 512 + c0 + 8 * (tid & 15));
    v2u ur[8]; float bias[8];
#pragma unroll
    for (int j = 0; j < 8; ++j) { const int t = 16 * j + fr; ur[j] = *(const GAS v2u*)(UA + (size_t)(t0 + t) * 512 + c0 + 16 * wave + 4 * fq); bias[j] = b_s[g * 128 + t]; }
    const f32x4 gv = *(const f32x4*)(g_v + c0 + 16 * wave + 4 * fq);
#pragma unroll
    for (int i = 0; i < 4; ++i) {
        const int s_ = (tid >> 4) + 32 * i, c = tid & 15;
        const v4u raw = vraw[i];
        float v[8];
#pragma unroll
        for (int j = 0; j < 4; ++j) { v[2 * j] = __uint_as_float(raw[j] << 16); v[2 * j + 1] = __uint_as_float(raw[j] & 0xffff0000u); }
        float ss = 0.f;
#pragma unroll
        for (int j = 0; j < 8; ++j) ss += v[j] * v[j];
        ss += __shfl_xor(ss, 1); ss += __shfl_xor(ss, 2); ss += __shfl_xor(ss, 4); ss += __shfl_xor(ss, 8);
        const float rs = rsqrtf(ss * (1.f / 128.f) + EPS);
        v4u o; o.x = pk2(v[0] * rs, v[1] * rs); o.y = pk2(v[2] * rs, v[3] * rs); o.z = pk2(v[4] * rs, v[5] * rs); o.w = pk2(v[6] * rs, v[7] * rs);
        *(LAS v4u*)(lds + MA_VS_OFF + (s_ * MA_VS_STRIDE + 8 * c) * 2) = o;
    }
    LDS_WAIT(); __syncthreads();
    bf16x8 vf[4];
#pragma unroll
    for (int ks = 0; ks < 4; ++ks) {
        LAS const unsigned char* p = lds + MA_VS_OFF + ((32 * ks + 8 * fq + (fr >> 2)) * MA_VS_STRIDE + 16 * wave + 4 * (lane & 3)) * 2;
        const s16x4 lo = lds_tr16(p), hi = lds_tr16(p + 4 * MA_VS_STRIDE * 2);
        vf[ks] = (bf16x8){lo[0], lo[1], lo[2], lo[3], hi[0], hi[1], hi[2], hi[3]};
    }
#pragma unroll
    for (int j = 0; j < 8; ++j) {
        f32x4 acc = {0.f, 0.f, 0.f, 0.f};
#pragma unroll
        for (int ks = 0; ks < 4; ++ks) if (ks <= (j >> 1)) {
            const bf16x8 wf = *(const LAS bf16x8*)(lds + ((16 * j + fr) * MA_WS_STRIDE + 32 * ks + 8 * fq) * 2);
            acc = __builtin_amdgcn_mfma_f32_16x16x32_bf16(vf[ks], wf, acc, 0, 0, 0);
        }
        const int t = 16 * j + fr;
        const size_t off = (size_t)(t0 + t) * 512 + c0 + 16 * wave + 4 * fq;
        v2u o;
        o.x = pk2(__uint_as_float(ur[j].x << 16) * (acc[0] * gv[0] + bias[j]), __uint_as_float(ur[j].x & 0xffff0000u) * (acc[1] * gv[1] + bias[j]));
        o.y = pk2(__uint_as_float(ur[j].y << 16) * (acc[2] * gv[2] + bias[j]), __uint_as_float(ur[j].y & 0xffff0000u) * (acc[3] * gv[3] + bias[j]));
        *(GAS v2u*)(YA + off) = o;
    }
    LDS_WAIT(); __syncthreads();
}

__device__ __forceinline__ void combine_row(int m, const bf16_t* YA, const bf16_t* OP, const float* LP, const float* g_out_a, const float* g_out_b, bf16_t* YCAT, int lane) {
    const int nsel = min((m & (S_ - 1)) >> 8, 3);
    const int h = lane >> 3;
    float o[8], l = 0.f;
#pragma unroll
    for (int j = 0; j < 8; ++j) o[j] = 0.f;
#pragma unroll
    for (int sl = 0; sl < 4; ++sl) {
        if (sl == 3 || sl < nsel) {
            const v4u raw = *(const GAS v4u*)(OP + ((size_t)sl * T_ + m) * 512 + 8 * lane);
#pragma unroll
            for (int j = 0; j < 4; ++j) { o[2 * j] += __uint_as_float(raw[j] << 16); o[2 * j + 1] += __uint_as_float(raw[j] & 0xffff0000u); }
            l += LP[((size_t)sl * T_ + m) * 8 + h];
        }
    }
    const float il = 1.f / l;
    float sb = 0.f;
#pragma unroll
    for (int j = 0; j < 8; ++j) { o[j] *= il; sb += o[j] * o[j]; }
    const v4u ar = *(const GAS v4u*)(YA + (size_t)m * 512 + 8 * lane);
    float a[8], sa = 0.f;
#pragma unroll
    for (int j = 0; j < 4; ++j) { a[2 * j] = __uint_as_float(ar[j] << 16); a[2 * j + 1] = __uint_as_float(ar[j] & 0xffff0000u); }
#pragma unroll
    for (int j = 0; j < 8; ++j) sa += a[j] * a[j];
    sa = wave_sum_x(sa); sb = wave_sum_x(sb);
    const float ra = rsqrtf(sa * (1.f / 512.f) + EPS), rb = rsqrtf(sb * (1.f / 512.f) + EPS);
    const f32x4 ga0 = *(const f32x4*)(g_out_a + 8 * lane), ga1 = *(const f32x4*)(g_out_a + 8 * lane + 4);
    const f32x4 gb0 = *(const f32x4*)(g_out_b + 8 * lane), gb1 = *(const f32x4*)(g_out_b + 8 * lane + 4);
    const float qa = ra * F8_ASCALE, qb = rb * F8_ASCALE;
    v2u wa, wb;
    wa.x = pk4_fp8(a[0] * qa * ga0[0], a[1] * qa * ga0[1], a[2] * qa * ga0[2], a[3] * qa * ga0[3]); wa.y = pk4_fp8(a[4] * qa * ga1[0], a[5] * qa * ga1[1], a[6] * qa * ga1[2], a[7] * qa * ga1[3]);
    wb.x = pk4_fp8(o[0] * qb * gb0[0], o[1] * qb * gb0[1], o[2] * qb * gb0[2], o[3] * qb * gb0[3]); wb.y = pk4_fp8(o[4] * qb * gb1[0], o[5] * qb * gb1[1], o[6] * qb * gb1[2], o[7] * qb * gb1[3]);
    *(GAS v2u*)((unsigned char*)YCAT + (size_t)m * D_ + 8 * lane) = wa;
    *(GAS v2u*)((unsigned char*)YCAT + (size_t)m * D_ + 512 + 8 * lane) = wb;
}

__device__ __forceinline__ void gate_task(int task, const bf16_t* QN, const float* KMEAN, unsigned* qcnt, unsigned short* QL, int lane, LAS float* kml  ) {
    const int qq = task & 3; int r = task >> 2; const int i = (r % 15) + 1; r /= 15; const int h = r & 7, b = r >> 3;
    const int s_ = i * 256 + qq * 64 + lane;
    const bf16_t* qp = QN + ((size_t)(b * NH + h) * S_ + s_) * DH;
    float q[64];
#pragma unroll
    for (int c = 0; c < 8; ++c) { const v4u raw = *(const GAS v4u*)(qp + 8 * c);
#pragma unroll
        for (int j = 0; j < 4; ++j) { q[8 * c + 2 * j] = __uint_as_float(raw[j] << 16); q[8 * c + 2 * j + 1] = __uint_as_float(raw[j] & 0xffff0000u); } }
    float v0 = -INFINITY, v1 = -INFINITY, v2 = -INFINITY; int i0 = -1, i1 = -1, i2 = -1;
    const float* kmb = KMEAN + (size_t)((b * NH + h) * NBLK) * DH;
    {
        f32x4 t4[4];
#pragma unroll
        for (int c = 0; c < 4; ++c) t4[c] = *(const GAS f32x4*)(kmb + c * 256 + lane * 4);
#pragma unroll
        for (int c = 0; c < 4; ++c) *(LAS f32x4*)(kml + c * 256 + lane * 4) = t4[c];
        LDS_WAIT(); asm volatile("" ::: "memory");
    }
#pragma unroll 1
    for (int n = 0; n < i; ++n) {
        const LAS float* km = kml + n * DH;
        float sc = 0.f;
#pragma unroll
        for (int d4 = 0; d4 < 16; ++d4) { const f32x4 kv = *(const LAS f32x4*)(km + 4 * d4); sc += q[4 * d4] * kv.x; sc += q[4 * d4 + 1] * kv.y; sc += q[4 * d4 + 2] * kv.z; sc += q[4 * d4 + 3] * kv.w; }
        if (sc > v0) { v2 = v1; i2 = i1; v1 = v0; i1 = i0; v0 = sc; i0 = n; }
        else if (sc > v1) { v2 = v1; i2 = i1; v1 = sc; i1 = n; }
        else if (sc > v2) { v2 = sc; i2 = n; }
    }
    const int lbase = (b * NH + h) * NBLK;
    int mycount = 0, rk0 = 0, rk1 = 0, rk2 = 0;
    const unsigned long long lt = (1ull << lane) - 1ull;
#pragma unroll 1
    for (int n = 0; n < i; ++n) {
        const unsigned long long mask = __ballot((i0 == n) | (i1 == n) | (i2 == n));
        const int below = __popcll(mask & lt);
        if (lane == n) mycount = __popcll(mask);
        if (i0 == n) rk0 = below;
        if (i1 == n) rk1 = below;
        if (i2 == n) rk2 = below;
    }
    unsigned mybase = 0;
    if (lane < i && mycount > 0) mybase = __hip_atomic_fetch_add(qcnt + lbase + lane, (unsigned)mycount, RLX_AGENT);
#pragma unroll
    for (int k = 0; k < 3; ++k) {
        const int sel = (k == 0) ? i0 : (k == 1) ? i1 : i2;
        const int rank = (k == 0) ? rk0 : (k == 1) ? rk1 : rk2;
        const unsigned base = (unsigned)__shfl((int)mybase, sel < 0 ? 0 : sel);
        if (sel >= 0) QL[(size_t)(lbase + sel) * 4096 + base + rank] = (unsigned short)(s_ | (k << 12));
    }
}

constexpr int AT_IPREF = XTRA_OFF + 2048, AT_ICNT = XTRA_OFF + 4352, AT_MYIT = XTRA_OFF + 6400;
__device__ __forceinline__ void attn_stage_tile(LAS unsigned char* dst, const bf16_t* src  , int wave, int lane) {
#pragma unroll
    for (int i = 0; i < 4; ++i) {
        const int key = 8 * (wave * 4 + i) + (lane >> 3), ch = (lane & 7) ^ (key & 7);
        __builtin_amdgcn_global_load_lds((const unsigned*)(src + (size_t)key * DH + ch * 8), (LAS unsigned*)(dst + (wave * 4 + i) * 1024), 16, 0, 0);
    }
}
__device__ __forceinline__ bf16x8 scale_bf16x8(const v4u raw, float c) {
    v4u o;
#pragma unroll
    for (int j = 0; j < 4; ++j) o[j] = cvt_pk(__uint_as_float(raw[j] << 16) * c, __uint_as_float(raw[j] & 0xffff0000u) * c);
    return __builtin_bit_cast(bf16x8, o);
}

template <bool OWN>
__device__ __forceinline__ void attn_item(LAS const unsigned char* Kb, LAS const unsigned char* Vb, const bf16x8 (&qf)[2][2], const float MREF, f32x4 (&O)[4][2], float& lsum0, float& lsum1,
                                          const int fr, const int fq, const int lane, const int ql0, const int ql1) {
    bf16x8 KA[2][2], KB[2][2], VA[4], VB[4], P[2];
    f32x4 SA[2][2], SB[2][2];
    const int kb0 = fr * 128 + ((fq ^ (fr & 7)) << 4), kb1 = fr * 128 + (((4 + fq) ^ (fr & 7)) << 4);
    int vb[4];
    { const int kq = 4 * fq + (fr >> 2);
#pragma unroll
      for (int dt = 0; dt < 4; ++dt) vb[dt] = kq * 128 + (((2 * dt + ((lane & 3) >> 1)) ^ (kq & 7)) << 4) + (lane & 1) * 8; }
    const bf16x8 ones = (bf16x8){0x3f80, 0x3f80, 0x3f80, 0x3f80, 0x3f80, 0x3f80, 0x3f80, 0x3f80};
    f32x4 L0 = {0.f, 0.f, 0.f, 0.f}, L1 = {0.f, 0.f, 0.f, 0.f};
    const int emax0 = OWN ? __builtin_amdgcn_readfirstlane(ql0 >> 5) : 7, emax1 = OWN ? __builtin_amdgcn_readfirstlane(ql1 >> 5) : 7;
#define SBAR() __builtin_amdgcn_sched_barrier(0)
#define LDK(e, KF) do { _Pragma("unroll") for (int kt = 0; kt < 2; ++kt) { \
        KF[kt][0] = *(const LAS bf16x8*)(Kb + kb0 + (32 * (e) + 16 * kt) * 128); KF[kt][1] = *(const LAS bf16x8*)(Kb + kb1 + (32 * (e) + 16 * kt) * 128); } } while (0)
#define MMS(e, KF, S) do { _Pragma("unroll") for (int kt = 0; kt < 2; ++kt) { \
        if (!OWN || (e) <= emax0) { f32x4 a = {-MREF, -MREF, -MREF, -MREF}; a = __builtin_amdgcn_mfma_f32_16x16x32_bf16(KF[kt][0], qf[0][0], a, 0, 0, 0); S[kt][0] = __builtin_amdgcn_mfma_f32_16x16x32_bf16(KF[kt][1], qf[0][1], a, 0, 0, 0); } \
        if (!OWN || (e) <= emax1) { f32x4 a = {-MREF, -MREF, -MREF, -MREF}; a = __builtin_amdgcn_mfma_f32_16x16x32_bf16(KF[kt][0], qf[1][0], a, 0, 0, 0); S[kt][1] = __builtin_amdgcn_mfma_f32_16x16x32_bf16(KF[kt][1], qf[1][1], a, 0, 0, 0); } } } while (0)
#define EXPP1(e, S, qi, QL, EMAX) do { if (!OWN || (e) <= EMAX) { \
        _Pragma("unroll") for (int kt = 0; kt < 2; ++kt) _Pragma("unroll") for (int r = 0; r < 4; ++r) { float x = S[kt][qi][r]; \
            if (OWN) { if (32 * (e) + 16 * kt + 4 * fq + r > QL) x = -INFINITY; } S[kt][qi][r] = __builtin_amdgcn_exp2f(x); } \
        v4u w; w.x = cvt_pk(S[0][qi][0], S[0][qi][1]); w.y = cvt_pk(S[0][qi][2], S[0][qi][3]); w.z = cvt_pk(S[1][qi][0], S[1][qi][1]); w.w = cvt_pk(S[1][qi][2], S[1][qi][3]); P[qi] = __builtin_bit_cast(bf16x8, w); } } while (0)
#define EXPP(e, S) do { EXPP1(e, S, 0, ql0, emax0); EXPP1(e, S, 1, ql1, emax1); } while (0)
#define LDV(e, VF) do { _Pragma("unroll") for (int dt = 0; dt < 4; ++dt) { \
            const s16x4 lo = lds_tr16(Vb + vb[dt] + (32 * (e)) * 128); const s16x4 hi = lds_tr16(Vb + vb[dt] + (32 * (e) + 16) * 128); \
            VF[dt] = (bf16x8){lo[0], lo[1], lo[2], lo[3], hi[0], hi[1], hi[2], hi[3]}; } } while (0)
#define MMV(e, VF) do { if (!OWN || (e) <= emax0) L0 = __builtin_amdgcn_mfma_f32_16x16x32_bf16(ones, P[0], L0, 0, 0, 0); \
        if (!OWN || (e) <= emax1) L1 = __builtin_amdgcn_mfma_f32_16x16x32_bf16(ones, P[1], L1, 0, 0, 0); \
        _Pragma("unroll") for (int dt = 0; dt < 4; ++dt) { \
        if (!OWN || (e) <= emax0) O[dt][0] = __builtin_amdgcn_mfma_f32_16x16x32_bf16(VF[dt], P[0], O[dt][0], 0, 0, 0); \
        if (!OWN || (e) <= emax1) O[dt][1] = __builtin_amdgcn_mfma_f32_16x16x32_bf16(VF[dt], P[1], O[dt][1], 0, 0, 0); } } while (0)
    LDK(0, KA); SBAR();
    LDK(1, KB); SBAR(); MMS(0, KA, SA); SBAR();
    LDK(2, KA); LDV(0, VA); SBAR(); MMS(1, KB, SB); EXPP(0, SA); SBAR();
    LDK(3, KB); LDV(1, VB); SBAR(); MMV(0, VA); MMS(2, KA, SA); EXPP(1, SB); SBAR();
    LDK(4, KA); LDV(2, VA); SBAR(); MMV(1, VB); MMS(3, KB, SB); EXPP(2, SA); SBAR();
    LDK(5, KB); LDV(3, VB); SBAR(); MMV(2, VA); MMS(4, KA, SA); EXPP(3, SB); SBAR();
    LDK(6, KA); LDV(4, VA); SBAR(); MMV(3, VB); MMS(5, KB, SB); EXPP(4, SA); SBAR();
    LDK(7, KB); LDV(5, VB); SBAR(); MMV(4, VA); MMS(6, KA, SA); EXPP(5, SB); SBAR();
    LDV(6, VA); SBAR(); MMV(5, VB); MMS(7, KB, SB); EXPP(6, SA); SBAR();
    LDV(7, VB); SBAR(); MMV(6, VA); EXPP(7, SB); SBAR();
    MMV(7, VB);
#undef SBAR
    lsum0 = L0[0]; lsum1 = L1[0];
#undef LDK
#undef MMS
#undef EXPP1
#undef EXPP
#undef LDV
#undef MMV
}
__device__ __forceinline__ void attn_phase(LAS unsigned char* L, const bf16_t* QN, const bf16_t* KN, const bf16_t* VB, const float* g_q, const float* g_k,
                                           const unsigned* qcnt, const unsigned short* QL, bf16_t* OP, float* LP, bf16_t* DUMMY, int vcu, int G, int tid, int lane, int wave) {
    LAS int* ipref = (LAS int*)(L + AT_IPREF); LAS int* icnt = (LAS int*)(L + AT_ICNT); LAS int* myit = (LAS int*)(L + AT_MYIT);
    {
        const int c = (int)__hip_atomic_load(qcnt + tid, RLX_AGENT);
        const int nit = 1 + ((c + 255) >> 8);
        int incl = nit;
#pragma unroll
        for (int o = 1; o < 64; o <<= 1) { const int v = __shfl_up(incl, o); if (lane >= o) incl += v; }
        icnt[tid] = c;
        if (lane == 63) myit[64 + wave] = incl;
        __syncthreads();
        int woff = 0;
        for (int w = 0; w < wave; ++w) woff += myit[64 + w];
        ipref[tid] = woff + incl - nit;
        if (tid == 511) ipref[512] = woff + incl;
        __syncthreads();
    }
    const int nitems = ipref[512];
    const int nmine = (nitems - vcu + G - 1) / G;
    if (tid < nmine && tid < 64) {
        const int Lx = tid * G + vcu; int t = 0;
#pragma unroll 1
        for (int j = 256; j > 0; j >>= 1) if (ipref[t + j] <= Lx) t += j;
        myit[tid] = (t << 8) | (Lx - ipref[t]);
    }
    __syncthreads();
    float gqm = fabsf(g_q[lane]), gkm = fabsf(g_k[lane]);
#pragma unroll
    for (int o = 1; o < 64; o <<= 1) { gqm = fmaxf(gqm, __shfl_xor(gqm, o)); gkm = fmaxf(gkm, __shfl_xor(gkm, o)); }
    const float MREF = 11.6f * gqm * gkm + 0.125f;
    const float CS = 0.125f * 1.4426950408889634f;
    const int fr = lane & 15, fq = lane >> 4;
    const int nloop = nmine < 64 ? nmine : 64;
    if (nloop <= 0) return;
#define AT_DECODE(itw, E0, E1, V0, V1) do { const int t_ = (itw) >> 8, k_ = (itw) & 255; \
        if (k_ == 0) { int l2_ = lane; asm volatile("" : "+v"(l2_)); const int f2_ = l2_ & 15; E0 = ((t_ & 15) * 256 + 16 * wave + f2_) | (3 << 12); E1 = ((t_ & 15) * 256 + 16 * (15 - wave) + f2_) | (3 << 12); V0 = 1; V1 = 1; } \
        else { const int base_ = (k_ - 1) * 256, nq_ = min(256, icnt[t_] - base_); const int q0 = 32 * wave + fr, q1 = q0 + 16; \
               const unsigned short* ql_ = QL + (size_t)t_ * 4096 + base_; V0 = q0 < nq_; V1 = q1 < nq_; \
               const unsigned short* p0_ = ql_ + (V0 ? q0 : 0); const unsigned short* p1_ = ql_ + (V1 ? q1 : 0); \
               asm volatile("global_load_ushort %0, %1, off" : "=v"(E0) : "v"(p0_) : "memory"); asm volatile("global_load_ushort %0, %1, off" : "=v"(E1) : "v"(p1_) : "memory"); } } while (0)
#define AT_QLOAD(itw, E0, E1, QR) do { const int t_ = (itw) >> 8; const int b_ = t_ >> 7, h_ = (t_ >> 4) & 7; \
        const bf16_t* q0_ = QN + ((size_t)(b_ * NH + h_) * S_ + ((E0) & 0xfff)) * DH + 8 * fq; const bf16_t* q1_ = QN + ((size_t)(b_ * NH + h_) * S_ + ((E1) & 0xfff)) * DH + 8 * fq; \
        const bf16_t* q0b_ = q0_ + 32; const bf16_t* q1b_ = q1_ + 32; \
        asm volatile("global_load_dwordx4 %0, %1, off" : "=v"(QR[0]) : "v"(q0_) : "memory"); asm volatile("global_load_dwordx4 %0, %1, off" : "=v"(QR[1]) : "v"(q0b_) : "memory"); \
        asm volatile("global_load_dwordx4 %0, %1, off" : "=v"(QR[2]) : "v"(q1_) : "memory"); asm volatile("global_load_dwordx4 %0, %1, off" : "=v"(QR[3]) : "v"(q1b_) : "memory"); } while (0)
#define AT_STAGE(itw, bufi) do { const int t_ = (itw) >> 8; const int b_ = t_ >> 7, h_ = (t_ >> 4) & 7, j_ = t_ & 15; const size_t r0_ = ((size_t)(b_ * NH + h_) * S_ + j_ * 256) * DH; \
        attn_stage_tile(L + (bufi) * 65536, KN + r0_, wave, lane); attn_stage_tile(L + (bufi) * 65536 + 32768, VB + r0_, wave, lane); } while (0)
    int it0 = myit[0];
    int ec0, ec1, xl0 = 0, xl1 = 0, vc0, vc1, vn0 = 0, vn1 = 0;
    v4u qn[4];
    AT_STAGE(it0, 0);
    AT_DECODE(it0, ec0, ec1, vc0, vc1);
    asm volatile("s_waitcnt vmcnt(0)" : "+v"(ec0), "+v"(ec1) :: "memory");
    AT_QLOAD(it0, ec0, ec1, qn);
    if (nloop > 1) { const int it1 = myit[1]; AT_DECODE(it1, xl0, xl1, vn0, vn1); }
    f32x4 O[4][2]; float lsum0 = 0.f, lsum1 = 0.f; int pe0 = 0, pe1 = 0, ph_ = 0, pb_ = 0;
    LAS unsigned char* ost = L + XTRA_OFF + 8192 + wave * 2304;
#define AT_STORE_PREV() do { _Pragma("unroll") for (int qi = 0; qi < 2; ++qi) { const int e = qi ? pe1 : pe0; \
            _Pragma("unroll") for (int dt = 0; dt < 4; ++dt) { v2u w; w.x = cvt_pk(O[dt][qi][0], O[dt][qi][1]); w.y = cvt_pk(O[dt][qi][2], O[dt][qi][3]); *(LAS v2u*)(ost + fr * 144 + 32 * dt + 8 * fq) = w; } \
            { const size_t row = (size_t)((e >> 12) & 3) * T_ + (size_t)(pb_ * S_ + (e & 0xfff)); float* lpd = ((e & 0x8000) && fq == 0) ? LP + row * 8 + ph_ : (float*)DUMMY + 1024 + lane; *(GAS float*)lpd = qi ? lsum1 : lsum0; } \
            LDS_WAIT(); asm volatile("" ::: "memory"); \
            _Pragma("unroll") for (int hh = 0; hh < 2; ++hh) { const int rq = (lane >> 3) + 8 * hh; const int er = __shfl(e, rq); \
                const v4u val = *(const LAS v4u*)(ost + rq * 144 + (lane & 7) * 16); \
                const size_t row = (size_t)((er >> 12) & 3) * T_ + (size_t)(pb_ * S_ + (er & 0xfff)); bf16_t* od = (er & 0x8000) ? OP + row * 512 + ph_ * 64 + (lane & 7) * 8 : DUMMY + lane * 8; *(GAS v4u*)od = val; } \
            LDS_WAIT(); asm volatile("" ::: "memory"); } } while (0)
    for (int it = 0; it < nloop; ++it) {
        const int itw = myit[it];
        const int t_ = itw >> 8, own = ((itw & 255) == 0);
        const int h_ = (t_ >> 4) & 7;
        if (it == 0) asm volatile("s_waitcnt vmcnt(0) lgkmcnt(0)" : "+v"(qn[0]), "+v"(qn[1]), "+v"(qn[2]), "+v"(qn[3]), "+v"(xl0), "+v"(xl1) :: "memory");
        else asm volatile("s_waitcnt vmcnt(6) lgkmcnt(0)" : "+v"(qn[0]), "+v"(qn[1]), "+v"(qn[2]), "+v"(qn[3]), "+v"(xl0), "+v"(xl1) :: "memory");
        __builtin_amdgcn_s_barrier(); asm volatile("" ::: "memory");
        const int en0 = xl0, en1 = xl1;
        bf16x8 qf[2][2];
        qf[0][0] = scale_bf16x8(qn[0], CS); qf[0][1] = scale_bf16x8(qn[1], CS); qf[1][0] = scale_bf16x8(qn[2], CS); qf[1][1] = scale_bf16x8(qn[3], CS);
        int vx0 = 0, vx1 = 0;
        if (it + 1 < nloop) {
            const int itn = myit[it + 1];
            AT_STAGE(itn, (it + 1) & 1);
            AT_QLOAD(itn, en0, en1, qn);
            if (it + 2 < nloop) { const int itn2 = myit[it + 2]; AT_DECODE(itn2, xl0, xl1, vx0, vx1); }
        }
        asm volatile("" ::: "memory");
        LAS const unsigned char* Kb = L + (it & 1) * 65536; LAS const unsigned char* Vb = Kb + 32768;
        lsum0 = 0.f; lsum1 = 0.f;
#pragma unroll
        for (int dt = 0; dt < 4; ++dt) { O[dt][0] = (f32x4){0.f, 0.f, 0.f, 0.f}; O[dt][1] = (f32x4){0.f, 0.f, 0.f, 0.f}; }
        const int ql0 = (ec0 & 0xff), ql1 = (ec1 & 0xff);
        if (own) attn_item<true>(Kb, Vb, qf, MREF, O, lsum0, lsum1, fr, fq, lane, ql0, ql1);
        else attn_item<false>(Kb, Vb, qf, MREF, O, lsum0, lsum1, fr, fq, lane, ql0, ql1);
        pe0 = ec0 | (vc0 << 15); pe1 = ec1 | (vc1 << 15); ph_ = h_; pb_ = t_ >> 7;
        AT_STORE_PREV();
        ec0 = en0; ec1 = en1; vc0 = vn0; vc1 = vn1; vn0 = vx0; vn1 = vx1;
    }
    asm volatile("s_waitcnt vmcnt(0) lgkmcnt(0)" ::: "memory"); __builtin_amdgcn_s_barrier();
#undef AT_STORE_PREV
#undef AT_DECODE
#undef AT_QLOAD
#undef AT_STAGE
}

__global__ void __launch_bounds__(NWAVES * 64, 2) mk_fwd(Args args) {
    extern __shared__ __attribute__((aligned(16))) unsigned char lds[];
    LAS unsigned char* L = (LAS unsigned char*)lds;
    volatile LAS unsigned* MISC = (volatile LAS unsigned*)(L + MISC_OFF);
    const int tid = threadIdx.x, lane = tid & 63, wave = __builtin_amdgcn_readfirstlane(tid >> 6);
    const int G = gridDim.x; const int bx = blockIdx.x;
    const int vcu = (G % 8 == 0) ? (bx % 8) * (G / 8) + bx / 8 : bx;
    unsigned char* ws = args.ws;
    gu32* ctl = (gu32*)(ws + WS_CTL);
    const float* x = args.in[0]; const float* p_in = args.in[1]; const float* g_mix = args.in[2]; const float* w_in = args.in[3];
    const float* g_q = args.in[7]; const float* g_k = args.in[8];
    const float* w_out = args.in[11]; const float* g_ffn = args.in[12];
    const float* w_gate_e = args.in[15]; const float* w_up_e = args.in[16]; const float* w_down_e = args.in[17];
    const float* g_ple = args.in[18]; const float* w_ple = args.in[19]; const float* w_ple_gate = args.in[20];
    bf16_t* WIN = (bf16_t*)(ws + WS_WIN); bf16_t* WOUT = (bf16_t*)(ws + WS_WOUT); bf16_t* WGU = (bf16_t*)(ws + WS_WGU); bf16_t* WD = (bf16_t*)(ws + WS_WD);
    bf16_t* WPLE = (bf16_t*)(ws + WS_WPLE); bf16_t* WPG = (bf16_t*)(ws + WS_WPG);
    bf16_t* XN = (bf16_t*)(ws + WS_XN); bf16_t* PB = (bf16_t*)(ws + WS_PB); bf16_t* ARR0 = (bf16_t*)(ws + WS_ARR); bf16_t* PW = (bf16_t*)(ws + WS_PW);
    float* KMEAN = (float*)(ws + WS_KMEAN); float* SSQ1 = (float*)(ws + WS_SSQ1);
    const float* w_group = args.in[13]; const float* w_expert = args.in[14];
    bf16_t* YCAT = (bf16_t*)(ws + WS_YCAT); bf16_t* H1B = (bf16_t*)(ws + WS_H1B); bf16_t* A2 = (bf16_t*)(ws + WS_A2); bf16_t* YS = (bf16_t*)(ws + WS_YS); bf16_t* H2B = (bf16_t*)(ws + WS_H2B);
    unsigned* LTOK = (unsigned*)(ws + WS_LTOK); f32x2* LSC = (f32x2*)(ws + WS_LSC); float* RSTD2 = (float*)(ws + WS_RSTD2); bf16_t* WR = (bf16_t*)(ws + WS_WR);
    float* OUT = args.out;
    unsigned char* WGU8 = (unsigned char*)(ws + WS_WGU); unsigned char* WPG8 = (unsigned char*)(ws + WS_WPG); unsigned char* H1F8 = (unsigned char*)args.out; unsigned char* H2F8 = (unsigned char*)(ws + WS_A2);
    const float* g_v_a = args.in[4]; const float* w_s = args.in[5]; const float* b_s = args.in[6]; const float* g_out_a = args.in[9]; const float* g_out_b = args.in[10];
    unsigned short* QLp = (unsigned short*)(ws + WS_QL);
    bf16_t* YA = (bf16_t*)(ws + WS_YA); bf16_t* OP = (bf16_t*)args.out; float* LP = (float*)(ws + WS_LP);

    for (int u = tid; u < (LDS_BYTES - LDSCTL_OFF) / 4; u += NWAVES * 64) ((LAS unsigned*)(L + LDSCTL_OFF))[u] = 0u;
    __syncthreads();
    const int lo = args.ph_lo, hi = args.ph_hi;
    const bool multi = (hi - lo) > 1;
    XcdBarrier bar; bar.bar = (unsigned*)(ctl + CW_BAR); bar.x = 0; bar.st = nullptr;
    if (multi) bar = xcd_barrier_post((unsigned*)(ctl + CW_BAR), MISC + 8);
#ifdef PROBE_PHASE
    unsigned long long* TS = (unsigned long long*)(ws + WS_ORC);
#define STAMP(k) do { if (bx == 0 && tid == 0) TS[k] = __builtin_amdgcn_s_memrealtime(); } while (0)
#else
#define STAMP(k) do {} while (0)
#endif
#define IN(k) (lo <= (k) && (k) < hi)
#define SEAM(k) do { if (IN(k) && IN((k) + 1)) xcd_barrier(bar); STAMP((k) + 1); } while (0)

    STAMP(0);
    if (IN(0)) {
        const int gw = vcu * NWAVES + wave, NGW = G * NWAVES;
        {
            constexpr int T_IN = 16 * 10, T_OUT = 16 * 4, T_G = 32 * 16, T_U = T_G, T_D = 32 * 16, T_PLE = 4 * 4, T_PG = 16 * 4;
            constexpr int NTILES = T_IN + T_OUT + T_G + T_U + T_D + T_PLE + T_PG;
            constexpr int NTP = 257, TBUF = 64 * NTP * 4;
#define P0_DECODE(itv, SRC, DST, GAIN, KK, NN, K0, N0, MM) do { int r_ = (itv); int tl_ = 0; MM = 0; \
                if (r_ < T_IN) { SRC = w_in; DST = WIN; GAIN = g_mix; KK = 1024; NN = 2560; MM = 1; tl_ = r_; } \
                else if ((r_ -= T_IN) < T_OUT) { SRC = w_out; DST = WOUT; GAIN = nullptr; KK = 1024; NN = 1024; MM = 5; tl_ = r_; } \
                else if ((r_ -= T_OUT) < T_G) { const int e_ = r_ >> 4; SRC = w_gate_e + (size_t)e_ * 1024 * 256; DST = (bf16_t*)(WGU8 + (size_t)e_ * 512 * 1024 * (MOE1_F8 ? 1 : 2)); GAIN = g_ffn; KK = 1024; NN = 256; MM = 2; tl_ = r_ & 15; } \
                else if ((r_ -= T_G) < T_U) { const int e_ = r_ >> 4; SRC = w_up_e + (size_t)e_ * 1024 * 256; DST = (bf16_t*)(WGU8 + (size_t)e_ * 512 * 1024 * (MOE1_F8 ? 1 : 2)); GAIN = g_ffn; KK = 1024; NN = 256; MM = 3; tl_ = r_ & 15; } \
                else if ((r_ -= T_U) < T_D) { const int e_ = r_ >> 4; SRC = w_down_e + (size_t)e_ * 256 * 1024; DST = WD + (size_t)e_ * 1024 * 256; GAIN = nullptr; KK = 256; NN = 1024; tl_ = r_ & 15; } \
                else if ((r_ -= T_D) < T_PLE) { SRC = w_ple; DST = WPLE; GAIN = nullptr; KK = 256; NN = 1024; tl_ = r_; } \
                else { r_ -= T_PLE; SRC = w_ple_gate; DST = (bf16_t*)WPG8; GAIN = g_ple; KK = 1024; NN = 1024; MM = 4; tl_ = r_; } \
                const int nblk_ = NN / 256; K0 = 64 * (tl_ / nblk_); N0 = 256 * (tl_ % nblk_); } while (0)
#define P0_LOAD(SRC, GAIN, NN, K0, N0) do { _Pragma("unroll") for (int i_ = 0; i_ < 8; ++i_) { const int kk_ = 8 * wave + i_; \
                pv[i_] = *(const GAS f32x4*)(SRC + (size_t)(K0 + kk_) * NN + N0 + 4 * lane); pg[i_] = GAIN ? GAIN[K0 + kk_] : 1.f; } } while (0)
            const float* csrc = nullptr; bf16_t* cdst = nullptr; const float* cgain = nullptr; int cK = 0, cN = 0, ck0 = 0, cn0 = 0, cmm = 0;
            f32x4 pv[8]; float pg[8];
            int tl = vcu, pbuf = 0;
            if (tl < NTILES) { P0_DECODE(tl, csrc, cdst, cgain, cK, cN, ck0, cn0, cmm); P0_LOAD(csrc, cgain, cN, ck0, cn0); }
            while (tl < NTILES) {
                LAS float* tb = (LAS float*)(L + pbuf * TBUF);
#pragma unroll
                for (int i = 0; i < 8; ++i) { LAS float* d_ = tb + (8 * wave + i) * NTP + 4 * lane; const f32x4 v = pv[i] * pg[i]; d_[0] = v.x; d_[1] = v.y; d_[2] = v.z; d_[3] = v.w; }
                bf16_t* odst = cdst; const int oK = cK, ok0 = ck0, on0 = cn0, omm = cmm;
                const int tln = tl + G;
                LDS_WAIT(); __syncthreads();
                if (tln < NTILES) { P0_DECODE(tln, csrc, cdst, cgain, cK, cN, ck0, cn0, cmm); P0_LOAD(csrc, cgain, cN, ck0, cn0); }
                asm volatile("" ::: "memory");
                const int kc = lane & 7;
#pragma unroll
                for (int j = 0; j < 4; ++j) {
                    const int c = (tid >> 3) + 64 * j;
                    const LAS float* s_ = tb + (8 * kc) * NTP + c;
                    int drow = on0 + c;
                    if (omm == 1) { if (on0 >= 1024 && on0 < 2048) drow = on0 + 128 * ((c >> 5) & 1) + 32 * (c >> 6) + (c & 31); }
                    else if (omm == 2) drow = (c >> 7) * 256 + (c & 127);
                    else if (omm == 3) drow = (c >> 7) * 256 + 128 + (c & 127);
                    if (omm >= 4 || (MOE1_F8 && omm >= 2)) {
                        v2u o8; o8.x = pk4_fp8(s_[0 * NTP] * F8_WSCALE, s_[1 * NTP] * F8_WSCALE, s_[2 * NTP] * F8_WSCALE, s_[3 * NTP] * F8_WSCALE); o8.y = pk4_fp8(s_[4 * NTP] * F8_WSCALE, s_[5 * NTP] * F8_WSCALE, s_[6 * NTP] * F8_WSCALE, s_[7 * NTP] * F8_WSCALE);
                        *(GAS v2u*)((unsigned char*)odst + (size_t)drow * oK + ok0 + 8 * kc) = o8;
                    } else {
                        v4u o; o.x = pk2(s_[0 * NTP], s_[1 * NTP]); o.y = pk2(s_[2 * NTP], s_[3 * NTP]); o.z = pk2(s_[4 * NTP], s_[5 * NTP]); o.w = pk2(s_[6 * NTP], s_[7 * NTP]);
                        *(GAS v4u*)(odst + (size_t)drow * oK + ok0 + 8 * kc) = o;
                    }
                }
                tl = tln; pbuf ^= 1;
            }
            LDS_WAIT(); __syncthreads();
#undef P0_DECODE
#undef P0_LOAD
        }
        for (int m = gw; m < T_; m += 2 * NGW) {
            const GAS f32x4* xr0 = (const GAS f32x4*)(x + (size_t)m * D_) + lane; const GAS f32x4* xr1 = (const GAS f32x4*)(x + (size_t)(m + NGW) * D_) + lane;
            f32x4 v0[4], v1[4]; float s0 = 0.f, s1 = 0.f;
#pragma unroll
            for (int j = 0; j < 4; ++j) { v0[j] = xr0[64 * j]; v1[j] = xr1[64 * j]; }
#pragma unroll
            for (int j = 0; j < 4; ++j) { s0 += (v0[j].x * v0[j].x + v0[j].y * v0[j].y) + (v0[j].z * v0[j].z + v0[j].w * v0[j].w); s1 += (v1[j].x * v1[j].x + v1[j].y * v1[j].y) + (v1[j].z * v1[j].z + v1[j].w * v1[j].w); }
            const float r0 = rsqrtf(wave_sum_x(s0) * (1.f / D_) + EPS), r1 = rsqrtf(wave_sum_x(s1) * (1.f / D_) + EPS);
            GAS v2u* o0 = (GAS v2u*)(XN + (size_t)m * D_) + lane; GAS v2u* o1 = (GAS v2u*)(XN + (size_t)(m + NGW) * D_) + lane;
#pragma unroll
            for (int j = 0; j < 4; ++j) { v2u w; w.x = pk2(v0[j].x * r0, v0[j].y * r0); w.y = pk2(v0[j].z * r0, v0[j].w * r0); o0[64 * j] = w;
                                          v2u w2; w2.x = pk2(v1[j].x * r1, v1[j].y * r1); w2.y = pk2(v1[j].z * r1, v1[j].w * r1); o1[64 * j] = w2; }
        }
        for (int i = gw * 64 + lane; i < 48 * 1024; i += NGW * 64) {
            const int jj = i >> 10, k = i & 1023; float v = 0.f;
            if (jj < 4) v = w_group[k * 4 + jj] * g_ffn[k];
            else if (jj >= 16) { const int hi = (jj >= 32), g = ((jj - 16) & 15) >> 2, r = jj & 3; v = w_expert[k * 32 + g * 8 + hi * 4 + r] * g_ffn[k]; }
            WR[i] = (bf16_t)f2bf(v);
        }
    }
    SEAM(0);
    if (IN(1)) {
        pg8::StaticOrder S; S.init(XN, WIN, T_, 2048, D_, G, bx);
        EpiInProj E{ARR0, KMEAN, g_q, g_k, 0, 0};
        pg8::gemm_phase<EpiInProj, pg8::StaticOrder, true>(L + RING_OFF, D_, S, E);
    }
    SEAM(1);
    if (IN(2)) {
        const int GH = G >> 1;
        if (bx < GH) {
            pg8::StaticOrder S; S.init(XN, WIN + (size_t)2048 * 1024, T_, 512, D_, GH, bx);
            EpiInProj E{ARR0, KMEAN, g_q, g_k, 8, 0};
            pg8::gemm_phase<EpiInProj, pg8::StaticOrder, true>(L + RING_OFF, D_, S, E);
            { const int u = 384 + bx; mixa_load_w(L + RING_OFF, w_s + (size_t)(u & 3) * 128 * 128, tid); mixa_unit(L + RING_OFF, u, ARR0, ARR0 + ARR, g_v_a, b_s, YA, tid, lane, wave); }
        } else {
            const int c2 = bx - GH, G2 = G - GH;
            { const int gw = c2 * NWAVES + wave, NGW = G2 * NWAVES;
              for (int tk = gw; tk < NB_ * NH * 15 * 4; tk += NGW) { const int task = (tk < NGW) ? tk : (NB_ * NH * 15 * 4 - 1) - (tk - NGW); if (task < NGW && tk >= NGW) continue; gate_task(task, ARR0 + 2 * ARR, KMEAN, (unsigned*)ctl + CW_QCNT, QLp, lane, (LAS float*)(L + RING_OFF + 81920 + wave * 4096)); }
              LDS_WAIT(); }
            int curg = -1;
            for (int u = c2; u < 384; u += G2) {
                const int g = u & 3;
                if (g != curg) { mixa_load_w(L + RING_OFF, w_s + (size_t)g * 128 * 128, tid); curg = g; }
                mixa_unit(L + RING_OFF, u, ARR0, ARR0 + ARR, g_v_a, b_s, YA, tid, lane, wave);
            }
        }
    }
    SEAM(2);
    if (IN(3)) attn_phase(L, ARR0 + 2 * ARR, ARR0 + 3 * ARR, ARR0 + 4 * ARR, g_q, g_k, (const unsigned*)ctl + CW_QCNT, QLp, OP, LP, (bf16_t*)(ws + 200 * MiB), vcu, G, tid, lane, wave);
    SEAM(3);
    if (IN(PH_COMB)) {
        const int gw = vcu * NWAVES + wave, NGW = G * NWAVES;
        for (int m = gw; m < T_; m += NGW) combine_row(m, YA, OP, LP, g_out_a, g_out_b, YCAT, lane);
    }
    SEAM(PH_COMB);
    if (IN(5)) {
        pg8::StaticOrderT<true> S; S.init(YCAT, WOUT, T_, D_, D_, G, bx);
        EpiOutProj E{x, H1B, SSQ1, H1F8};
        pg8::gemm_phase<EpiOutProj, pg8::StaticOrderT<true>, true>(L + RING_OFF, D_, S, E);
    }
    SEAM(5);
    if (IN(6)) {
        { const int gw = vcu * NWAVES + wave, NGW = G * NWAVES;
          for (int m = gw; m < T_; m += NGW) {
              const f32x4 v = ((const GAS f32x4*)(p_in + (size_t)m * DPLE))[lane];
              v2u w; w.x = pk2(v.x, v.y); w.y = pk2(v.z, v.w);
              ((GAS v2u*)(PB + (size_t)m * DPLE))[lane] = w;
          } }
        LAS int* hist = (LAS int*)(L + XTRA_OFF); LAS int* hbase = hist + 32;
        for (int chunk = vcu; chunk < T_ / 64; chunk += G) {
            if (tid < 32) hist[tid] = 0;
            __syncthreads();
            int e1 = -1, e2 = -1, rk1 = 0, rk2 = 0, tok = 0; float c1 = 0.f, c2 = 0.f, rs1 = 0.f;
            LAS float* part = (LAS float*)(L + RING_OFF + 100352);
            {
                const int fr = lane & 15, fq = lane >> 4;
                const int t0 = chunk * 64 + (wave & 3) * 16, kh = wave >> 2;
                f32x4 d0 = {0.f, 0.f, 0.f, 0.f}, d1 = d0, d2 = d0;
                const bf16_t* ap = H1B + (size_t)(t0 + fr) * D_ + 8 * fq + kh * 512;
                bf16x8 hf[16];
#pragma unroll
                for (int ks = 0; ks < 16; ++ks) hf[ks] = *(const bf16x8*)(ap + ks * 32);
                const float ssq_tok = SSQ1[t0 + fr];
#pragma unroll
                for (int i = 0; i < 12; ++i) { const int pc = tid + 512 * i, rr = pc >> 7, cc = pc & 127; *(LAS v4u*)(L + RING_OFF + rr * 2064 + cc * 16) = *(const GAS v4u*)(WR + (size_t)rr * D_ + cc * 8); }
                LDS_WAIT(); __syncthreads();
                LAS const unsigned char* bpl = L + RING_OFF + fr * 2064 + (8 * fq + kh * 512) * 2;
#pragma unroll
                for (int ks = 0; ks < 16; ++ks) {
                    const bf16x8 w0 = *(const LAS bf16x8*)(bpl + ks * 64), w1 = *(const LAS bf16x8*)(bpl + 16 * 2064 + ks * 64), w2 = *(const LAS bf16x8*)(bpl + 32 * 2064 + ks * 64);
                    d0 = __builtin_amdgcn_mfma_f32_16x16x32_bf16(w0, hf[ks], d0, 0, 0, 0);
                    d1 = __builtin_amdgcn_mfma_f32_16x16x32_bf16(w1, hf[ks], d1, 0, 0, 0);
                    d2 = __builtin_amdgcn_mfma_f32_16x16x32_bf16(w2, hf[ks], d2, 0, 0, 0);
                }
                if (kh == 1) {
#pragma unroll
                    for (int r = 0; r < 4; ++r) { part[((wave & 3) * 12 + r) * 64 + lane] = d0[r]; part[((wave & 3) * 12 + 4 + r) * 64 + lane] = d1[r]; part[((wave & 3) * 12 + 8 + r) * 64 + lane] = d2[r]; }
                }
                LDS_WAIT(); __syncthreads();
              if (kh == 0) {
#pragma unroll
                for (int r = 0; r < 4; ++r) { d0[r] += part[(wave * 12 + r) * 64 + lane]; d1[r] += part[(wave * 12 + 4 + r) * 64 + lane]; d2[r] += part[(wave * 12 + 8 + r) * 64 + lane]; }
                tok = t0 + fr;
                rs1 = rsqrtf(ssq_tok * (1.f / D_) + EPS);
                float gl[4];
#pragma unroll
                for (int r = 0; r < 4; ++r) gl[r] = __shfl(d0[r], fr) * rs1;
                int gs = 0; float gm = gl[0];
#pragma unroll
                for (int r = 1; r < 4; ++r) if (gl[r] > gm) { gm = gl[r]; gs = r; }
                float den = 0.f;
#pragma unroll
                for (int r = 0; r < 4; ++r) den += __expf(gl[r] - gm);
                const float pg = 1.f / den;
                float el[8];
#pragma unroll
                for (int r = 0; r < 4; ++r) { el[r] = d1[r] * rs1; el[4 + r] = d2[r] * rs1; }
                int a1 = 0; float m1 = el[0];
#pragma unroll
                for (int j = 1; j < 8; ++j) if (el[j] > m1) { m1 = el[j]; a1 = j; }
                int a2 = -1; float m2 = -INFINITY;
#pragma unroll
                for (int j = 0; j < 8; ++j) if (j != a1 && el[j] > m2) { m2 = el[j]; a2 = j; }
                const float ex2 = __expf(m2 - m1);
                if (fq == gs) {
                    e1 = gs * 8 + a1; e2 = gs * 8 + a2; c1 = pg / (1.f + ex2); c2 = pg * ex2 / (1.f + ex2);
                    rk1 = __hip_atomic_fetch_add(hist + e1, 1, __ATOMIC_RELAXED, __HIP_MEMORY_SCOPE_WORKGROUP);
                    rk2 = __hip_atomic_fetch_add(hist + e2, 1, __ATOMIC_RELAXED, __HIP_MEMORY_SCOPE_WORKGROUP);
                }
              }
            }
            __syncthreads();
            if (tid < 32) { const int hc = hist[tid]; hbase[tid] = hc > 0 ? (int)__hip_atomic_fetch_add((unsigned*)ctl + CW_CNT + 64 * tid, (unsigned)hc, RLX_AGENT) : 0; }
            __syncthreads();
            if (e1 >= 0) {
                const int p1 = hbase[e1] + rk1, p2 = hbase[e2] + rk2;
                LTOK[(size_t)e1 * LCAP + p1] = (unsigned)tok; LSC[(size_t)e1 * LCAP + p1] = (f32x2){rs1, c1};
                LTOK[(size_t)e2 * LCAP + p2] = (unsigned)tok | 0x10000u; LSC[(size_t)e2 * LCAP + p2] = (f32x2){rs1, c2};
            }
            __syncthreads();
        }
    }
    SEAM(6);
    if (IN(7) || IN(8) || IN(9)) {
        LAS int* pref = (LAS int*)(L + XTRA_OFF + 1024);
        __syncthreads();
        if (tid < 32) pref[33 + tid] = (int)__hip_atomic_load((unsigned*)ctl + CW_CNT + 64 * tid, RLX_AGENT);
        __syncthreads();
        if (tid == 0) { int acc_ = 0; for (int e = 0; e < 32; ++e) { pref[e] = acc_; acc_ += (pref[33 + e] + 255) >> 8; } pref[32] = acc_; }
        __syncthreads();
    }
    if (IN(7) || IN(8) || IN(9)) {
        const LAS int* pref = (const LAS int*)(L + XTRA_OFF + 1024);
        const int tot = pref[32], U1 = 2 * tot, first = U1 < G ? U1 : G, rem = U1 - first, T1 = first >> 1;
        if (IN(7)) {
            MoeOrder1 S{MOE1_F8 ? (const char*)H1F8 : (const char*)H1B, (const char*)WGU8, LTOK, pref, G, bx, 0, first};
            EpiMoe1 E{A2, LSC};
            pg8::gemm_phase<EpiMoe1, MoeOrder1, true>(L + RING_OFF, D_, S, E);
        }
        SEAM(7);
        if (IN(8)) {
            if (bx < rem) {
                MoeOrder1 S{MOE1_F8 ? (const char*)H1F8 : (const char*)H1B, (const char*)WGU8, LTOK, pref, rem, bx, first, U1};
                EpiMoe1 E{A2, LSC};
                pg8::gemm_phase<EpiMoe1, MoeOrder1, true>(L + RING_OFF, D_, S, E);
            } else {
                MoeOrder2 S{(const char*)A2, (const char*)WD, pref, G - rem, bx - rem, 0, 4 * T1};
                EpiMoe2 E{YS, LTOK};
                pg8::gemm_phase<EpiMoe2, MoeOrder2, true>(L + RING_OFF, DFF, S, E);
            }
        }
        SEAM(8);
        if (IN(9)) {
            { MoeOrder2 S{(const char*)A2, (const char*)WD, pref, G, bx, 4 * T1, 4 * tot};
              EpiMoe2 E{YS, LTOK};
              pg8::gemm_phase<EpiMoe2, MoeOrder2, true>(L + RING_OFF, DFF, S, E); }
            { pg8::StaticOrder S; S.init(PB, WPLE, T_, D_, DPLE, G, (bx + G / 2) % G);
              EpiBf16Plain E{PW, D_};
              pg8::gemm_phase<EpiBf16Plain, pg8::StaticOrder, true>(L + RING_OFF, DPLE, S, E); }
        }
    }
    SEAM(9);
    if (IN(10)) {
        const int gw = vcu * NWAVES + wave, NGW = G * NWAVES;
        for (int m = gw; m < T_; m += NGW) {
            const GAS v2u* hr = (const GAS v2u*)(H1B + (size_t)m * D_) + lane;
            const GAS v2u* y0 = (const GAS v2u*)(YS + (size_t)m * D_) + lane; const GAS v2u* y1 = (const GAS v2u*)(YS + (size_t)(T_ + m) * D_) + lane;
            GAS v2u* hb = (GAS v2u*)(H2B + (size_t)m * D_) + lane;
            float s = 0.f;
#pragma unroll
            for (int j = 0; j < 4; ++j) {
                const v2u hq = hr[64 * j]; const v2u a = y0[64 * j], b = y1[64 * j];
                f32x4 v; v.x = __uint_as_float(hq.x << 16); v.y = __uint_as_float(hq.x & 0xffff0000u); v.z = __uint_as_float(hq.y << 16); v.w = __uint_as_float(hq.y & 0xffff0000u);
                v.x += __uint_as_float(a.x << 16) + __uint_as_float(b.x << 16); v.y += __uint_as_float(a.x & 0xffff0000u) + __uint_as_float(b.x & 0xffff0000u);
                v.z += __uint_as_float(a.y << 16) + __uint_as_float(b.y << 16); v.w += __uint_as_float(a.y & 0xffff0000u) + __uint_as_float(b.y & 0xffff0000u);
                v2u w; w.x = pk2(v.x, v.y); w.y = pk2(v.z, v.w); hb[64 * j] = w;
                ((GAS unsigned*)(H2F8 + (size_t)m * D_))[lane + 64 * j] = pk4_fp8(v.x * F8_ASCALE, v.y * F8_ASCALE, v.z * F8_ASCALE, v.w * F8_ASCALE);
                s += (v.x * v.x + v.y * v.y) + (v.z * v.z + v.w * v.w);
            }
            s = wave_sum_x(s);
            if (lane == 0) RSTD2[m] = rsqrtf(s * (1.f / D_) + EPS);
        }
    }
    SEAM(10);
    if (IN(11)) {
        pg8::StaticOrderT<true> S; S.init(H2F8, WPG8, T_, D_, D_, G, bx);
        EpiPleGate E{OUT, PW, RSTD2, H2B};
        pg8::gemm_phase<EpiPleGate, pg8::StaticOrderT<true>, true>(L + RING_OFF, D_, S, E);
    }
#ifdef PROBE_PHASE
    if (multi) { xcd_barrier(bar); STAMP(12);
        if (bx == 0 && tid == 0) { const float us = (float)(TS[PROBE_PHASE + 1] - TS[PROBE_PHASE]) * 0.01f; OUT[0] += us; } }
#endif
#undef IN
#undef SEAM
}

extern "C" void kernel_launch(void* const* d_in, const int* in_sizes, int n_in, void* d_out, int out_size, void* d_ws, size_t ws_size, hipStream_t stream) {
    using namespace orc;
    const float* x = (const float*)d_in[0];
    const float* p = (const float*)d_in[1];
    const float* g_mix = (const float*)d_in[2];
    const float* w_in = (const float*)d_in[3];
    const float* g_v_a = (const float*)d_in[4];
    const float* w_s = (const float*)d_in[5];
    const float* b_s = (const float*)d_in[6];
    const float* g_q = (const float*)d_in[7];
    const float* g_k = (const float*)d_in[8];
    const float* g_out_a = (const float*)d_in[9];
    const float* g_out_b = (const float*)d_in[10];
    const float* w_out = (const float*)d_in[11];
    const float* g_ffn = (const float*)d_in[12];
    const float* w_group = (const float*)d_in[13];
    const float* w_expert = (const float*)d_in[14];
    const float* w_gate_e = (const float*)d_in[15];
    const float* w_up_e = (const float*)d_in[16];
    const float* w_down_e = (const float*)d_in[17];
    const float* g_ple = (const float*)d_in[18];
    const float* w_ple = (const float*)d_in[19];
    const float* w_ple_gate = (const float*)d_in[20];
    float* out = (float*)d_out;
    char* ws = (char*)d_ws;
    (void)g_mix; (void)w_in; (void)p; (void)w_ple; (void)w_out; (void)g_ffn; (void)w_group; (void)w_expert; (void)w_gate_e; (void)w_up_e; (void)w_down_e; (void)g_ple; (void)w_ple_gate; (void)x;

    static int grid = 0;
    if (grid == 0) {
        int dev = 0, cus = 0, per_cu = 0;
        if (hipGetDevice(&dev) != hipSuccess || hipDeviceGetAttribute(&cus, hipDeviceAttributeMultiprocessorCount, dev) != hipSuccess) { fprintf(stderr, "kernel_launch: device query failed\n"); grid = -1; return; }
        if (hipFuncSetAttribute((const void*)mk_fwd, hipFuncAttributeMaxDynamicSharedMemorySize, LDS_BYTES) != hipSuccess) { fprintf(stderr, "kernel_launch: hipFuncSetAttribute(%d) failed\n", LDS_BYTES); grid = -1; return; }
        if (hipOccupancyMaxActiveBlocksPerMultiprocessor(&per_cu, (const void*)mk_fwd, NWAVES * 64, LDS_BYTES) != hipSuccess || per_cu < 1) { fprintf(stderr, "kernel_launch: occupancy query says %d\n", per_cu); per_cu = 1; }
        (void)hipGetLastError();
        grid = cus * 1;
        if (ws_size < 256 * MiB) { fprintf(stderr, "kernel_launch: workspace too small\n"); grid = -1; return; }
    }
    if (grid < 0) return;
    hipMemsetAsync(ws + WS_CTL, 0, ZERO_BYTES, stream);
    Args a{};
    for (int i = 0; i < 21; ++i) a.in[i] = (const float*)d_in[i];
    a.out = out; a.ws = (unsigned char*)d_ws; a.li = 0; a.pad = 0;

    float* rstd_va = (float*)(ws + WS_ORC);
    int* sel = (int*)(ws + WS_ORC + 512 * 1024);
    Route* route = (Route*)(ws + WS_ORC + 2 * MiB);
    float* rstd_h = (float*)(ws + WS_ORC + 2 * MiB + 512 * 1024);
    float* rstd_h2 = (float*)(ws + WS_ORC + 3 * MiB);
    float* kmean = (float*)(ws + WS_KMEAN);
    const bf16_t* ua = (const bf16_t*)(ws + WS_ARR); const bf16_t* va = ua + ARR; const bf16_t* qn = ua + 2 * ARR; const bf16_t* kn = ua + 3 * ARR; const bf16_t* vb = ua + 4 * ARR;
    const bf16_t* pwb = (const bf16_t*)(ws + WS_PW);

#ifndef ONE_LAUNCH
#define ONE_LAUNCH 1
#endif
#ifndef LEVEL
#define LEVEL 4
#endif
#ifndef ATT_ORACLE
#define ATT_ORACLE 0
#endif
#define LAUNCH_PH(lo_, hi_) do { a.ph_lo = (lo_); a.ph_hi = (hi_); hipLaunchKernelGGL(mk_fwd, dim3(grid), dim3(NWAVES * 64), LDS_BYTES, stream, a); } while (0)
#if ONE_LAUNCH
    LAUNCH_PH(0, 12);
    (void)ua; (void)va; (void)qn; (void)kn; (void)vb; (void)sel; (void)kmean; (void)rstd_va; (void)route; (void)rstd_h; (void)rstd_h2; (void)pwb; (void)g_v_a; (void)w_s; (void)b_s; (void)g_q; (void)g_k; (void)g_out_a; (void)g_out_b;
#else
    LAUNCH_PH(0, 1); LAUNCH_PH(1, 2);
    LAUNCH_PH(2, 3);
#if ATT_ORACLE
    bf16_t* op = (bf16_t*)out; float* lp = (float*)(ws + WS_LP);
    hipMemsetAsync(op, 0, (size_t)3 * T_ * 512 * 2, stream);
    hipMemsetAsync(lp, 0, (size_t)3 * T_ * 8 * 4, stream);
    k_fill<<<T_ * 8 / 256, 256, 0, stream>>>(lp + (size_t)3 * T_ * 8, 1.0f, T_ * 8, 0);
    k_gate<bf16_t><<<T_ * NH / 256, 256, 0, stream>>>(qn, kmean, sel);
    k_attn<bf16_t, bf16_t><<<T_ * NH, 256, 0, stream>>>(qn, kn, vb, sel, op + (size_t)3 * T_ * 512, 512, 0);
#else
    LAUNCH_PH(3, 4);
    (void)qn; (void)kn; (void)vb; (void)sel; (void)kmean;
#endif
    LAUNCH_PH(4, 5);
    (void)ua; (void)va; (void)rstd_va; (void)g_v_a; (void)w_s; (void)b_s; (void)g_out_a; (void)g_out_b;
#if LEVEL >= 2
    LAUNCH_PH(5, 6);
#else
    k_sgemm<<<dim3(D_ / 64, T_ / 64), 256, 0, stream>>>((long)D_, ALPlain<bf16_t>{ycat, D_, 0}, BLPlain{w_out, D_, 0}, EPResid{x, out, D_, 0});
#endif
#if LEVEL >= 3
    LAUNCH_PH(6, 7); LAUNCH_PH(7, 8); LAUNCH_PH(8, 9); LAUNCH_PH(9, 10); LAUNCH_PH(10, 11);
#if LEVEL >= 4
    LAUNCH_PH(11, 12);
#else
    float* h2 = (float*)(ws);
    hipMemcpyAsync(h2, out, (size_t)T_ * D_ * 4, hipMemcpyDeviceToDevice, stream);
    k_row_rstd<float><<<T_ / 4, 256, 0, stream>>>(h2, rstd_h2, T_, D_, D_, 0);
    k_sgemm<<<dim3(D_ / 64, T_ / 64), 256, 0, stream>>>((long)D_, ALScaled<float>{h2, rstd_h2, g_ple, D_, 0}, BLPlain{w_ple_gate, D_, 0}, EPPle<bf16_t>{h2, pwb, out, D_, 0});
#endif
#else
    float* h2 = (float*)(ws + 90 * MiB);
    k_row_rstd<float><<<T_ / 4, 256, 0, stream>>>(out, rstd_h, T_, D_, D_, 0);
    k_route<<<T_ / 4, 256, 0, stream>>>(out, rstd_h, g_ffn, w_group, w_expert, route);
    k_moe<<<T_, 256, 0, stream>>>(out, rstd_h, g_ffn, route, w_gate_e, w_up_e, w_down_e, h2);
    k_row_rstd<float><<<T_ / 4, 256, 0, stream>>>(h2, rstd_h2, T_, D_, D_, 0);
    k_sgemm<<<dim3(D_ / 64, T_ / 64), 256, 0, stream>>>((long)D_, ALScaled<float>{h2, rstd_h2, g_ple, D_, 0}, BLPlain{w_ple_gate, D_, 0}, EPPle<bf16_t>{h2, pwb, out, D_, 0});
#endif
#endif
}
```
